# Optimizing an MI355X kernel written in HIP

```python
import math
import jax, jax.numpy as jnp
from jax import lax
import numpy as np

D_MODEL = 1024
BATCH = 8
SEQ = 2048
DEPTH = 2

ROPE_THETA = 500000.0
NEG_INF = -1e30
LN_EPS = 1e-5
RMS_EPS = 1e-6
DEEPNORM_ALPHA = (2 * DEPTH) ** 0.25
DEEPNORM_BETA = (8 * DEPTH) ** -0.25
POS_OFFSET_MAX = 4096
MLA_HEADS = 8
MLA_NOPE = 64
MLA_ROPE = 32
MLA_V = 64
MLA_Q_RANK = 768
MLA_KV_RANK = 256
ATTN_Q_BLOCK = 128
MOBA_HEADS = 8
MOBA_HEAD_DIM = 64
MOBA_ROT_DIM = MOBA_HEAD_DIM // 4
MOBA_BLOCK = 256
MOBA_TOPK = 3
MOBA_Q_CHUNK = 16
GDN_HEADS = 8
GDN_HEAD_DIM = 64
GDN_CONV = 4
GDN_CHUNK = 64
N_BRANCH = 3
BRANCH_WIDTH = 512
MLA_WIDTH = MLA_HEADS * MLA_V
MOBA_WIDTH = MOBA_HEADS * MOBA_HEAD_DIM
GDN_WIDTH = GDN_HEADS * GDN_HEAD_DIM
IN_SPLITS = (MLA_Q_RANK, MLA_KV_RANK, MLA_ROPE, 3 * MOBA_WIDTH, 3 * GDN_WIDTH, GDN_WIDTH, GDN_HEADS, GDN_HEADS, N_BRANCH * D_MODEL)
IN_COLS = sum(IN_SPLITS)
PEER_HEADS = 8
N_KEYS = 128
N_EXPERTS = N_KEYS * N_KEYS
PEER_TOPK = 16
PEER_QDIM = 256
PEER_HALF = PEER_QDIM // 2
PEER_TOKEN_CHUNK = 128

kernel_name = 'hybrid_mla_moba_gdn_peer_deepnorm'


def layer_norm(x, g, b):
    xf = x.astype(jnp.float32)
    mu = jnp.mean(xf, axis=-1, keepdims=True)
    var = jnp.mean(jnp.square(xf - mu), axis=-1, keepdims=True)
    return ((xf - mu) * lax.rsqrt(var + LN_EPS) * g + b).astype(x.dtype)


def rms_norm(x, g):
    xf = x.astype(jnp.float32)
    return (xf * lax.rsqrt(jnp.mean(xf * xf, axis=-1, keepdims=True) + RMS_EPS) * g).astype(x.dtype)


def l2_normalize(t):
    tf = t.astype(jnp.float32)
    return tf * lax.rsqrt(jnp.sum(tf * tf, axis=-1, keepdims=True) + RMS_EPS)


def rope_tables(positions, rot_dim):
    inv_freq = ROPE_THETA ** (-jnp.arange(0, rot_dim, 2, dtype=jnp.float32) / rot_dim)
    ang = positions.astype(jnp.float32)[..., None] * inv_freq
    return jnp.cos(ang), jnp.sin(ang)


def apply_rope(x, cos, sin):
    r = cos.shape[-1]
    c = cos[:, :, None, :].astype(x.dtype)
    s = sin[:, :, None, :].astype(x.dtype)
    x1, x2, rest = x[..., :r], x[..., r:2 * r], x[..., 2 * r:]
    return jnp.concatenate([x1 * c - x2 * s, x2 * c + x1 * s, rest], axis=-1)


def causal_attention_blocked(q, k, v, scale):
    B, S, H, dk = q.shape
    nq = S // ATTN_Q_BLOCK
    qb = q.reshape(B, nq, ATTN_Q_BLOCK, H, dk).transpose(1, 0, 2, 3, 4)
    kpos = jnp.arange(S)

    def one_block(args):
        i, qi = args
        s = jnp.einsum('bqhd,bkhd->bhqk', qi, k, preferred_element_type=jnp.float32) * scale
        qpos = i * ATTN_Q_BLOCK + jnp.arange(ATTN_Q_BLOCK)
        s = jnp.where(kpos[None, :] <= qpos[:, None], s, NEG_INF)
        p = jax.nn.softmax(s, axis=-1).astype(v.dtype)
        return jnp.einsum('bhqk,bkhd->bqhd', p, v)

    out = lax.map(one_block, (jnp.arange(nq), qb))
    return out.transpose(1, 0, 2, 3, 4).reshape(B, S, H, v.shape[-1])


def mla_branch(c_q, c_kv, k_rope_in, q_norm_g, kv_norm_g, w_uq, w_ukv, cos, sin):
    B, S, _ = c_q.shape
    q = (rms_norm(c_q, q_norm_g) @ w_uq).reshape(B, S, MLA_HEADS, MLA_NOPE + MLA_ROPE)
    q = jnp.concatenate([q[..., :MLA_NOPE], apply_rope(q[..., MLA_NOPE:], cos, sin)], axis=-1)
    kv = (rms_norm(c_kv, kv_norm_g) @ w_ukv).reshape(B, S, MLA_HEADS, MLA_NOPE + MLA_V)
    k_nope, v = kv[..., :MLA_NOPE], kv[..., MLA_NOPE:]
    k_rope = apply_rope(k_rope_in[:, :, None, :], cos, sin)
    k = jnp.concatenate([k_nope, jnp.broadcast_to(k_rope, (B, S, MLA_HEADS, MLA_ROPE))], axis=-1)
    o = causal_attention_blocked(q, k, v, (MLA_NOPE + MLA_ROPE) ** -0.5)
    return o.reshape(B, S, MLA_WIDTH)


def moba_branch(q, k, v, cos, sin):
    B, S, H, dh = q.shape
    q = apply_rope(q, cos, sin)
    k = apply_rope(k, cos, sin)
    nb = -(-S // MOBA_BLOCK)
    n_sel = min(MOBA_TOPK, nb)
    pad = nb * MOBA_BLOCK - S
    kp = jnp.pad(k, ((0, 0), (0, pad), (0, 0), (0, 0)))
    vp = jnp.pad(v, ((0, 0), (0, pad), (0, 0), (0, 0)))
    k_blk = kp.reshape(B, nb, MOBA_BLOCK, H, dh).transpose(0, 3, 1, 2, 4)
    v_blk = vp.reshape(B, nb, MOBA_BLOCK, H, dh).transpose(0, 3, 1, 2, 4)
    k_mean = jnp.mean(k_blk.astype(jnp.float32), axis=3)
    scale = dh ** -0.5
    nqc = S // MOBA_Q_CHUNK
    q_chunks = q.reshape(B, nqc, MOBA_Q_CHUNK, H, dh).transpose(1, 0, 3, 2, 4)
    b_idx = jnp.arange(B)[:, None, None, None]
    h_idx = jnp.arange(H)[None, :, None, None]
    blk_ids = jnp.arange(nb)

    def one_chunk(args):
        c, qc = args
        q0 = c * MOBA_Q_CHUNK
        own = q0 // MOBA_BLOCK
        gate = jnp.einsum('bhqd,bhnd->bhqn', qc.astype(jnp.float32), k_mean)
        gate = jnp.where(blk_ids < own, gate, NEG_INF)
        _, sel = lax.top_k(gate, n_sel)
        valid = sel < own
        kg = k_blk[b_idx, h_idx, sel]
        vg = v_blk[b_idx, h_idx, sel]
        s_past = jnp.einsum('bhqd,bhqjpd->bhqjp', qc, kg, preferred_element_type=jnp.float32) * scale
        s_past = jnp.where(valid[..., None], s_past, NEG_INF).reshape(B, H, MOBA_Q_CHUNK, n_sel * MOBA_BLOCK)
        k_own = lax.dynamic_index_in_dim(k_blk, own, axis=2, keepdims=False)
        v_own = lax.dynamic_index_in_dim(v_blk, own, axis=2, keepdims=False)
        s_own = jnp.einsum('bhqd,bhpd->bhqp', qc, k_own, preferred_element_type=jnp.float32) * scale
        qpos = q0 + jnp.arange(MOBA_Q_CHUNK)
        kpos = own * MOBA_BLOCK + jnp.arange(MOBA_BLOCK)
        s_own = jnp.where(kpos[None, :] <= qpos[:, None], s_own, NEG_INF)
        p = jax.nn.softmax(jnp.concatenate([s_past, s_own], axis=-1), axis=-1).astype(v.dtype)
        p_past = p[..., :n_sel * MOBA_BLOCK].reshape(B, H, MOBA_Q_CHUNK, n_sel, MOBA_BLOCK)
        p_own = p[..., n_sel * MOBA_BLOCK:]
        return jnp.einsum('bhqjp,bhqjpd->bhqd', p_past, vg) + jnp.einsum('bhqp,bhpd->bhqd', p_own, v_own)

    out = lax.map(one_chunk, (jnp.arange(nqc), q_chunks))
    return out.transpose(1, 0, 3, 2, 4).reshape(B, S, MOBA_WIDTH)


def causal_depthwise_conv(x, w):
    K = w.shape[0]
    return lax.conv_general_dilated(x, w[:, None, :].astype(x.dtype), window_strides=(1,), padding=((K - 1, 0),),
                                    dimension_numbers=('NWC', 'WIO', 'NWC'), feature_group_count=x.shape[-1])


def chunk_gated_delta_rule(q, k, v, g, beta):
    B, S, H, dk = q.shape
    dv = v.shape[-1]
    C = GDN_CHUNK
    n = S // C
    f32 = jnp.float32

    def to_chunks(t):
        return t.astype(f32).reshape(B, n, C, H, -1).transpose(0, 3, 1, 2, 4)

    q, k, v = to_chunks(q), to_chunks(k), to_chunks(v)
    g = g.astype(f32).reshape(B, n, C, H).transpose(0, 3, 1, 2)
    beta = beta.astype(f32).reshape(B, n, C, H).transpose(0, 3, 1, 2)
    g_cum = jnp.cumsum(g, axis=-1)
    tril = jnp.tril(jnp.ones((C, C), dtype=bool))
    strict = jnp.tril(jnp.ones((C, C), dtype=bool), -1)
    decay = jnp.exp(jnp.where(tril, g_cum[..., :, None] - g_cum[..., None, :], -jnp.inf))
    k_beta = k * beta[..., None]
    A = jnp.where(strict, jnp.einsum('bhncd,bhnsd->bhncs', k_beta, k) * decay, 0.0)
    lhs = jnp.eye(C, dtype=f32) + A
    rhs = jnp.concatenate([v * beta[..., None], k_beta * jnp.exp(g_cum)[..., None]], axis=-1)
    sol = lax.linalg.triangular_solve(lhs, rhs, left_side=True, lower=True, unit_diagonal=True)
    u, w = sol[..., :dv], sol[..., dv:]
    qk = jnp.where(tril, jnp.einsum('bhncd,bhnsd->bhncs', q, k) * decay, 0.0)

    def step(state, xs):
        q_c, k_c, u_c, w_c, g_c, qk_c = xs
        v_new = u_c - jnp.einsum('bhcd,bhde->bhce', w_c, state)
        o_c = jnp.einsum('bhcd,bhde->bhce', q_c * jnp.exp(g_c)[..., None], state) + jnp.einsum('bhcs,bhse->bhce', qk_c, v_new)
        g_last = g_c[..., -1]
        k_dec = k_c * jnp.exp(g_last[..., None] - g_c)[..., None]
        state = state * jnp.exp(g_last)[..., None, None] + jnp.einsum('bhcd,bhce->bhde', k_dec, v_new)
        return state, o_c

    xs = tuple(jnp.moveaxis(t, 2, 0) for t in (q, k, u, w, g_cum, qk))
    _, o = lax.scan(step, jnp.zeros((B, H, dk, dv), f32), xs)
    return o.transpose(1, 0, 3, 2, 4).reshape(B, S, H, dv)


def gdn_branch(qkv, z, a, b_logit, conv_w, A_log, dt_bias, o_norm_g):
    B, S, _ = qkv.shape
    qkv = jax.nn.silu(causal_depthwise_conv(qkv, conv_w))
    q, k, v = jnp.split(qkv, 3, axis=-1)
    q = l2_normalize(q.reshape(B, S, GDN_HEADS, GDN_HEAD_DIM)) * (GDN_HEAD_DIM ** -0.5)
    k = l2_normalize(k.reshape(B, S, GDN_HEADS, GDN_HEAD_DIM))
    v = v.reshape(B, S, GDN_HEADS, GDN_HEAD_DIM)
    beta = jax.nn.sigmoid(b_logit.astype(jnp.float32))
    g = -jnp.exp(A_log.astype(jnp.float32)) * jax.nn.softplus(a.astype(jnp.float32) + dt_bias)
    o = chunk_gated_delta_rule(q, k, v, g, beta)
    o = rms_norm(o, o_norm_g) * jax.nn.silu(z.reshape(B, S, GDN_HEADS, GDN_HEAD_DIM).astype(jnp.float32))
    return o.reshape(B, S, GDN_WIDTH).astype(z.dtype)


def token_mixer(h, cos_a, sin_a, cos_b, sin_b, w_in, mla_q_norm, mla_kv_norm, mla_w_uq, mla_w_ukv,
                gdn_conv_w, gdn_A_log, gdn_dt_bias, gdn_o_norm, gate_bias, w_branch, w_out):
    B, S, D = h.shape
    offs = np.cumsum(IN_SPLITS)[:-1].tolist()
    c_q, c_kv, k_rope, moba_qkv, gdn_qkv, gdn_z, gdn_a, gdn_b, gate_logits = jnp.split(h @ w_in, offs, axis=-1)
    o_a = mla_branch(c_q, c_kv, k_rope, mla_q_norm, mla_kv_norm, mla_w_uq, mla_w_ukv, cos_a, sin_a)
    mq, mk, mv = [t.reshape(B, S, MOBA_HEADS, MOBA_HEAD_DIM) for t in jnp.split(moba_qkv, 3, axis=-1)]
    o_b = moba_branch(mq, mk, mv, cos_b, sin_b)
    o_c = gdn_branch(gdn_qkv, gdn_z, gdn_a, gdn_b, gdn_conv_w, gdn_A_log, gdn_dt_bias, gdn_o_norm)
    branches = jnp.stack([o_a, o_b, o_c], axis=2)
    gates = jax.nn.sigmoid(gate_logits.reshape(B, S, N_BRANCH, D) + gate_bias)
    merged = jnp.sum(gates * jnp.einsum('bsnw,nwd->bsnd', branches, w_branch), axis=2)
    return merged @ w_out


def peer_ffn(h, w_q, sub_keys, expert_u, expert_v):
    B, S, D = h.shape
    T = B * S
    xt = h.reshape(T, D)
    qry = (xt @ w_q).reshape(T, PEER_HEADS, 2, PEER_HALF)
    sc = jnp.einsum('thpd,hpnd->thpn', qry, sub_keys, preferred_element_type=jnp.float32)
    s1, i1 = lax.top_k(sc[:, :, 0], PEER_TOPK)
    s2, i2 = lax.top_k(sc[:, :, 1], PEER_TOPK)
    cand_s = (s1[..., :, None] + s2[..., None, :]).reshape(T, PEER_HEADS, PEER_TOPK * PEER_TOPK)
    cand_i = (i1[..., :, None] * N_KEYS + i2[..., None, :]).reshape(T, PEER_HEADS, PEER_TOPK * PEER_TOPK)
    top_s, pos = lax.top_k(cand_s, PEER_TOPK)
    idx = jnp.take_along_axis(cand_i, pos, axis=-1)
    gate = jax.nn.softmax(top_s, axis=-1)
    n_chunks = T // PEER_TOKEN_CHUNK

    def one_chunk(args):
        xc, ic, gc = args
        u = expert_u[ic]
        act = jax.nn.gelu(jnp.einsum('td,thkd->thk', xc, u, preferred_element_type=jnp.float32), approximate=False)
        return jnp.einsum('thk,thkd->td', (gc * act).astype(h.dtype), expert_v[ic])

    out = lax.map(one_chunk, (xt.reshape(n_chunks, PEER_TOKEN_CHUNK, D),
                              idx.reshape(n_chunks, PEER_TOKEN_CHUNK, PEER_HEADS, PEER_TOPK),
                              gate.reshape(n_chunks, PEER_TOKEN_CHUNK, PEER_HEADS, PEER_TOPK)))
    return out.reshape(B, S, D)


def setup_inputs(seed: int = 0) -> dict:
    key = jax.random.key(seed)
    ks = jax.random.split(key, 32)
    f32 = jnp.float32
    L, D = DEPTH, D_MODEL

    def nrm(k, shape, scale):
        return jax.random.normal(k, shape, f32) * scale

    def gain(k, shape):
        return 1.0 + 0.05 * jax.random.normal(k, shape, f32)

    x = nrm(ks[0], (BATCH, SEQ, D), 1.0)
    positions = jax.random.randint(ks[1], (BATCH, 1), 0, POS_OFFSET_MAX, dtype=jnp.int32) + jnp.arange(SEQ, dtype=jnp.int32)[None, :]
    dt = jnp.exp(jax.random.uniform(ks[11], (L, GDN_HEADS), f32, math.log(1e-3), math.log(1e-1)))
    return {
        'x': x,
        'positions': positions,
        'ln_in_g': gain(ks[2], (D,)),
        'ln_in_b': nrm(ks[3], (D,), 0.02),
        'w_in': nrm(ks[4], (L, D, IN_COLS), D ** -0.5),
        'mla_q_norm': gain(ks[5], (L, MLA_Q_RANK)),
        'mla_kv_norm': gain(ks[6], (L, MLA_KV_RANK)),
        'mla_w_uq': nrm(ks[7], (L, MLA_Q_RANK, MLA_HEADS * (MLA_NOPE + MLA_ROPE)), MLA_Q_RANK ** -0.5),
        'mla_w_ukv': nrm(ks[8], (L, MLA_KV_RANK, MLA_HEADS * (MLA_NOPE + MLA_V)), MLA_KV_RANK ** -0.5),
        'gdn_conv_w': nrm(ks[9], (L, GDN_CONV, 3 * GDN_WIDTH), GDN_CONV ** -0.5),
        'gdn_A_log': jnp.log(jax.random.uniform(ks[10], (L, GDN_HEADS), f32, 1.0, 16.0)),
        'gdn_dt_bias': dt + jnp.log(-jnp.expm1(-dt)),
        'gdn_o_norm': gain(ks[12], (L, GDN_HEAD_DIM)),
        'gate_bias': nrm(ks[13], (L, N_BRANCH, D), 0.02),
        'w_branch': nrm(ks[14], (L, N_BRANCH, BRANCH_WIDTH, D), DEEPNORM_BETA * BRANCH_WIDTH ** -0.5),
        'w_out': nrm(ks[15], (L, D, D), DEEPNORM_BETA * D ** -0.5),
        'ln1_g': gain(ks[16], (L, D)),
        'ln1_b': nrm(ks[17], (L, D), 0.02),
        'peer_w_q': nrm(ks[18], (L, D, PEER_HEADS * PEER_QDIM), D ** -0.5),
        'peer_sub_keys': nrm(ks[19], (L, PEER_HEADS, 2, N_KEYS, PEER_HALF), PEER_HALF ** -0.5),
        'peer_u': nrm(ks[20], (L, N_EXPERTS, D), D ** -0.5),
        'peer_v': nrm(ks[21], (L, N_EXPERTS, D), DEEPNORM_BETA * PEER_HEADS ** -0.5),
        'ln2_g': gain(ks[22], (L, D)),
        'ln2_b': nrm(ks[23], (L, D), 0.02),
    }


def reference(x, positions, ln_in_g, ln_in_b, w_in, mla_q_norm, mla_kv_norm, mla_w_uq, mla_w_ukv,
              gdn_conv_w, gdn_A_log, gdn_dt_bias, gdn_o_norm, gate_bias, w_branch, w_out, ln1_g, ln1_b,
              peer_w_q, peer_sub_keys, peer_u, peer_v, ln2_g, ln2_b):
    cos_a, sin_a = rope_tables(positions, MLA_ROPE)
    cos_b, sin_b = rope_tables(positions, MOBA_ROT_DIM)
    h = layer_norm(x, ln_in_g, ln_in_b)
    for l in range(DEPTH):
        mix = token_mixer(h, cos_a, sin_a, cos_b, sin_b, w_in[l], mla_q_norm[l], mla_kv_norm[l], mla_w_uq[l],
                          mla_w_ukv[l], gdn_conv_w[l], gdn_A_log[l], gdn_dt_bias[l], gdn_o_norm[l],
                          gate_bias[l], w_branch[l], w_out[l])
        h = layer_norm(DEEPNORM_ALPHA * h + mix, ln1_g[l], ln1_b[l])
        ffn = peer_ffn(h, peer_w_q[l], peer_sub_keys[l], peer_u[l], peer_v[l])
        h = layer_norm(DEEPNORM_ALPHA * h + ffn, ln2_g[l], ln2_b[l])
    return h
```

```cpp
#include <hip/hip_runtime.h>
#include <hip/hip_cooperative_groups.h>
#include <cstdio>
#include <cstdint>
namespace cg = cooperative_groups;

namespace pg8 {
#define PG8_LAS __attribute__((address_space(3)))
typedef unsigned short bf16_t;
typedef short bf16x8 __attribute__((ext_vector_type(8)));
typedef float f32x4 __attribute__((ext_vector_type(4)));
typedef unsigned u32x4 __attribute__((ext_vector_type(4)));
constexpr int BM = 256, BK = 64, HALF = 128, HTB = HALF * BK * 2  , STAGE_BYTES = 8 * HTB, NXCD = 8, WGM = 8;

__host__ __device__ __forceinline__ int lds_byte(int r, int c) { const int st = (r >> 4) * 2 + (c >> 5), rr = r & 15, cc = c & 31, ob = rr * 64 + cc * 2; return st * 1024 + (ob ^ (((ob >> 9) & 1) << 5)); }
__host__ __device__ __forceinline__ void stage_rc(int b, int& R, int& C) { const int st = b / 1024, sb = b % 1024, swz = sb ^ (((sb >> 9) & 1) << 5); R = (st >> 1) * 16 + swz / 64; C = (st & 1) * 32 + (swz % 64) / 2; }
__host__ __device__ __forceinline__ int perm32(int rho) { const int n = rho >> 4, i = rho & 15; return 8 * (i >> 2) + 4 * n + (i & 3); }

struct Unit { int pm, pn, za, tag; };
struct Gemm { const bf16_t* A; const bf16_t* Bt; int M, N, K, lda, ldb; };

struct StaticOrder {
    int nM, nN, nwg, G, c;
    __host__ __device__ void init(int M, int N, int G_, int c_) { nM = M / BM; nN = N / BM; nwg = nM * nN; G = G_; c = c_; }
    __host__ __device__ bool next(int i, Unit& u) const {
        const long L = (long)i * G + c; if (L >= nwg) return false;
        int wgid = (int)L; { const int q = nwg / NXCD, r = nwg % NXCD, xcd = wgid % NXCD, off = wgid / NXCD; wgid = (xcd < r ? xcd * (q + 1) : r * (q + 1) + (xcd - r) * q) + off; }
        const int nig = WGM * nN, gid = wgid / nig, fm = gid * WGM, gsz = (nM - fm) < WGM ? (nM - fm) : WGM;
        u.pm = fm + ((wgid % nig) % gsz); u.pn = (wgid % nig) / gsz; u.za = 0; u.tag = 0; return true;
    }
    __device__ __forceinline__ void a_ready(const Unit&) const {}
    __device__ __forceinline__ void done(const Unit&) const {}
};

__device__ __forceinline__ unsigned cvt_pk_bf16(float lo, float hi) { unsigned r; asm volatile("v_cvt_pk_bf16_f32 %0, %1, %2" : "=v"(r) : "v"(lo), "v"(hi)); return r; }
typedef float f32x2 __attribute__((ext_vector_type(2)));
__device__ __forceinline__ f32x2 gelu_pk(f32x2 v) {
    const f32x2 av = __builtin_elementwise_abs(v), d = av * 0.2316418882f + 1.0f;
    f32x2 t; t.x = __builtin_amdgcn_rcpf(d.x); t.y = __builtin_amdgcn_rcpf(d.y);
    f32x2 q = t * 0.5307027145f + (-0.7265760135f); q = q * t + 0.7107068705f; q = q * t + (-0.142248368f); q = q * t + 0.127414796f; q = q * t;
    const f32x2 s = (v * v) * (-0.72134752044f);
    f32x2 e; e.x = __builtin_amdgcn_exp2f(s.x); e.y = __builtin_amdgcn_exp2f(s.y);
    const f32x2 m = v * (q * e), r = v - m;
    f32x2 o; o.x = v.x < 0.f ? m.x : r.x; o.y = v.y < 0.f ? m.y : r.y; return o;
}

template <int ACT  > struct EpiBf16 {
    static constexpr bool PERM = true, AFTER_DRAIN = false; static_assert(ACT == 0 || ACT == 1, "EpiBf16: ACT is 0 (none) or 1 (gelu_pk)");
    bf16_t* O; int ldc; const float* bias; int split_cols; size_t split_stride; float scale0;
    __device__ __forceinline__ void operator()(const f32x4 (&acc)[2][2][4][2], const Unit& u, int wr, int wc, int fr, int fq) const {
        const int row0 = u.pm * BM + wr * 64 + fr; int colt = u.pn * BM; bf16_t* base = O;
        float sc = 1.f; if (split_cols) { const int t = colt / split_cols; base += (size_t)t * split_stride; colt -= t * split_cols; if (t == 0) sc = scale0; }
        const int col0 = colt + wc * 32 + 8 * fq, bcol0 = u.pn * BM + wc * 32 + 8 * fq;
        f32x4 bv[2][2];
#pragma unroll
        for (int bj = 0; bj < 2; ++bj)
#pragma unroll
            for (int n = 0; n < 2; ++n) bv[bj][n] = bias ? *(const f32x4*)(bias + bcol0 + bj * HALF + 4 * n) : (f32x4){0.f, 0.f, 0.f, 0.f};
#pragma unroll
        for (int ai = 0; ai < 2; ++ai)
#pragma unroll
            for (int m = 0; m < 4; ++m) { bf16_t* rowp = base + (size_t)(row0 + ai * HALF + m * 16) * ldc + col0;
#pragma unroll
                for (int bj = 0; bj < 2; ++bj) { f32x4 v0 = acc[ai][bj][m][0] + bv[bj][0], v1 = acc[ai][bj][m][1] + bv[bj][1];
                    if (ACT == 1) { f32x2 a = gelu_pk((f32x2){v0[0], v0[1]}), b = gelu_pk((f32x2){v0[2], v0[3]}), c = gelu_pk((f32x2){v1[0], v1[1]}), d = gelu_pk((f32x2){v1[2], v1[3]});
                        v0 = (f32x4){a.x, a.y, b.x, b.y}; v1 = (f32x4){c.x, c.y, d.x, d.y}; }
                    v0 = v0 * sc; v1 = v1 * sc; u32x4 w; w.x = cvt_pk_bf16(v0[0], v0[1]); w.y = cvt_pk_bf16(v0[2], v0[3]); w.z = cvt_pk_bf16(v1[0], v1[1]); w.w = cvt_pk_bf16(v1[2], v1[3]);
                    *(u32x4*)(rowp + bj * HALF) = w; } }
    }
};

struct PanelStats {
    unsigned* xbuf;
    unsigned* cnt;
    unsigned* tmo;
    int ntn; float eps;
    unsigned code;
    __device__ __forceinline__ bool run(const f32x4 (&v)[2][2][4][2], const Unit& u, int wr, int wc, int fr, int fq, PG8_LAS unsigned char* lds, int wid, int lane) const {
        typedef float f32x2v __attribute__((ext_vector_type(2)));
        PG8_LAS f32x2v* P = (PG8_LAS f32x2v*)lds;
        PG8_LAS f32x2v* S = (PG8_LAS f32x2v*)(lds + 8192);
        PG8_LAS unsigned* flag = (PG8_LAS unsigned*)(lds + 8192 + 2048);
#pragma unroll
        for (int ai = 0; ai < 2; ++ai)
#pragma unroll
            for (int m = 0; m < 4; ++m) {
                float s = 0.f;
#pragma unroll
                for (int bj = 0; bj < 2; ++bj)
#pragma unroll
                    for (int n = 0; n < 2; ++n) { const f32x4 x = v[ai][bj][m][n]; s += (x[0] + x[1]) + (x[2] + x[3]); }
                s += __shfl_xor(s, 16); s += __shfl_xor(s, 32);
                const float mw = s * (1.0f / 64.0f); float q = 0.f;
#pragma unroll
                for (int bj = 0; bj < 2; ++bj)
#pragma unroll
                    for (int n = 0; n < 2; ++n) { const f32x4 d = v[ai][bj][m][n] - mw; q += (d[0] * d[0] + d[1] * d[1]) + (d[2] * d[2] + d[3] * d[3]); }
                q += __shfl_xor(q, 16); q += __shfl_xor(q, 32);
                if (fq == 0) P[(ai * HALF + wr * 64 + m * 16 + fr) * 4 + wc] = (f32x2v){mw, q};
            }
        asm volatile("s_waitcnt lgkmcnt(0)" ::: "memory"); __builtin_amdgcn_s_barrier(); asm volatile("" ::: "memory");
#if defined(BROKEN_EXCHANGE_NO_WAIT)
#warning BROKEN CONTROL BUILD: the row-statistics exchange does not wait; results are wrong by design
        if (blockIdx.x >= 64) { const long long t0_ = clock64(); while (clock64() - t0_ < 60000) __builtin_amdgcn_s_sleep(8); }
#endif
        const int row = wid * 32 + (lane & 31);
        if (lane < 32) {
            const f32x2v a = P[row * 4 + 0], b = P[row * 4 + 1], c = P[row * 4 + 2], d = P[row * 4 + 3];
            const float mt = (a.x + b.x + c.x + d.x) * 0.25f;
            const float da = a.x - mt, db = b.x - mt, dc = c.x - mt, dd = d.x - mt;
            const float m2 = (a.y + b.y) + (c.y + d.y) + 64.0f * ((da * da + db * db) + (dc * dc + dd * dd));
            unsigned long long* slot = (unsigned long long*)xbuf + ((size_t)(u.pm * BM + row) * 4 + u.pn);
            __hip_atomic_store(slot, ((unsigned long long)__float_as_uint(m2) << 32) | __float_as_uint(mt), __ATOMIC_RELAXED, __HIP_MEMORY_SCOPE_AGENT);
        }
        asm volatile("s_waitcnt vmcnt(0)" ::: "memory");
        if (lane == 0) __hip_atomic_fetch_add(cnt + 64 * u.pm, 1u, __ATOMIC_RELAXED, __HIP_MEMORY_SCOPE_AGENT);
        if (wid == 0) {
            bool dead = false; const unsigned long long t0 = __builtin_amdgcn_s_memrealtime(); const unsigned want = 8u * (unsigned)ntn;
            for (;;) {
#if defined(BROKEN_EXCHANGE_NO_WAIT)
                break;
#endif
                if ((unsigned)__builtin_amdgcn_readfirstlane(__hip_atomic_load(cnt + 64 * u.pm, __ATOMIC_RELAXED, __HIP_MEMORY_SCOPE_AGENT)) >= want) break;
                if (__builtin_amdgcn_s_memrealtime() - t0 > 2000000ull) {
                    if (lane == 0) { unsigned expect = 0u; __hip_atomic_compare_exchange_strong(tmo + 1, &expect, code | (unsigned)(u.pm & 0xff), __ATOMIC_RELAXED, __ATOMIC_RELAXED, __HIP_MEMORY_SCOPE_AGENT);
                                     __hip_atomic_store(tmo, 1u, __ATOMIC_RELAXED, __HIP_MEMORY_SCOPE_AGENT); }
                    dead = true; break; }
                __builtin_amdgcn_s_sleep(2);
            }
            __builtin_amdgcn_fence(__ATOMIC_ACQUIRE, "agent");
            if (lane == 0) flag[0] = dead ? 1u : 0u;
        }
        asm volatile("s_waitcnt vmcnt(0) lgkmcnt(0)" ::: "memory"); __builtin_amdgcn_s_barrier(); asm volatile("" ::: "memory");
        const bool bad = flag[0] != 0u;
        if (lane < 32) {
            const unsigned long long* slot = (const unsigned long long*)xbuf + (size_t)(u.pm * BM + row) * 4; float mt[4], m2[4]; float ms = 0.f;
#pragma unroll
            for (int t = 0; t < 4; ++t) { if (t < ntn) { const unsigned long long w = __hip_atomic_load(slot + t, __ATOMIC_RELAXED, __HIP_MEMORY_SCOPE_AGENT); mt[t] = __uint_as_float((unsigned)w); m2[t] = __uint_as_float((unsigned)(w >> 32)); } else { mt[t] = 0.f; m2[t] = 0.f; } ms += mt[t]; }
            const float mean = ms / (float)ntn; float q = 0.f;
#pragma unroll
            for (int t = 0; t < 4; ++t) if (t < ntn) { const float dm = mt[t] - mean; q += m2[t] + 256.0f * dm * dm; }
            S[row] = (f32x2v){mean, 1.0f / sqrtf(q / (256.0f * (float)ntn) + eps)};
        }
        asm volatile("s_waitcnt lgkmcnt(0)" ::: "memory"); __builtin_amdgcn_s_barrier(); asm volatile("" ::: "memory");
        return bad;
    }
};
struct EpiLnRes {
    static constexpr bool PERM = false, AFTER_DRAIN = true;
    const float* base; float* out; int ldc; const float* bias; PanelStats st; unsigned poison;
    __device__ __forceinline__ void fused(f32x4 (&acc)[2][2][4][2], const Unit& u, int wr, int wc, int fr, int fq, PG8_LAS unsigned char* lds, int wid, int lane) const {
        typedef float f32x2v __attribute__((ext_vector_type(2)));
        const PG8_LAS f32x2v* S = (const PG8_LAS f32x2v*)(lds + 8192);
        const int col0 = u.pn * BM + wc * 32 + 4 * fq;
#pragma unroll
        for (int bj = 0; bj < 2; ++bj)
#pragma unroll
            for (int n = 0; n < 2; ++n) { const f32x4 bv = bias ? *(const f32x4*)(bias + col0 + bj * HALF + n * 16) : (f32x4){0.f, 0.f, 0.f, 0.f};
#pragma unroll
                for (int ai = 0; ai < 2; ++ai)
#pragma unroll
                    for (int m = 0; m < 4; ++m) acc[ai][bj][m][n] += bv; }
        f32x4 pre[4][2][2];
#pragma unroll
        for (int m = 0; m < 4; ++m) { const size_t off = (size_t)(u.pm * BM + wr * 64 + m * 16 + fr) * ldc + col0;
#pragma unroll
            for (int bj = 0; bj < 2; ++bj)
#pragma unroll
                for (int n = 0; n < 2; ++n) pre[m][bj][n] = *(const f32x4*)(base + off + bj * HALF + n * 16); }
        const bool bad = st.run(acc, u, wr, wc, fr, fq, lds, wid, lane) || poison != 0u;
        const float qnan = __builtin_nanf("");
#pragma unroll
        for (int ai = 0; ai < 2; ++ai)
#pragma unroll
            for (int m = 0; m < 4; ++m) { const int r = ai * HALF + wr * 64 + m * 16 + fr; const f32x2v sr = S[r]; const size_t off = (size_t)(u.pm * BM + r) * ldc + col0;
#pragma unroll
                for (int bj = 0; bj < 2; ++bj)
#pragma unroll
                    for (int n = 0; n < 2; ++n) { const f32x4 bs = ai == 0 ? pre[m][bj][n] : *(const f32x4*)(base + off + bj * HALF + n * 16); f32x4 o = bs + (acc[ai][bj][m][n] - sr.x) * sr.y;
                        if (bad) o = (f32x4){qnan, qnan, qnan, qnan}; *(f32x4*)(out + off + bj * HALF + n * 16) = o; }
                if (m & 1) asm volatile("" ::: "memory"); }
    }
};
struct EpiLnResLn {
    static constexpr bool PERM = false, AFTER_DRAIN = true;
    const float* base; float* out; bf16_t* xn; int ldc; const float* bias; PanelStats st1, st2; unsigned poison;
    __device__ __forceinline__ void fused(f32x4 (&acc)[2][2][4][2], const Unit& u, int wr, int wc, int fr, int fq, PG8_LAS unsigned char* lds, int wid, int lane) const {
        typedef float f32x2v __attribute__((ext_vector_type(2))); typedef unsigned u32x2v __attribute__((ext_vector_type(2)));
        const PG8_LAS f32x2v* S = (const PG8_LAS f32x2v*)(lds + 8192);
        const int col0 = u.pn * BM + wc * 32 + 4 * fq;
#pragma unroll
        for (int bj = 0; bj < 2; ++bj)
#pragma unroll
            for (int n = 0; n < 2; ++n) { const f32x4 bv = bias ? *(const f32x4*)(bias + col0 + bj * HALF + n * 16) : (f32x4){0.f, 0.f, 0.f, 0.f};
#pragma unroll
                for (int ai = 0; ai < 2; ++ai)
#pragma unroll
                    for (int m = 0; m < 4; ++m) acc[ai][bj][m][n] += bv; }
        bool bad = st1.run(acc, u, wr, wc, fr, fq, lds, wid, lane) || poison != 0u;
        const float qnan = __builtin_nanf("");
#pragma unroll
        for (int ai = 0; ai < 2; ++ai)
#pragma unroll
            for (int m = 0; m < 4; ++m) { const int r = ai * HALF + wr * 64 + m * 16 + fr; const f32x2v sr = S[r]; const size_t off = (size_t)(u.pm * BM + r) * ldc + col0;
#pragma unroll
                for (int bj = 0; bj < 2; ++bj)
#pragma unroll
                    for (int n = 0; n < 2; ++n) { const f32x4 bs = *(const f32x4*)(base + off + bj * HALF + n * 16); acc[ai][bj][m][n] = bs + (acc[ai][bj][m][n] - sr.x) * sr.y; }
                asm volatile("" : "+v"(acc[ai][0][m][0]), "+v"(acc[ai][0][m][1]), "+v"(acc[ai][1][m][0]), "+v"(acc[ai][1][m][1]));
                if (m & 1) asm volatile("" ::: "memory"); }
        const bool bad1 = bad;
        bad = st2.run(acc, u, wr, wc, fr, fq, lds, wid, lane) || bad;
#pragma unroll
        for (int ai = 0; ai < 2; ++ai)
#pragma unroll
            for (int m = 0; m < 4; ++m) { const int r = ai * HALF + wr * 64 + m * 16 + fr; const f32x2v sr = S[r]; const size_t off = (size_t)(u.pm * BM + r) * ldc + col0;
#pragma unroll
                for (int bj = 0; bj < 2; ++bj)
#pragma unroll
                    for (int n = 0; n < 2; ++n) { const f32x4 x1 = acc[ai][bj][m][n]; *(f32x4*)(out + off + bj * HALF + n * 16) = bad1 ? (f32x4){qnan, qnan, qnan, qnan} : x1;
                        const f32x4 o = (x1 - sr.x) * sr.y; u32x2v w; w.x = cvt_pk_bf16(o[0], o[1]); w.y = cvt_pk_bf16(o[2], o[3]);
                        if (bad) { w.x = 0x7fc07fc0u; w.y = 0x7fc07fc0u; } *(u32x2v*)(xn + off + bj * HALF + n * 16) = w; }
                asm volatile("" ::: "memory"); }
    }
};

template <class Epi, class Sched, bool ALIGN_EPI = false, bool SP2 = false>
__device__ __forceinline__ void gemm_phase(PG8_LAS unsigned char* lds, const Gemm g, const Sched& S, const Epi& E) {
    const int tid = threadIdx.x, wid = __builtin_amdgcn_readfirstlane(tid >> 6), lane = tid & 63, wr = wid >> 2, wc = wid & 3, fr = lane & 15, fq = lane >> 4;
    const int K = g.K, nt = K / BK;
    unsigned voffA[2], voffB[2];
#pragma unroll
    for (int i = 0; i < 2; ++i) { int R, C; stage_rc(tid * 16 + i * 8192, R, C); const int Rb = Epi::PERM ? ((R & ~31) + perm32(R & 31)) : R;
        voffA[i] = (unsigned)(R * g.lda + C) * 2u; voffB[i] = (unsigned)(Rb * g.ldb + C) * 2u; }
    const size_t kstep = (size_t)(BK * 2);
    const size_t hstepA = (size_t)HALF * g.lda * 2, hstepB = (size_t)HALF * g.ldb * 2;
    const size_t tstepA = 2 * hstepA, tstepB = 2 * hstepB;
    const unsigned ldsw = (unsigned)wid * 1024u;
    const int aoff = lds_byte(wr * 64 + fr, fq * 8), boff = lds_byte(wc * 32 + fr, fq * 8);
#define PG8_SA(b, h) (((b) * 2 + (h)) * HTB)
#define PG8_SB(b, h) ((4 + (b) * 2 + (h)) * HTB)
#define PG8_STAGE(bufoff, gbase, voff) do { _Pragma("unroll") for (int _i = 0; _i < 2; ++_i) \
        __builtin_amdgcn_global_load_lds((const unsigned*)((const char*)(gbase) + (voff)[_i]), (PG8_LAS unsigned*)(lds + (bufoff) + ldsw + _i * 8192), 16, 0, 0); } while (0)
#define PG8_LDA(dst, b, h) do { _Pragma("unroll") for (int m = 0; m < 4; ++m) _Pragma("unroll") for (int k = 0; k < 2; ++k) dst[m][k] = *(const PG8_LAS bf16x8*)(lds + PG8_SA(b, h) + aoff + m * 2048 + k * 1024); } while (0)
#define PG8_LDB(dst, b, h) do { _Pragma("unroll") for (int n = 0; n < 2; ++n) _Pragma("unroll") for (int k = 0; k < 2; ++k) dst[n][k] = *(const PG8_LAS bf16x8*)(lds + PG8_SB(b, h) + boff + n * 2048 + k * 1024); } while (0)
#define PG8_MMA(ai, bj, At, Bt) do { __builtin_amdgcn_s_setprio(1); _Pragma("unroll") for (int m = 0; m < 4; ++m) _Pragma("unroll") for (int n = 0; n < 2; ++n) _Pragma("unroll") for (int k = 0; k < 2; ++k) \
        acc[ai][bj][m][n] = __builtin_amdgcn_mfma_f32_16x16x32_bf16(Bt[n][k], At[m][k], acc[ai][bj][m][n], 0, 0, 0); __builtin_amdgcn_s_setprio(0); } while (0)
#define PG8_WAIT_V(n) asm volatile("s_waitcnt vmcnt(" #n ")" ::: "memory")
#define PG8_WAIT_L(n) asm volatile("s_waitcnt lgkmcnt(" #n ")" ::: "memory")
#define PG8_BAR __builtin_amdgcn_s_barrier()
#define PG8_SCHED __builtin_amdgcn_sched_barrier(0)
    Unit cur, nxt; int ui = 0;
    if (!S.next(0, cur)) return;
    f32x4 acc[2][2][4][2];
#pragma unroll
    for (int a = 0; a < 2; ++a)
#pragma unroll
        for (int b = 0; b < 2; ++b)
#pragma unroll
            for (int m = 0; m < 4; ++m)
#pragma unroll
                for (int n = 0; n < 2; ++n) acc[a][b][m][n] = (f32x4){0.f, 0.f, 0.f, 0.f};
    bf16x8 At[4][2], B0[2][2], B1[2][2];
    const char* cA = (const char*)g.A + (size_t)cur.pm * tstepA + (size_t)cur.za * 2; const char* cB = (const char*)g.Bt + (size_t)cur.pn * tstepB;
    S.a_ready(cur);
    if constexpr (SP2) {
        PG8_STAGE(PG8_SB(0, 0), cB, voffB); PG8_STAGE(PG8_SB(0, 1), cB + hstepB, voffB); PG8_STAGE(PG8_SA(0, 0), cA, voffA); PG8_STAGE(PG8_SA(0, 1), cA + hstepA, voffA);
        if (wr == 1) PG8_BAR;
        PG8_WAIT_V(2); PG8_BAR;
        PG8_STAGE(PG8_SB(1, 0), cB + kstep, voffB); PG8_STAGE(PG8_SA(1, 0), cA + kstep, voffA); PG8_STAGE(PG8_SB(1, 1), cB + hstepB + kstep, voffB);
        PG8_WAIT_V(6); PG8_BAR;
    } else {
        PG8_STAGE(PG8_SB(0, 0), cB, voffB); PG8_STAGE(PG8_SA(0, 0), cA, voffA); PG8_STAGE(PG8_SB(0, 1), cB + hstepB, voffB); PG8_STAGE(PG8_SA(0, 1), cA + hstepA, voffA);
        if (wr == 1) PG8_BAR;
        PG8_WAIT_V(4); PG8_BAR;
        PG8_STAGE(PG8_SB(1, 0), cB + kstep, voffB); PG8_STAGE(PG8_SA(1, 0), cA + kstep, voffA); PG8_STAGE(PG8_SB(1, 1), cB + hstepB + kstep, voffB);
        PG8_WAIT_V(6); PG8_BAR;
    }
    for (;;) {
        const bool has_next = S.next(ui + 1, nxt);
        const char* nA = has_next ? (const char*)g.A + (size_t)nxt.pm * tstepA + (size_t)nxt.za * 2 : cA; const char* nB = has_next ? (const char*)g.Bt + (size_t)nxt.pn * tstepB : cB;
        for (int t = 0; t < nt; t += 2) {
            const bool last = (t == nt - 2);
            const char* a1 = cA + (size_t)(t + 1) * kstep;
            const char* a2 = last ? nA : cA + (size_t)(t + 2) * kstep; const char* b2 = last ? nB : cB + (size_t)(t + 2) * kstep;
            const char* a3 = a2 + kstep; const char* b3 = b2 + kstep;
            if (last && has_next) S.a_ready(nxt);
            if constexpr (SP2) {
            PG8_LDB(B0, 0, 0); PG8_LDB(B1, 0, 1); PG8_SCHED; PG8_LDA(At, 0, 0); PG8_STAGE(PG8_SA(1, 1), a1 + hstepA, voffA);
            PG8_WAIT_V(8); PG8_WAIT_L(0); PG8_BAR; PG8_MMA(0, 0, At, B0); PG8_MMA(0, 1, At, B1); PG8_BAR; PG8_SCHED;
            PG8_LDA(At, 0, 1); PG8_STAGE(PG8_SB(0, 0), b2, voffB); PG8_STAGE(PG8_SB(0, 1), b2 + hstepB, voffB); PG8_STAGE(PG8_SA(0, 0), a2, voffA);
            PG8_WAIT_V(8); PG8_WAIT_L(0); PG8_BAR; PG8_MMA(1, 0, At, B0); PG8_MMA(1, 1, At, B1); PG8_BAR; PG8_SCHED;
            PG8_LDB(B0, 1, 0); PG8_LDB(B1, 1, 1); PG8_SCHED; PG8_LDA(At, 1, 0); PG8_STAGE(PG8_SA(0, 1), a2 + hstepA, voffA);
            PG8_WAIT_V(8); PG8_WAIT_L(0); PG8_BAR; PG8_MMA(0, 0, At, B0); PG8_MMA(0, 1, At, B1); PG8_BAR; PG8_SCHED;
            PG8_LDA(At, 1, 1); PG8_STAGE(PG8_SB(1, 0), b3, voffB); PG8_STAGE(PG8_SB(1, 1), b3 + hstepB, voffB); PG8_STAGE(PG8_SA(1, 0), a3, voffA);
            PG8_WAIT_V(8); PG8_WAIT_L(0); PG8_BAR; PG8_MMA(1, 0, At, B0); PG8_MMA(1, 1, At, B1); PG8_BAR; PG8_SCHED;
            } else {
            PG8_LDB(B0, 0, 0); PG8_SCHED; PG8_LDA(At, 0, 0); PG8_STAGE(PG8_SA(1, 1), a1 + hstepA, voffA);
            PG8_WAIT_L(8); PG8_BAR; PG8_WAIT_L(0); PG8_MMA(0, 0, At, B0); PG8_BAR; PG8_SCHED;
            PG8_LDB(B1, 0, 1); PG8_STAGE(PG8_SB(0, 0), b2, voffB);
            PG8_BAR; PG8_WAIT_L(0); PG8_MMA(0, 1, At, B1); PG8_BAR;
            PG8_LDA(At, 0, 1); PG8_STAGE(PG8_SA(0, 0), a2, voffA);
            PG8_BAR; PG8_WAIT_L(0); PG8_MMA(1, 0, At, B0); PG8_BAR; PG8_SCHED;
            PG8_STAGE(PG8_SB(0, 1), b2 + hstepB, voffB);
            PG8_WAIT_V(6); PG8_BAR; PG8_MMA(1, 1, At, B1); PG8_BAR;
            PG8_LDB(B0, 1, 0); PG8_SCHED; PG8_LDA(At, 1, 0); PG8_STAGE(PG8_SA(0, 1), a2 + hstepA, voffA);
            PG8_WAIT_L(8); PG8_BAR; PG8_WAIT_L(0); PG8_MMA(0, 0, At, B0); PG8_BAR; PG8_SCHED;
            PG8_LDB(B1, 1, 1); PG8_STAGE(PG8_SB(1, 0), b3, voffB);
            PG8_BAR; PG8_WAIT_L(0); PG8_MMA(0, 1, At, B1); PG8_BAR;
            PG8_LDA(At, 1, 1); PG8_STAGE(PG8_SA(1, 0), a3, voffA);
            PG8_BAR; PG8_WAIT_L(0); PG8_MMA(1, 0, At, B0); PG8_BAR; PG8_SCHED;
            PG8_STAGE(PG8_SB(1, 1), b3 + hstepB, voffB);
            PG8_WAIT_V(6); PG8_BAR; PG8_MMA(1, 1, At, B1); PG8_BAR;
            }
        }
        if constexpr (ALIGN_EPI) { if (wr == 0) PG8_BAR; }
        if constexpr (!Epi::AFTER_DRAIN) { E(acc, cur, wr, wc, fr, fq); S.done(cur); }
        if (!has_next) break;
#pragma unroll
        for (int a = 0; a < 2; ++a)
#pragma unroll
            for (int b = 0; b < 2; ++b)
#pragma unroll
                for (int m = 0; m < 4; ++m)
#pragma unroll
                    for (int n = 0; n < 2; ++n) acc[a][b][m][n] = (f32x4){0.f, 0.f, 0.f, 0.f};
        cur = nxt; cA = nA; cB = nB; ++ui;
        if constexpr (ALIGN_EPI) { if (wr == 1) PG8_BAR; }
    }
    PG8_WAIT_V(0);
    if constexpr (!ALIGN_EPI) { if (wr == 0) PG8_BAR; }
    PG8_BAR;
    if constexpr (Epi::AFTER_DRAIN) { E.fused(acc, cur, wr, wc, fr, fq, lds, wid, lane); S.done(cur); }
#undef PG8_SA
#undef PG8_SB
#undef PG8_STAGE
#undef PG8_LDA
#undef PG8_LDB
#undef PG8_MMA
#undef PG8_WAIT_V
#undef PG8_WAIT_L
#undef PG8_BAR
#undef PG8_SCHED
}
}

constexpr int NB = 8, SEQ = 2048, DM = 1024, MROWS = NB * SEQ;
constexpr int NLAYER = 2;
constexpr int IN_COLS = 7728;
constexpr int P1LD = 1280, P2LD = 3840;
constexpr int C2_MQ = 0, C2_MK = 512, C2_MV = 1024, C2_GQ = 1536, C2_GK = 2048, C2_GV = 2560, C2_GZ = 3072, C2_GA = 3584, C2_GB = 3592;
constexpr int BRLD = 1536;
constexpr float LN_EPS = 1e-5f, RMS_EPS = 1e-6f;
constexpr float DN_ALPHA = 1.4142135623730951f;
constexpr int NWAVES = 8, NTHREADS = 512;

constexpr size_t KiB = 1024, MiB = 1024 * 1024;
constexpr size_t OFF_CTL = 0, CTL_BYTES = 1 * MiB;
constexpr size_t OFF_MISC = 1 * MiB;
constexpr size_t OFF_KMEAN = OFF_MISC;
constexpr size_t OFF_RSTD = OFF_MISC + 128 * KiB;
constexpr size_t OFF_GLS = OFF_MISC + 256 * KiB;
constexpr size_t OFF_TAB = 2 * MiB;
constexpr size_t OFF_COSA = OFF_TAB, OFF_SINA = OFF_TAB + 1 * MiB, OFF_COSB = OFF_TAB + 2 * MiB, OFF_SINB = OFF_TAB + 2 * MiB + 512 * KiB;
constexpr size_t OFF_W = 5 * MiB, W_LAYER = 28 * MiB;
constexpr size_t WO_IN = 0, WO_G = 10 * MiB, WO_UQ = 16 * MiB, WO_UKV = 17 * MiB + 256 * KiB, WO_BR = 17 * MiB + 768 * KiB,
                 WO_OUT = 20 * MiB + 768 * KiB, WO_PQ = 22 * MiB + 768 * KiB, WO_SK = 26 * MiB + 768 * KiB;
constexpr size_t OFF_HF = 61 * MiB, OFF_HB = 125 * MiB, OFF_RA = 157 * MiB, OFF_RB = 205 * MiB, OFF_RC = 325 * MiB, OFF_RD = 383 * MiB, WS_END = 480 * MiB;
constexpr size_t OFF_PROJ1 = OFF_RA, OFF_BR = OFF_RA;
constexpr size_t OFF_PROJ2 = OFF_RB, OFF_Y = OFF_RB, OFF_QRY = OFF_RB;
constexpr size_t OFF_QMLA = OFF_RC, OFF_KVMLA = OFF_RC + 24 * MiB, OFF_KR = OFF_RC + 56 * MiB, OFF_MERGED = OFF_RC, OFF_IDX = OFF_RC, OFF_GATE = OFF_RC + 8 * MiB;
constexpr size_t OFF_GDN = OFF_RD, OFF_GLG = OFF_RD, OFF_PU = OFF_RD, OFF_PV = OFF_RD + 32 * MiB;
constexpr int GDN_MAT = 4096;

#define GAS __attribute__((address_space(1)))
#define LAS __attribute__((address_space(3)))
typedef unsigned short bf16;
typedef short bf16x8 __attribute__((ext_vector_type(8)));
typedef short s16x4 __attribute__((ext_vector_type(4)));
typedef float f32x4 __attribute__((ext_vector_type(4)));
typedef float f32x2 __attribute__((ext_vector_type(2)));
typedef float f32x16 __attribute__((ext_vector_type(16)));
typedef unsigned u32x4 __attribute__((ext_vector_type(4)));
typedef unsigned u32x2 __attribute__((ext_vector_type(2)));

__device__ __forceinline__ unsigned f2bf(float f) { unsigned u = __builtin_bit_cast(unsigned, f); return (u + 0x7fffu + ((u >> 16) & 1u)) >> 16; }
__device__ __forceinline__ unsigned pk2(float lo, float hi) { return f2bf(lo) | (f2bf(hi) << 16); }
__device__ __forceinline__ float bflo(unsigned w) { return __builtin_bit_cast(float, w << 16); }
__device__ __forceinline__ float bfhi(unsigned w) { return __builtin_bit_cast(float, w & 0xffff0000u); }
__device__ __forceinline__ float bf1(bf16 h) { return __builtin_bit_cast(float, (unsigned)h << 16); }
__device__ __forceinline__ float wave_sum(float v) {
#pragma unroll
    for (int o = 1; o < 64; o <<= 1) v += __shfl_xor(v, o);
    return v;
}
__device__ __forceinline__ float sigmoidf_(float x) { return 1.0f / (1.0f + __expf(-x)); }
__device__ __forceinline__ float siluf_(float x) { return x / (1.0f + __expf(-x)); }
__device__ __forceinline__ float softplusf_(float x) { return x > 20.f ? x : log1pf(__expf(x)); }
__device__ __forceinline__ void unpack8(const u32x4 v, float* f) {
    f[0] = bflo(v.x); f[1] = bfhi(v.x); f[2] = bflo(v.y); f[3] = bfhi(v.y); f[4] = bflo(v.z); f[5] = bfhi(v.z); f[6] = bflo(v.w); f[7] = bfhi(v.w);
}
__device__ __forceinline__ u32x4 pack8(const float* f) { u32x4 v; v.x = pk2(f[0], f[1]); v.y = pk2(f[2], f[3]); v.z = pk2(f[4], f[5]); v.w = pk2(f[6], f[7]); return v; }

struct Params { const void* in[24]; float* out; unsigned char* ws; int pad0, pad1; };

constexpr int RING_BYTES = 131072;
constexpr int LDS_BYTES = 147456;

struct Frame {
    LAS unsigned char* lds;
    int tid, lane, wave, G, bid;
    unsigned char* ws;
};

#define LDS_WAIT() asm volatile("s_waitcnt lgkmcnt(0)" ::: "memory")
#define VM_WAIT() asm volatile("s_waitcnt vmcnt(0)" ::: "memory")
__device__ __forceinline__ float ld_coh_f32(float* p) { return __hip_atomic_load(p, __ATOMIC_RELAXED, __HIP_MEMORY_SCOPE_AGENT); }

__device__ __forceinline__ void ln_row(const float* xrow, const float* g, const float* bta, float* of32, bf16* obf, int lane, float pre = 1.0f) {
    const f32x4* xr = (const f32x4*)xrow + lane;
    f32x4 v[4]; float s = 0.f;
#pragma unroll
    for (int j = 0; j < 4; ++j) { v[j] = xr[64 * j] * pre; s += (v[j].x + v[j].y) + (v[j].z + v[j].w); }
    const float mean = wave_sum(s) * (1.f / 1024.f); float s2 = 0.f;
#pragma unroll
    for (int j = 0; j < 4; ++j) { v[j] = v[j] - mean; s2 += (v[j].x * v[j].x + v[j].y * v[j].y) + (v[j].z * v[j].z + v[j].w * v[j].w); }
    const float rstd = 1.f / sqrtf(wave_sum(s2) * (1.f / 1024.f) + LN_EPS);
    const f32x4* gr = (const f32x4*)g + lane; const f32x4* br = (const f32x4*)bta + lane;
    f32x4* o4 = (f32x4*)of32 + lane; u32x2* o8 = (u32x2*)obf + lane;
#pragma unroll
    for (int j = 0; j < 4; ++j) { const f32x4 o = v[j] * rstd * gr[64 * j] + br[64 * j]; if (of32) o4[64 * j] = o; u32x2 w; w.x = pk2(o.x, o.y); w.y = pk2(o.z, o.w); o8[64 * j] = w; }
}

__device__ __forceinline__ void transpose_item(const float* W, int ldw, int c_off, int n_valid, const float* kscale, bf16* WT, int K, int row0, LAS float* scr, int kb, int nb, int lane) {
    const int k0 = 64 * kb, n0 = 32 * nb;
#pragma unroll 8
    for (int i = 0; i < 32; ++i) { const int kk = 2 * i + (lane >> 5), n = n0 + (lane & 31);
        float v = (n < n_valid) ? W[(size_t)(k0 + kk) * ldw + c_off + n] : 0.f; if (kscale) v *= kscale[k0 + kk];
        scr[kk * 33 + (lane & 31)] = v; }
    LDS_WAIT(); asm volatile("" ::: "memory");
    const int c = lane & 7;
#pragma unroll
    for (int j = 0; j < 4; ++j) { const int n = (lane >> 3) + 8 * j; const LAS float* s = scr + (8 * c) * 33 + n;
        u32x4 o; o.x = pk2(s[0 * 33], s[1 * 33]); o.y = pk2(s[2 * 33], s[3 * 33]); o.z = pk2(s[4 * 33], s[5 * 33]); o.w = pk2(s[6 * 33], s[7 * 33]);
        *(u32x4*)(WT + (size_t)(row0 + n0 + n) * K + k0 + 8 * c) = o; }
    LDS_WAIT(); asm volatile("" ::: "memory");
}

__device__ __forceinline__ void p0_prologue(const Frame& F, const Params& P) {
    LAS float* scr = (LAS float*)(F.lds + F.wave * 16384);
    const int gw = F.bid * NWAVES + F.wave, NGW = F.G * NWAVES;
    constexpr int I_IN1 = 16 * 40, I_IN2 = 16 * 120, I_G = 16 * 96, I_UQ = 12 * 24, I_UKV = 4 * 32, I_BR = 8 * 32, I_OUT = 16 * 32, I_PQ = 16 * 64;
    constexpr int I_LAYER = I_IN1 + I_IN2 + I_G + I_UQ + I_UKV + 3 * I_BR + I_OUT + I_PQ;
    for (int it = gw; it < NLAYER * I_LAYER; it += NGW) {
        const int l = it / I_LAYER; int r = it % I_LAYER;
        unsigned char* wl = F.ws + OFF_W + (size_t)l * W_LAYER;
        const float* w_in = (const float*)P.in[4] + (size_t)l * 1024 * IN_COLS;
        if (r < I_IN1) { transpose_item(w_in, IN_COLS, 0, 1056, nullptr, (bf16*)(wl + WO_IN), 1024, 0, scr, r / 40, r % 40, F.lane); continue; } r -= I_IN1;
        if (r < I_IN2) { transpose_item(w_in, IN_COLS, 1056, 3600, nullptr, (bf16*)(wl + WO_IN), 1024, 1280, scr, r / 120, r % 120, F.lane); continue; } r -= I_IN2;
        if (r < I_G) { transpose_item(w_in, IN_COLS, 4656, 3072, nullptr, (bf16*)(wl + WO_G), 1024, 0, scr, r / 96, r % 96, F.lane); continue; } r -= I_G;
        if (r < I_UQ) { transpose_item((const float*)P.in[7] + (size_t)l * 768 * 768, 768, 0, 768, (const float*)P.in[5] + l * 768, (bf16*)(wl + WO_UQ), 768, 0, scr, r / 24, r % 24, F.lane); continue; } r -= I_UQ;
        if (r < I_UKV) { transpose_item((const float*)P.in[8] + (size_t)l * 256 * 1024, 1024, 0, 1024, (const float*)P.in[6] + l * 256, (bf16*)(wl + WO_UKV), 256, 0, scr, r / 32, r % 32, F.lane); continue; } r -= I_UKV;
        if (r < 3 * I_BR) { const int n = r / I_BR; r %= I_BR;
            transpose_item((const float*)P.in[14] + ((size_t)l * 3 + n) * 512 * 1024, 1024, 0, 1024, nullptr, (bf16*)(wl + WO_BR) + (size_t)n * 1024 * 512, 512, 0, scr, r / 32, r % 32, F.lane); continue; } r -= 3 * I_BR;
        if (r < I_OUT) { transpose_item((const float*)P.in[15] + (size_t)l * 1024 * 1024, 1024, 0, 1024, nullptr, (bf16*)(wl + WO_OUT), 1024, 0, scr, r / 32, r % 32, F.lane); continue; } r -= I_OUT;
        transpose_item((const float*)P.in[18] + (size_t)l * 1024 * 2048, 2048, 0, 2048, nullptr, (bf16*)(wl + WO_PQ), 1024, 0, scr, r / 64, r % 64, F.lane);
    }
    const int gt = F.bid * NTHREADS + F.tid, NGT = F.G * NTHREADS;
    for (int i = gt; i < NLAYER * 65536; i += NGT) {
        const int l = i / 65536, e = (i % 65536) * 4;
        const f32x4 v = *(const f32x4*)((const float*)P.in[19] + (size_t)l * 262144 + e);
        u32x2 w; w.x = pk2(v.x, v.y); w.y = pk2(v.z, v.w);
        *(u32x2*)((bf16*)(F.ws + OFF_W + (size_t)l * W_LAYER + WO_SK) + e) = w;
    }
    {
        float* cosA = (float*)(F.ws + OFF_COSA); float* sinA = (float*)(F.ws + OFF_SINA); float* cosB = (float*)(F.ws + OFF_COSB); float* sinB = (float*)(F.ws + OFF_SINB);
        const int* pos = (const int*)P.in[1];
        for (int i = gt; i < MROWS * 24; i += NGT) {
            const int m = i / 24, j = i % 24; const float p = (float)pos[m];
            if (j < 16) { const float inv = powf(500000.0f, -(float)(2 * j) / 32.0f); const float a = p * inv; cosA[m * 16 + j] = cosf(a); sinA[m * 16 + j] = sinf(a); }
            else { const int jj = j - 16; const float inv = powf(500000.0f, -(float)(2 * jj) / 16.0f); const float a = p * inv; cosB[m * 8 + jj] = cosf(a); sinB[m * 8 + jj] = sinf(a); }
        }
    }
    for (int m = gw; m < MROWS; m += NGW)
        ln_row((const float*)P.in[0] + (size_t)m * DM, (const float*)P.in[2], (const float*)P.in[3], (float*)(F.ws + OFF_HF) + (size_t)m * DM, (bf16*)(F.ws + OFF_HB) + (size_t)m * DM, F.lane);
}

__device__ __forceinline__ void peer_tables(const Frame& F, const Params& P, int l) {
    const int gt = F.bid * NTHREADS + F.tid, NGT = F.G * NTHREADS;
    const float* u = (const float*)P.in[20] + (size_t)l * 16384 * 1024; const float* v = (const float*)P.in[21] + (size_t)l * 16384 * 1024;
    bf16* pu = (bf16*)(F.ws + OFF_PU); bf16* pv = (bf16*)(F.ws + OFF_PV);
    for (int i = gt; i < 2 * 2097152; i += NGT) {
        const bool isv = i >= 2097152; const size_t e = (size_t)(isv ? i - 2097152 : i) * 8;
        const float* s = (isv ? v : u) + e; const f32x4 a = *(const f32x4*)s, b = *(const f32x4*)(s + 4);
        u32x4 w; w.x = pk2(a.x, a.y); w.y = pk2(a.z, a.w); w.z = pk2(b.x, b.y); w.w = pk2(b.z, b.w);
        *(u32x4*)((isv ? pv : pu) + e) = w;
    }
}

namespace epi {
using pg8::Unit; using pg8::HALF; using pg8::BM;

struct Proj {
    static constexpr bool PERM = true, AFTER_DRAIN = false;
    bf16* P1; bf16* P2;
    __device__ __forceinline__ void operator()(const f32x4 (&acc)[2][2][4][2], const Unit& u, int wr, int wc, int fr, int fq) const {
        const int row0 = u.pm * BM + wr * 64 + fr;
        bf16* base; int ldc, colt;
        if (u.pn < 5) { base = P1; ldc = P1LD; colt = u.pn * BM; } else { base = P2; ldc = P2LD; colt = (u.pn - 5) * BM; }
        const int col0 = colt + wc * 32 + 8 * fq;
#pragma unroll
        for (int ai = 0; ai < 2; ++ai)
#pragma unroll
            for (int m = 0; m < 4; ++m) { bf16* rowp = base + (size_t)(row0 + ai * HALF + m * 16) * ldc + col0;
#pragma unroll
                for (int bj = 0; bj < 2; ++bj) { const f32x4 v0 = acc[ai][bj][m][0], v1 = acc[ai][bj][m][1];
                    u32x4 w; w.x = pk2(v0[0], v0[1]); w.y = pk2(v0[2], v0[3]); w.z = pk2(v1[0], v1[1]); w.w = pk2(v1[2], v1[3]);
                    *(u32x4*)(rowp + bj * HALF) = w; } }
    }
};
struct Store {
    static constexpr bool PERM = true, AFTER_DRAIN = false;
    bf16* O; int ldc; const float* rs; int rsel;
    __device__ __forceinline__ void operator()(const f32x4 (&acc)[2][2][4][2], const Unit& u, int wr, int wc, int fr, int fq) const {
        const int row0 = u.pm * BM + wr * 64 + fr; const int col0 = u.pn * BM + wc * 32 + 8 * fq;
#pragma unroll
        for (int ai = 0; ai < 2; ++ai)
#pragma unroll
            for (int m = 0; m < 4; ++m) { const int row = row0 + ai * HALF + m * 16; bf16* rowp = O + (size_t)row * ldc + col0;
                const float sc = rs ? rs[(size_t)row * 2 + rsel] : 1.0f;
#pragma unroll
                for (int bj = 0; bj < 2; ++bj) { const f32x4 v0 = acc[ai][bj][m][0] * sc, v1 = acc[ai][bj][m][1] * sc;
                    u32x4 w; w.x = pk2(v0[0], v0[1]); w.y = pk2(v0[2], v0[3]); w.z = pk2(v1[0], v1[1]); w.w = pk2(v1[2], v1[3]);
                    *(u32x4*)(rowp + bj * HALF) = w; } }
    }
};
struct Merge {
    static constexpr bool PERM = true, AFTER_DRAIN = false;
    bf16* MG; const bf16* GLG; const float* gbias;
    __device__ __forceinline__ void operator()(const f32x4 (&acc)[2][2][4][2], const Unit& u, int wr, int wc, int fr, int fq) const {
        const int n = u.tag; const int row0 = u.pm * BM + wr * 64 + fr; const int col0 = (u.pn & 3) * BM + wc * 32 + 8 * fq;
        if (n > 0) asm volatile("s_waitcnt vmcnt(0)" ::: "memory");
#pragma unroll
        for (int ai = 0; ai < 2; ++ai)
#pragma unroll
            for (int m = 0; m < 4; ++m) { const int row = row0 + ai * HALF + m * 16;
#pragma unroll
                for (int bj = 0; bj < 2; ++bj) { const int col = col0 + bj * HALF;
                    const u32x4 gl = *(const u32x4*)(GLG + (size_t)row * 3072 + n * 1024 + col);
                    const f32x4 b0 = *(const f32x4*)(gbias + n * 1024 + col), b1 = *(const f32x4*)(gbias + n * 1024 + col + 4);
                    float g[8]; unpack8(gl, g);
                    float v[8];
                    const f32x4 a0 = acc[ai][bj][m][0], a1 = acc[ai][bj][m][1];
                    v[0] = a0[0] * sigmoidf_(g[0] + b0[0]); v[1] = a0[1] * sigmoidf_(g[1] + b0[1]); v[2] = a0[2] * sigmoidf_(g[2] + b0[2]); v[3] = a0[3] * sigmoidf_(g[3] + b0[3]);
                    v[4] = a1[0] * sigmoidf_(g[4] + b1[0]); v[5] = a1[1] * sigmoidf_(g[5] + b1[1]); v[6] = a1[2] * sigmoidf_(g[6] + b1[2]); v[7] = a1[3] * sigmoidf_(g[7] + b1[3]);
                    bf16* mp = MG + (size_t)row * 1024 + col;
                    if (n > 0) {
                        const unsigned long long p0 = __hip_atomic_load((const unsigned long long*)mp, __ATOMIC_RELAXED, __HIP_MEMORY_SCOPE_AGENT);
                        const unsigned long long p1 = __hip_atomic_load((const unsigned long long*)mp + 1, __ATOMIC_RELAXED, __HIP_MEMORY_SCOPE_AGENT);
                        u32x4 pv; pv.x = (unsigned)p0; pv.y = (unsigned)(p0 >> 32); pv.z = (unsigned)p1; pv.w = (unsigned)(p1 >> 32);
                        float pf[8]; unpack8(pv, pf);
#pragma unroll
                        for (int e = 0; e < 8; ++e) v[e] += pf[e];
                    }
                    *(u32x4*)mp = pack8(v); } }
    }
};
struct OutRes {
    static constexpr bool PERM = true, AFTER_DRAIN = false;
    float* Y; const float* H;
    __device__ __forceinline__ void operator()(const f32x4 (&acc)[2][2][4][2], const Unit& u, int wr, int wc, int fr, int fq) const {
        const int row0 = u.pm * BM + wr * 64 + fr; const int col0 = u.pn * BM + wc * 32 + 8 * fq;
#pragma unroll
        for (int ai = 0; ai < 2; ++ai)
#pragma unroll
            for (int m = 0; m < 4; ++m) { const size_t off = (size_t)(row0 + ai * HALF + m * 16) * 1024 + col0;
#pragma unroll
                for (int bj = 0; bj < 2; ++bj) {
                    const f32x4 h0 = *(const f32x4*)(H + off + bj * HALF), h1 = *(const f32x4*)(H + off + bj * HALF + 4);
                    *(f32x4*)(Y + off + bj * HALF) = h0 * DN_ALPHA + acc[ai][bj][m][0]; *(f32x4*)(Y + off + bj * HALF + 4) = h1 * DN_ALPHA + acc[ai][bj][m][1]; } }
    }
};
struct MergeOrder {
    pg8::StaticOrder so;
    __device__ void init(int G, int c) { so.init(MROWS, 1024, G, c); }
    __device__ bool next(int i, Unit& u) const {
        Unit b; if (!so.next(i / 3, b)) return false; const int n = i % 3;
        u.pm = b.pm; u.pn = 4 * n + b.pn; u.za = 512 * n; u.tag = n; return true;
    }
    __device__ __forceinline__ void a_ready(const Unit&) const {}
    __device__ __forceinline__ void done(const Unit&) const {}
};
}

__device__ __forceinline__ void p2_moba_block(const Frame& F, int u) {
    bf16* P2 = (bf16*)(F.ws + OFF_PROJ2);
    const float* cosB = (const float*)(F.ws + OFF_COSB); const float* sinB = (const float*)(F.ws + OFF_SINB);
    const int c = F.tid & 63, rg = F.tid >> 6;
    const int hh = c >> 3, cc = c & 7;
    float acc[16];
#pragma unroll
    for (int e = 0; e < 16; ++e) acc[e] = 0.f;
    for (int r = rg; r < 256; r += 8) {
        const size_t m = (size_t)u * 256 + r;
        if (cc <= 1) {
            bf16* p = P2 + m * P2LD + (cc == 0 ? C2_MK : C2_MQ) + hh * 64;
            const u32x4 a = *(const u32x4*)p, b = *(const u32x4*)(p + 8);
            float x1[8], x2[8], o1[8], o2[8]; unpack8(a, x1); unpack8(b, x2);
            const f32x4 c0 = *(const f32x4*)(cosB + m * 8), c1 = *(const f32x4*)(cosB + m * 8 + 4), s0 = *(const f32x4*)(sinB + m * 8), s1 = *(const f32x4*)(sinB + m * 8 + 4);
            const float cs[8] = {c0[0], c0[1], c0[2], c0[3], c1[0], c1[1], c1[2], c1[3]}, sn[8] = {s0[0], s0[1], s0[2], s0[3], s1[0], s1[1], s1[2], s1[3]};
#pragma unroll
            for (int e = 0; e < 8; ++e) { o1[e] = x1[e] * cs[e] - x2[e] * sn[e]; o2[e] = x2[e] * cs[e] + x1[e] * sn[e]; }
            const u32x4 w1 = pack8(o1), w2 = pack8(o2);
            *(u32x4*)p = w1; *(u32x4*)(p + 8) = w2;
            if (cc == 0) { float r1[8], r2[8]; unpack8(w1, r1); unpack8(w2, r2);
#pragma unroll
                for (int e = 0; e < 8; ++e) { acc[e] += r1[e]; acc[8 + e] += r2[e]; } }
        } else {
            const u32x4 a = *(const u32x4*)(P2 + m * P2LD + C2_MK + 8 * c);
            float x[8]; unpack8(a, x);
#pragma unroll
            for (int e = 0; e < 8; ++e) acc[e] += x[e];
        }
    }
    LAS float* red = (LAS float*)F.lds;
    __syncthreads();
    if (cc == 0) {
#pragma unroll
        for (int e = 0; e < 16; ++e) red[rg * 512 + hh * 64 + e] = acc[e];
    } else if (cc >= 2) {
#pragma unroll
        for (int e = 0; e < 8; ++e) red[rg * 512 + 8 * c + e] = acc[e];
    }
    __syncthreads();
    {
        float s = 0.f;
#pragma unroll
        for (int g = 0; g < 8; ++g) s += red[g * 512 + F.tid];
        const int b = u >> 3, blk = u & 7, h = F.tid >> 6, d = F.tid & 63;
        ((float*)(F.ws + OFF_KMEAN))[((b * 8 + blk) * 8 + h) * 64 + d] = s * (1.0f / 256.0f);
    }
    __syncthreads();
}

__device__ __forceinline__ void p2_row(const Frame& F, int m) {
    const bf16* P1 = (const bf16*)(F.ws + OFF_PROJ1) + (size_t)m * P1LD;
    const int lane = F.lane;
    float sq = 0.f, skv = 0.f;
    {
        const u32x4 a = *(const u32x4*)(P1 + 8 * lane); float x[8]; unpack8(a, x);
#pragma unroll
        for (int e = 0; e < 8; ++e) sq += x[e] * x[e];
        if (lane < 32) { const u32x4 b = *(const u32x4*)(P1 + 512 + 8 * lane); unpack8(b, x);
#pragma unroll
            for (int e = 0; e < 8; ++e) sq += x[e] * x[e]; }
        else { const u32x4 b = *(const u32x4*)(P1 + 768 + 8 * (lane - 32)); unpack8(b, x);
#pragma unroll
            for (int e = 0; e < 8; ++e) skv += x[e] * x[e]; }
    }
    sq = wave_sum(sq); skv = wave_sum(skv);
    if (lane == 0) { float* rs = (float*)(F.ws + OFF_RSTD) + (size_t)m * 2; rs[0] = 1.0f / sqrtf(sq * (1.0f / 768.0f) + RMS_EPS); rs[1] = 1.0f / sqrtf(skv * (1.0f / 256.0f) + RMS_EPS); }
    if (lane < 16) {
        const float x1 = bf1(P1[1024 + lane]), x2 = bf1(P1[1040 + lane]);
        const float c = ((const float*)(F.ws + OFF_COSA))[(size_t)m * 16 + lane], s = ((const float*)(F.ws + OFF_SINA))[(size_t)m * 16 + lane];
        bf16* kr = (bf16*)(F.ws + OFF_KR) + (size_t)m * 32;
        kr[lane] = (bf16)f2bf(x1 * c - x2 * s); kr[16 + lane] = (bf16)f2bf(x2 * c + x1 * s);
    }
}

template <int I> struct SubstRow {
    static __device__ __forceinline__ void run(float (&t)[64], const LAS float* A, int c) {
        float s0 = (I == c) ? 1.0f : 0.0f, s1 = 0.f, s2 = 0.f, s3 = 0.f;
        const LAS float* row = A + I * 68;
#pragma unroll
        for (int j = 0; j + 3 < I; j += 4) { const f32x4 a = *(const LAS f32x4*)(row + j); s0 -= a[0] * t[j]; s1 -= a[1] * t[j + 1]; s2 -= a[2] * t[j + 2]; s3 -= a[3] * t[j + 3]; }
#pragma unroll
        for (int j = (I / 4) * 4; j < I; ++j) s0 -= row[j] * t[j];
        t[I] = (s0 + s1) + (s2 + s3);
        SubstRow<I + 1>::run(t, A, c);
    }
};
template <> struct SubstRow<64> { static __device__ __forceinline__ void run(float (&)[64], const LAS float*, int) {} };

__device__ __forceinline__ void gdn_chunk_wave(const Frame& F, const Params& P, int l, int ch, LAS float* Asm) {
    const int lane = F.lane, i16 = lane & 15, kq = lane >> 4;
    const int h = ch & 7, c = (ch >> 3) & 31, b = ch >> 8;
    const size_t t0 = (size_t)b * SEQ + c * 64;
    const bf16* P2 = (const bf16*)(F.ws + OFF_PROJ2);
    bf16* G = (bf16*)(F.ws + OFF_GDN) + (size_t)ch * 6 * GDN_MAT;
    const float* convw = (const float*)P.in[9] + (size_t)l * 4 * 1536;
    float g, beta;
    {
        const float ga = bf1(P2[(t0 + lane) * P2LD + C2_GA + h]), gb = bf1(P2[(t0 + lane) * P2LD + C2_GB + h]);
        const float Al = ((const float*)P.in[10])[l * 8 + h], dtb = ((const float*)P.in[11])[l * 8 + h];
        g = -__expf(Al) * softplusf_(ga + dtb); beta = sigmoidf_(gb);
    }
    float gc = g;
#pragma unroll
    for (int o = 1; o < 64; o <<= 1) { const float t = __shfl_up(gc, o); if (lane >= o) gc += t; }
    const float glast = __shfl(gc, 63);
    if (lane == 0) ((float*)(F.ws + OFF_GLS))[ch] = __expf(glast);
    bf16x8 qf[4][2], kf[4][2];
    float gct[4], btk[4];
#pragma unroll
    for (int mt = 0; mt < 4; ++mt) { gct[mt] = __shfl(gc, 16 * mt + i16); btk[mt] = __shfl(beta, 16 * mt + i16); }
    float ssq_q[4], ssq_k[4];
#pragma unroll
    for (int mt = 0; mt < 4; ++mt) { ssq_q[mt] = 0.f; ssq_k[mt] = 0.f; }
    LAS u32x4* raw = (LAS u32x4*)Asm;
#pragma unroll 1
    for (int blk = 0; blk < 6; ++blk) {
        const int w3 = blk >> 1, ks = blk & 1;
        const int c0 = 32 * ks + 8 * kq;
        const int pcol = C2_GQ + w3 * 512 + h * 64 + c0, wcol = w3 * 512 + h * 64 + c0;
        float wt[4][8];
#pragma unroll
        for (int j = 0; j < 4; ++j) { const f32x4 w0 = *(const f32x4*)(convw + j * 1536 + wcol), w1 = *(const f32x4*)(convw + j * 1536 + wcol + 4);
            wt[j][0] = w0[0]; wt[j][1] = w0[1]; wt[j][2] = w0[2]; wt[j][3] = w0[3]; wt[j][4] = w1[0]; wt[j][5] = w1[1]; wt[j][6] = w1[2]; wt[j][7] = w1[3]; }
#pragma unroll
        for (int mt = 0; mt < 4; ++mt) {
            const int tok = 16 * mt + i16;
            float a8[8];
#pragma unroll
            for (int e = 0; e < 8; ++e) a8[e] = 0.f;
#pragma unroll
            for (int j = 0; j < 4; ++j) {
                const int s = c * 64 + tok - 3 + j;
                u32x4 xv = (u32x4){0u, 0u, 0u, 0u};
                if (s >= 0) xv = *(const u32x4*)(P2 + ((size_t)b * SEQ + s) * P2LD + pcol);
                float x[8]; unpack8(xv, x);
#pragma unroll
                for (int e = 0; e < 8; ++e) a8[e] += x[e] * wt[j][e];
            }
#pragma unroll
            for (int e = 0; e < 8; ++e) a8[e] = siluf_(a8[e]);
            if (w3 == 2) {
#pragma unroll
                for (int e = 0; e < 8; ++e) G[3 * GDN_MAT + (c0 + e) * 64 + tok] = (bf16)f2bf(a8[e] * btk[mt]);
            } else {
                float ss = 0.f;
#pragma unroll
                for (int e = 0; e < 8; ++e) ss += a8[e] * a8[e];
                ssq_q[mt] += (w3 == 0) ? ss : 0.f; ssq_k[mt] += (w3 == 1) ? ss : 0.f;
                raw[((w3 * 4 + mt) * 2 + ks) * 64 + lane] = pack8(a8);
            }
        }
    }
    LDS_WAIT(); asm volatile("" ::: "memory");
#pragma unroll
    for (int mt = 0; mt < 4; ++mt) {
        const int tok = 16 * mt + i16;
        float sq = ssq_q[mt], sk = ssq_k[mt];
        sq += __shfl_xor(sq, 16); sq += __shfl_xor(sq, 32); sk += __shfl_xor(sk, 16); sk += __shfl_xor(sk, 32);
        const float rq = 0.125f / sqrtf(sq + RMS_EPS), rk = 1.0f / sqrtf(sk + RMS_EPS);
        const float eg = __expf(gct[mt]), ed = __expf(glast - gct[mt]), bt = btk[mt];
#pragma unroll
        for (int ks = 0; ks < 2; ++ks) {
            const int c0 = 32 * ks + 8 * kq;
            float q[8], k[8], tq[8], tk[8];
            unpack8(raw[((0 * 4 + mt) * 2 + ks) * 64 + lane], q); unpack8(raw[((1 * 4 + mt) * 2 + ks) * 64 + lane], k);
#pragma unroll
            for (int e = 0; e < 8; ++e) { q[e] *= rq; k[e] *= rk; }
            qf[mt][ks] = __builtin_bit_cast(bf16x8, pack8(q)); kf[mt][ks] = __builtin_bit_cast(bf16x8, pack8(k));
#pragma unroll
            for (int e = 0; e < 8; ++e) { tq[e] = q[e] * eg; tk[e] = -k[e] * bt * eg; }
            *(u32x4*)(G + 0 * GDN_MAT + tok * 64 + c0) = pack8(tq);
            *(u32x4*)(G + 1 * GDN_MAT + tok * 64 + c0) = pack8(tk);
#pragma unroll
            for (int e = 0; e < 8; ++e) G[2 * GDN_MAT + (c0 + e) * 64 + tok] = (bf16)f2bf(k[e] * ed);
        }
    }
    LDS_WAIT(); asm volatile("" ::: "memory");
#pragma unroll
    for (int mt = 0; mt < 4; ++mt) {
        const int i = 16 * mt + i16; const float bti = __shfl(beta, i);
#pragma unroll
        for (int nt = 0; nt < 4; ++nt) {
            f32x4 sqk = {0.f, 0.f, 0.f, 0.f}, skk = {0.f, 0.f, 0.f, 0.f};
            if (nt <= mt) {
#pragma unroll
                for (int ks = 0; ks < 2; ++ks) {
                    sqk = __builtin_amdgcn_mfma_f32_16x16x32_bf16(kf[nt][ks], qf[mt][ks], sqk, 0, 0, 0);
                    skk = __builtin_amdgcn_mfma_f32_16x16x32_bf16(kf[nt][ks], kf[mt][ks], skk, 0, 0, 0);
                }
            }
            float oq[4], oa[4];
#pragma unroll
            for (int r = 0; r < 4; ++r) {
                const int j = 16 * nt + 4 * kq + r; const float gcj = __shfl(gc, j);
                const float dec = (j <= i) ? __expf(gct[mt] - gcj) : 0.f;
                oq[r] = sqk[r] * dec; oa[r] = (j < i) ? skk[r] * dec * bti : 0.f;
            }
            u32x2 w; w.x = pk2(oq[0], oq[1]); w.y = pk2(oq[2], oq[3]);
            *(u32x2*)(G + 5 * GDN_MAT + i * 64 + 16 * nt + 4 * kq) = w;
            *(LAS f32x4*)(Asm + i * 68 + 16 * nt + 4 * kq) = (f32x4){oa[0], oa[1], oa[2], oa[3]};
        }
    }
    LDS_WAIT(); asm volatile("" ::: "memory");
#ifndef NO_SUBST
    float t[64];
    SubstRow<0>::run(t, Asm, lane);
#pragma unroll
    for (int i = 0; i < 64; ++i) G[4 * GDN_MAT + i * 64 + lane] = (bf16)f2bf(t[i]);
#endif
    LDS_WAIT(); asm volatile("" ::: "memory");
}

__device__ __forceinline__ void p2_phase(const Frame& F, const Params& P, int l) {
    if (F.bid < 64) p2_moba_block(F, F.bid);
    const int gw = ((F.bid + F.G - 64) % F.G) * NWAVES + F.wave, NGW = F.G * NWAVES;
    for (int m = gw; m < MROWS; m += NGW) p2_row(F, m);
    LAS float* Asm = (LAS float*)(F.lds + F.wave * 17408);
    for (int ch = gw; ch < 2048; ch += NGW) gdn_chunk_wave(F, P, l, ch, Asm);
}

typedef short v4i16_t __attribute__((ext_vector_type(4)));
__device__ __forceinline__ s16x4 ds_tr16(const LAS bf16* p) { return __builtin_bit_cast(s16x4, __builtin_amdgcn_ds_read_tr16_b64_v4i16((LAS v4i16_t*)p)); }
__device__ __forceinline__ int crow(int r, int hi) { return (r & 3) + 8 * (r >> 2) + 4 * hi; }

template <int DK, bool MOBA>
__device__ __forceinline__ void attn_unit(const Frame& F, int b, int h, int qb) {
    constexpr int KSTR = (DK == 96) ? 104 : 72;
    constexpr int VSTR = 96;
    constexpr int BUF = 64 * KSTR + 64 * VSTR;
    constexpr int NS = DK / 16;
    const int tid = F.tid, lane = F.lane, w = F.wave, ql = lane & 31, hh = lane >> 5;
    LAS bf16* L = (LAS bf16*)F.lds;
    const bf16* Qs; const bf16* Ks; const bf16* Vs; int ldq, ldk; float scale;
    if (MOBA) { const bf16* P2 = (const bf16*)(F.ws + OFF_PROJ2); Qs = P2 + C2_MQ + h * 64; Ks = P2 + C2_MK + h * 64; Vs = P2 + C2_MV + h * 64; ldq = P2LD; ldk = P2LD; scale = 0.125f * 1.4426950408889634f; }
    else { Qs = (const bf16*)(F.ws + OFF_QMLA) + h * 96; const bf16* KV = (const bf16*)(F.ws + OFF_KVMLA) + h * 128; Ks = KV; Vs = KV + 64; ldq = 768; ldk = 1024; scale = 0.10206207261596575f * 1.4426950408889634f; }
    const bf16* KR = (const bf16*)(F.ws + OFF_KR);
    const size_t mb = (size_t)b * SEQ;
    const size_t mq = mb + qb * 256 + w * 32 + ql;

    unsigned selbits = 0;
    if (MOBA) {
        if (qb <= 3) selbits = (1u << qb) - 1u;
        else {
            LAS float* kml = (LAS float*)(F.lds + 2 * BUF * 2);
            __syncthreads();
            if (tid < qb * 64) kml[tid] = ((const float*)(F.ws + OFF_KMEAN))[((b * 8 + (tid >> 6)) * 8 + h) * 64 + (tid & 63)];
            __syncthreads();
            float qv[64];
#pragma unroll
            for (int c8 = 0; c8 < 8; ++c8) { const u32x4 a = *(const u32x4*)(Qs + mq * ldq + 8 * c8); unpack8(a, qv + 8 * c8); }
            float g0 = -3e38f, g1 = -3e38f, g2 = -3e38f; int i0 = 0, i1 = 0, i2 = 0;
            for (int j = 0; j < qb; ++j) {
                float s = 0.f;
#pragma unroll
                for (int d = 0; d < 64; ++d) s += qv[d] * kml[j * 64 + d];
                if (s > g0) { g2 = g1; i2 = i1; g1 = g0; i1 = i0; g0 = s; i0 = j; }
                else if (s > g1) { g2 = g1; i2 = i1; g1 = s; i1 = j; }
                else if (s > g2) { g2 = s; i2 = j; }
            }
            selbits = (1u << i0) | (1u << i1) | (1u << i2);
        }
    }
    bf16x8 qf[NS];
    {
        float qx[NS][8];
#pragma unroll
        for (int s = 0; s < NS; ++s) { const u32x4 a = *(const u32x4*)(Qs + mq * ldq + 16 * s + 8 * hh); unpack8(a, qx[s]); }
        if (!MOBA) {
            const float* cp = (const float*)(F.ws + OFF_COSA) + mq * 16 + 8 * hh; const float* sp = (const float*)(F.ws + OFF_SINA) + mq * 16 + 8 * hh;
            const f32x4 c0 = *(const f32x4*)cp, c1 = *(const f32x4*)(cp + 4), s0 = *(const f32x4*)sp, s1 = *(const f32x4*)(sp + 4);
            const float cs[8] = {c0[0], c0[1], c0[2], c0[3], c1[0], c1[1], c1[2], c1[3]}, sn[8] = {s0[0], s0[1], s0[2], s0[3], s1[0], s1[1], s1[2], s1[3]};
#pragma unroll
            for (int e = 0; e < 8; ++e) { const float x1 = qx[NS - 2][e], x2 = qx[NS - 1][e]; qx[NS - 2][e] = x1 * cs[e] - x2 * sn[e]; qx[NS - 1][e] = x2 * cs[e] + x1 * sn[e]; }
        }
#pragma unroll
        for (int s = 0; s < NS; ++s) {
#pragma unroll
            for (int e = 0; e < 8; ++e) qx[s][e] *= scale;
            qf[s] = __builtin_bit_cast(bf16x8, pack8(qx[s]));
        }
    }
    const int skr = tid >> 3, sc8 = tid & 7;
    const int rkr = tid >> 2, rc4 = tid & 3;
    const int ntile = 4 * (qb + 1);
    auto tile_of = [&](int it) -> int { return MOBA ? (it < 4 ? 4 * qb + it : it - 4) : it; };
    u32x4 rk, rv, rr;
    auto gload = [&](int t) {
        const size_t kb = mb + (size_t)t * 64;
        rk = *(const u32x4*)(Ks + (kb + skr) * ldk + 8 * sc8);
        rv = *(const u32x4*)(Vs + (kb + skr) * ldk + 8 * sc8);
        if (DK == 96 && tid < 256) rr = *(const u32x4*)(KR + (kb + rkr) * 32 + 8 * rc4);
    };
    auto lstore = [&](int buf) {
        LAS bf16* Kt = L + buf * BUF; LAS bf16* Vt = Kt + 64 * KSTR;
        *(LAS u32x4*)(Kt + skr * KSTR + 8 * sc8) = rk;
        *(LAS u32x4*)(Vt + skr * VSTR + 8 * sc8) = rv;
        if (DK == 96 && tid < 256) *(LAS u32x4*)(Kt + rkr * KSTR + 64 + 8 * rc4) = rr;
    };
    float mrun = -1e30f, lrun = 0.f;
    f32x16 o0 = {}, o1 = {};
    __syncthreads();
    gload(tile_of(0)); lstore(0);
    __syncthreads();
    for (int it = 0; it < ntile; ++it) {
        const int t = tile_of(it);
        if (it + 1 < ntile) gload(tile_of(it + 1));
        const bool diag = t >= 4 * qb; const int tb = t - 4 * qb;
        bool active = true;
        if (diag) active = tb <= (w >> 1);
        bool rowsel = true;
        if (MOBA && !diag) { rowsel = (selbits >> (t >> 2)) & 1u; active = __any(rowsel) != 0; }
        if (active) {
            const LAS bf16* Kt = L + (it & 1) * BUF; const LAS bf16* Vt = Kt + 64 * KSTR;
            f32x16 p0 = {}, p1 = {};
#pragma unroll
            for (int s = 0; s < NS; ++s) {
                const bf16x8 a0 = *(const LAS bf16x8*)(Kt + ql * KSTR + 16 * s + 8 * hh);
                const bf16x8 a1 = *(const LAS bf16x8*)(Kt + (32 + ql) * KSTR + 16 * s + 8 * hh);
                p0 = __builtin_amdgcn_mfma_f32_32x32x16_bf16(a0, qf[s], p0, 0, 0, 0);
                p1 = __builtin_amdgcn_mfma_f32_32x32x16_bf16(a1, qf[s], p1, 0, 0, 0);
            }
            if (diag) {
                const int qloc = 32 * w + ql;
#pragma unroll
                for (int r = 0; r < 16; ++r) { const int kl = 64 * tb + crow(r, hh); if (kl > qloc) p0[r] = -1e30f; if (kl + 32 > qloc) p1[r] = -1e30f; }
            }
            if (MOBA && !diag && !rowsel) {
#pragma unroll
                for (int r = 0; r < 16; ++r) { p0[r] = -1e30f; p1[r] = -1e30f; }
            }
            float mx = p0[0];
#pragma unroll
            for (int r = 1; r < 16; ++r) mx = fmaxf(mx, p0[r]);
#pragma unroll
            for (int r = 0; r < 16; ++r) mx = fmaxf(mx, p1[r]);
            mx = fmaxf(mx, __shfl_xor(mx, 32));
            const float mnew = fmaxf(mrun, mx);
            const float alpha = __builtin_amdgcn_exp2f(mrun - mnew);
            mrun = mnew;
            float ps = 0.f;
#pragma unroll
            for (int r = 0; r < 16; ++r) { p0[r] = __builtin_amdgcn_exp2f(p0[r] - mnew); p1[r] = __builtin_amdgcn_exp2f(p1[r] - mnew); ps += p0[r] + p1[r]; }
            lrun = lrun * alpha + ps;
#pragma unroll
            for (int r = 0; r < 16; ++r) { o0[r] *= alpha; o1[r] *= alpha; }
            bf16x8 pf[4];
            { float tmp[8];
#pragma unroll
              for (int e = 0; e < 8; ++e) tmp[e] = p0[e];
              pf[0] = __builtin_bit_cast(bf16x8, pack8(tmp));
#pragma unroll
              for (int e = 0; e < 8; ++e) tmp[e] = p0[8 + e];
              pf[1] = __builtin_bit_cast(bf16x8, pack8(tmp));
#pragma unroll
              for (int e = 0; e < 8; ++e) tmp[e] = p1[e];
              pf[2] = __builtin_bit_cast(bf16x8, pack8(tmp));
#pragma unroll
              for (int e = 0; e < 8; ++e) tmp[e] = p1[8 + e];
              pf[3] = __builtin_bit_cast(bf16x8, pack8(tmp)); }
            const int i15 = lane & 15, dblk = (lane >> 4) & 1;
#pragma unroll
            for (int s4 = 0; s4 < 4; ++s4) {
                const int key0 = 16 * s4 + 4 * hh;
#pragma unroll
                for (int dt = 0; dt < 2; ++dt) {
                    const LAS bf16* va = Vt + (key0 + (i15 >> 2)) * VSTR + 32 * dt + 16 * dblk + 4 * (i15 & 3);
                    const s16x4 lo = ds_tr16(va), hi2 = ds_tr16(va + 8 * VSTR);
                    const bf16x8 vf = (bf16x8){lo[0], lo[1], lo[2], lo[3], hi2[0], hi2[1], hi2[2], hi2[3]};
                    if (dt == 0) o0 = __builtin_amdgcn_mfma_f32_32x32x16_bf16(vf, pf[s4], o0, 0, 0, 0);
                    else o1 = __builtin_amdgcn_mfma_f32_32x32x16_bf16(vf, pf[s4], o1, 0, 0, 0);
                }
            }
        }
        if (it + 1 < ntile) lstore((it + 1) & 1);
        __syncthreads();
    }
    const float ltot = lrun + __shfl_xor(lrun, 32);
    const float inv = 1.0f / ltot;
    bf16* op = (bf16*)(F.ws + OFF_BR) + mq * BRLD + (MOBA ? 512 : 0) + h * 64;
#pragma unroll
    for (int g = 0; g < 4; ++g) {
        u32x2 w0, w1;
        w0.x = pk2(o0[4 * g] * inv, o0[4 * g + 1] * inv); w0.y = pk2(o0[4 * g + 2] * inv, o0[4 * g + 3] * inv);
        w1.x = pk2(o1[4 * g] * inv, o1[4 * g + 1] * inv); w1.y = pk2(o1[4 * g + 2] * inv, o1[4 * g + 3] * inv);
        *(u32x2*)(op + 8 * g + 4 * hh) = w0; *(u32x2*)(op + 32 + 8 * g + 4 * hh) = w1;
    }
}

__device__ __forceinline__ void gdn_scan_unit(const Frame& F, const Params& P, int l, int b, int h) {
    constexpr int BSTR = 72;
    constexpr int OSTR = 68;
    const int lane = F.lane, w = F.wave, i16 = lane & 15, kq = lane >> 4;
    LAS bf16* Sb = (LAS bf16*)F.lds;
    LAS bf16* XT = Sb + 64 * BSTR;
    LAS bf16* VT = XT + 64 * BSTR;
    LAS float* Ob = (LAS float*)(F.lds + 3 * 64 * BSTR * 2);
    const bf16* Gb = (const bf16*)(F.ws + OFF_GDN);
    const float* gls = (const float*)(F.ws + OFF_GLS);
    const bf16* P2 = (const bf16*)(F.ws + OFF_PROJ2);
    bf16* BR = (bf16*)(F.ws + OFF_BR);
    const float* onorm = (const float*)P.in[12] + l * 64;
    __syncthreads();
    f32x4 Sacc[4];
#pragma unroll
    for (int m = 0; m < 4; ++m) Sacc[m] = (f32x4){0.f, 0.f, 0.f, 0.f};
    if (w < 4) {
#pragma unroll
        for (int m = 0; m < 4; ++m) *(LAS u32x2*)(Sb + (16 * w + i16) * BSTR + 16 * m + 4 * kq) = (u32x2){0u, 0u};
    }
    for (int c = 0; c <= 32; ++c) {
        if (w < 4 && c < 32) {
            const int ch = (b * 32 + c) * 8 + h;
            const bf16* G = Gb + (size_t)ch * 6 * GDN_MAT;
            const float gl = ld_coh_f32((float*)gls + ch);
            const int dvr = 16 * w + i16;
#define AFRAG(mat, mt, ks) (*(const bf16x8*)(G + (mat) * GDN_MAT + (16 * (mt) + i16) * 64 + 32 * (ks) + 8 * kq))
#define BFRAG(img, ks) (*(const LAS bf16x8*)((img) + dvr * BSTR + 32 * (ks) + 8 * kq))
            f32x4 acc[4];
#pragma unroll
            for (int m = 0; m < 4; ++m) { const u32x2 vb = *(const u32x2*)(G + 3 * GDN_MAT + dvr * 64 + 16 * m + 4 * kq); acc[m] = (f32x4){bflo(vb.x), bfhi(vb.x), bflo(vb.y), bfhi(vb.y)}; }
            {
                const bf16x8 s0 = BFRAG(Sb, 0), s1 = BFRAG(Sb, 1);
#pragma unroll
                for (int m = 0; m < 4; ++m) { acc[m] = __builtin_amdgcn_mfma_f32_16x16x32_bf16(AFRAG(1, m, 0), s0, acc[m], 0, 0, 0); acc[m] = __builtin_amdgcn_mfma_f32_16x16x32_bf16(AFRAG(1, m, 1), s1, acc[m], 0, 0, 0); }
                f32x4 oacc[4];
#pragma unroll
                for (int m = 0; m < 4; ++m) { oacc[m] = __builtin_amdgcn_mfma_f32_16x16x32_bf16(AFRAG(0, m, 0), s0, (f32x4){0.f, 0.f, 0.f, 0.f}, 0, 0, 0); oacc[m] = __builtin_amdgcn_mfma_f32_16x16x32_bf16(AFRAG(0, m, 1), s1, oacc[m], 0, 0, 0); }
#pragma unroll
                for (int m = 0; m < 4; ++m) { u32x2 wv; wv.x = pk2(acc[m][0], acc[m][1]); wv.y = pk2(acc[m][2], acc[m][3]); *(LAS u32x2*)(XT + dvr * BSTR + 16 * m + 4 * kq) = wv; }
                const bf16x8 x0 = BFRAG(XT, 0), x1 = BFRAG(XT, 1);
#pragma unroll
                for (int m = 0; m < 4; ++m) { acc[m] = __builtin_amdgcn_mfma_f32_16x16x32_bf16(AFRAG(4, m, 0), x0, (f32x4){0.f, 0.f, 0.f, 0.f}, 0, 0, 0); acc[m] = __builtin_amdgcn_mfma_f32_16x16x32_bf16(AFRAG(4, m, 1), x1, acc[m], 0, 0, 0); }
#pragma unroll
                for (int m = 0; m < 4; ++m) { u32x2 wv; wv.x = pk2(acc[m][0], acc[m][1]); wv.y = pk2(acc[m][2], acc[m][3]); *(LAS u32x2*)(VT + dvr * BSTR + 16 * m + 4 * kq) = wv; }
                const bf16x8 v0 = BFRAG(VT, 0), v1 = BFRAG(VT, 1);
#pragma unroll
                for (int m = 0; m < 4; ++m) { oacc[m] = __builtin_amdgcn_mfma_f32_16x16x32_bf16(AFRAG(5, m, 0), v0, oacc[m], 0, 0, 0); oacc[m] = __builtin_amdgcn_mfma_f32_16x16x32_bf16(AFRAG(5, m, 1), v1, oacc[m], 0, 0, 0); }
                LAS float* Oc = Ob + (c & 1) * 64 * OSTR;
#pragma unroll
                for (int m = 0; m < 4; ++m)
#pragma unroll
                    for (int r = 0; r < 4; ++r) Oc[(16 * m + 4 * kq + r) * OSTR + dvr] = oacc[m][r];
#pragma unroll
                for (int m = 0; m < 4; ++m) { Sacc[m] = Sacc[m] * gl; Sacc[m] = __builtin_amdgcn_mfma_f32_16x16x32_bf16(AFRAG(2, m, 0), v0, Sacc[m], 0, 0, 0); Sacc[m] = __builtin_amdgcn_mfma_f32_16x16x32_bf16(AFRAG(2, m, 1), v1, Sacc[m], 0, 0, 0); }
#pragma unroll
                for (int m = 0; m < 4; ++m) { u32x2 wv; wv.x = pk2(Sacc[m][0], Sacc[m][1]); wv.y = pk2(Sacc[m][2], Sacc[m][3]); *(LAS u32x2*)(Sb + dvr * BSTR + 16 * m + 4 * kq) = wv; }
            }
#undef AFRAG
#undef BFRAG
        }
        if (w >= 4 && c >= 1) {
            const int cc = c - 1; const LAS float* Oc = Ob + (cc & 1) * 64 * OSTR;
            const int tok = 16 * (w - 4) + i16; const size_t m = (size_t)b * SEQ + cc * 64 + tok;
            float o[16];
#pragma unroll
            for (int q4 = 0; q4 < 4; ++q4) { const f32x4 v = *(const LAS f32x4*)(Oc + tok * OSTR + 16 * kq + 4 * q4); o[4 * q4] = v[0]; o[4 * q4 + 1] = v[1]; o[4 * q4 + 2] = v[2]; o[4 * q4 + 3] = v[3]; }
            float ss = 0.f;
#pragma unroll
            for (int e = 0; e < 16; ++e) ss += o[e] * o[e];
            ss += __shfl_xor(ss, 16); ss += __shfl_xor(ss, 32);
            const float rs = 1.0f / sqrtf(ss * (1.0f / 64.0f) + RMS_EPS);
            const bf16* zp = P2 + m * P2LD + C2_GZ + h * 64 + 16 * kq;
            float z[16]; unpack8(*(const u32x4*)zp, z); unpack8(*(const u32x4*)(zp + 8), z + 8);
            float r16[16];
#pragma unroll
            for (int e = 0; e < 16; ++e) r16[e] = o[e] * rs * onorm[16 * kq + e] * siluf_(z[e]);
            bf16* op = BR + m * BRLD + 1024 + h * 64 + 16 * kq;
            *(u32x4*)op = pack8(r16); *(u32x4*)(op + 8) = pack8(r16 + 8);
        }
        __syncthreads();
    }
}

__device__ __forceinline__ unsigned f2key(float f) { unsigned u = __builtin_bit_cast(unsigned, f); return (u & 0x80000000u) ? ~u : (u | 0x80000000u); }
__device__ __forceinline__ float key2f(unsigned k) { const unsigned u = (k & 0x80000000u) ? (k & 0x7fffffffu) : ~k; return __builtin_bit_cast(float, u); }

__device__ __forceinline__ void peer_topk_unit(const Frame& F, int l, int tt) {
    const int lane = F.lane, h = F.wave, tk = lane & 31, hh = lane >> 5;
    const size_t m = (size_t)tt * 32 + tk;
    const bf16* QRY = (const bf16*)(F.ws + OFF_QRY);
    const bf16* SK = (const bf16*)(F.ws + OFF_W + (size_t)l * W_LAYER + WO_SK);
    LAS int* li = (LAS int*)F.lds + F.tid * 33;
    unsigned top[2][16];
#pragma unroll
    for (int p = 0; p < 2; ++p) {
        bf16x8 qf[8];
#pragma unroll
        for (int s = 0; s < 8; ++s) qf[s] = *(const bf16x8*)(QRY + m * 2048 + (2 * h + p) * 128 + 16 * s + 8 * hh);
        unsigned key[64];
#pragma unroll
        for (int kt = 0; kt < 4; ++kt) {
            f32x16 acc = {};
            const bf16* kp = SK + ((size_t)(h * 2 + p) * 128 + 32 * kt + tk) * 128 + 8 * hh;
#pragma unroll
            for (int s = 0; s < 8; ++s) acc = __builtin_amdgcn_mfma_f32_32x32x16_bf16(*(const bf16x8*)(kp + 16 * s), qf[s], acc, 0, 0, 0);
#pragma unroll
            for (int r = 0; r < 16; ++r) { const int kidx = 32 * kt + crow(r, hh); key[16 * kt + r] = (f2key(acc[r]) & ~0x7fu) | (unsigned)(127 - kidx); }
        }
#pragma unroll
        for (int rd = 0; rd < 16; ++rd) {
            unsigned mx = key[0];
#pragma unroll
            for (int e = 1; e < 64; ++e) mx = mx > key[e] ? mx : key[e];
            const unsigned ox = (unsigned)__shfl_xor((int)mx, 32);
            mx = mx > ox ? mx : ox;
            top[p][rd] = mx;
#pragma unroll
            for (int e = 0; e < 64; ++e) key[e] = (key[e] == mx) ? 0u : key[e];
        }
    }
    float v1[16], v2[16];
#pragma unroll
    for (int a = 0; a < 16; ++a) { li[a] = 127 - (int)(top[0][a] & 0x7fu); li[16 + a] = 127 - (int)(top[1][a] & 0x7fu); v1[a] = key2f(top[0][a] & ~0x7fu); v2[a] = key2f(top[1][a] & ~0x7fu); }
    unsigned ck[25];
#pragma unroll
    for (int e = 0; e < 25; ++e) ck[e] = 0u;
    {
        int n = 0;
#pragma unroll
        for (int a = 0; a < 16; ++a)
#pragma unroll
            for (int bb = 0; bb < 16; ++bb)
                if ((a + 1) * (bb + 1) <= 16) {
                    const int slot = n % 25, owner = n / 25;
                    const unsigned kv = (f2key(v1[a] + v2[bb]) & ~0xffu) | (unsigned)(255 - (16 * a + bb));
                    if (owner == 0) ck[slot] = (hh == 0) ? kv : ck[slot]; else ck[slot] = (hh == 1) ? kv : ck[slot];
                    ++n;
                }
    }
    unsigned win[16];
#pragma unroll
    for (int rd = 0; rd < 16; ++rd) {
        unsigned mx = ck[0];
#pragma unroll
        for (int e = 1; e < 25; ++e) mx = mx > ck[e] ? mx : ck[e];
        const unsigned ox = (unsigned)__shfl_xor((int)mx, 32);
        mx = mx > ox ? mx : ox;
        win[rd] = mx;
#pragma unroll
        for (int e = 0; e < 25; ++e) ck[e] = (ck[e] == mx) ? 0u : ck[e];
    }
    LDS_WAIT();
    float sv[16]; int ids[16];
#pragma unroll
    for (int rd = 0; rd < 16; ++rd) {
        const int flat = 255 - (int)(win[rd] & 0xffu), a = flat >> 4, bb = flat & 15;
        const int ia = li[a], ib = li[16 + bb];
        ids[rd] = ia * 128 + ib;
        float sa = 0.f, sb = 0.f;
#pragma unroll
        for (int e = 0; e < 16; ++e) { sa = (e == a) ? v1[e] : sa; sb = (e == bb) ? v2[e] : sb; }
        sv[rd] = sa + sb;
    }
    float mxv = sv[0];
#pragma unroll
    for (int e = 1; e < 16; ++e) mxv = fmaxf(mxv, sv[e]);
    float den = 0.f;
#pragma unroll
    for (int e = 0; e < 16; ++e) { sv[e] = __expf(sv[e] - mxv); den += sv[e]; }
    const float inv = 1.0f / den;
    if (hh == 0) { int* ip = (int*)(F.ws + OFF_IDX) + m * 128 + h * 16;
#pragma unroll
        for (int q4 = 0; q4 < 4; ++q4) *(u32x4*)(ip + 4 * q4) = (u32x4){(unsigned)ids[4 * q4], (unsigned)ids[4 * q4 + 1], (unsigned)ids[4 * q4 + 2], (unsigned)ids[4 * q4 + 3]}; }
    else { float* gp = (float*)(F.ws + OFF_GATE) + m * 128 + h * 16;
#pragma unroll
        for (int q4 = 0; q4 < 4; ++q4) *(f32x4*)(gp + 4 * q4) = (f32x4){sv[4 * q4] * inv, sv[4 * q4 + 1] * inv, sv[4 * q4 + 2] * inv, sv[4 * q4 + 3] * inv}; }
    LDS_WAIT();
}

__device__ __forceinline__ float gelu_exact(float x) { return 0.5f * x * (1.0f + erff(x * 0.7071067811865475f)); }
__device__ __forceinline__ float dot8(const u32x4 a, const u32x4 b) {
    float s = bflo(a.x) * bflo(b.x); s += bfhi(a.x) * bfhi(b.x); s += bflo(a.y) * bflo(b.y); s += bfhi(a.y) * bfhi(b.y);
    s += bflo(a.z) * bflo(b.z); s += bfhi(a.z) * bfhi(b.z); s += bflo(a.w) * bflo(b.w); s += bfhi(a.w) * bfhi(b.w); return s;
}
__device__ __forceinline__ void axpy8(float* o, float w, const u32x4 v) {
    o[0] += w * bflo(v.x); o[1] += w * bfhi(v.x); o[2] += w * bflo(v.y); o[3] += w * bfhi(v.y); o[4] += w * bflo(v.z); o[5] += w * bfhi(v.z); o[6] += w * bflo(v.w); o[7] += w * bfhi(v.w);
}
__device__ __forceinline__ void peer_token(const Frame& F, const Params& P, int l, size_t m, bool last_layer, bool en_peer) {
    const int lane = F.lane;
    const bf16* PU = (const bf16*)(F.ws + OFF_PU); const bf16* PV = (const bf16*)(F.ws + OFF_PV);
    const bf16* hb = (const bf16*)(F.ws + OFF_HB) + m * DM;
    float* hf = (float*)(F.ws + OFF_HF) + m * DM;
    const u32x4 xa = *(const u32x4*)(hb + 8 * lane), xb = *(const u32x4*)(hb + 512 + 8 * lane);
    const int id0 = ((const int*)(F.ws + OFF_IDX))[m * 128 + lane], id1 = ((const int*)(F.ws + OFF_IDX))[m * 128 + 64 + lane];
    const float g0 = ((const float*)(F.ws + OFF_GATE))[m * 128 + lane], g1 = ((const float*)(F.ws + OFF_GATE))[m * 128 + 64 + lane];
    float out[16];
#pragma unroll
    for (int e = 0; e < 16; ++e) out[e] = 0.f;
    const int jl = ((lane >> 5) & 1) * 4 + ((lane >> 4) & 1) * 2 + ((lane >> 3) & 1);
#pragma unroll 1
    for (int bt = 0; bt < (en_peer ? 16 : 0); ++bt) {
        u32x4 ua[8], ub[8], va[8], vb[8];
#pragma unroll
        for (int j = 0; j < 8; ++j) {
            const int e = 8 * bt + j;
            const int id = __builtin_amdgcn_readlane(bt < 8 ? id0 : id1, e & 63);
            const bf16* up = PU + (size_t)id * 1024 + 8 * lane; const bf16* vp = PV + (size_t)id * 1024 + 8 * lane;
            ua[j] = *(const u32x4*)up; ub[j] = *(const u32x4*)(up + 512); va[j] = *(const u32x4*)vp; vb[j] = *(const u32x4*)(vp + 512);
        }
        float p[8];
#pragma unroll
        for (int j = 0; j < 8; ++j) p[j] = dot8(ua[j], xa) + dot8(ub[j], xb);
#pragma unroll
        for (int j = 0; j < 4; ++j) { const bool up_ = (lane & 32) != 0; const float send = up_ ? p[j] : p[j + 4]; const float recv = __shfl_xor(send, 32); p[j] = (up_ ? p[j + 4] : p[j]) + recv; }
#pragma unroll
        for (int j = 0; j < 2; ++j) { const bool up_ = (lane & 16) != 0; const float send = up_ ? p[j] : p[j + 2]; const float recv = __shfl_xor(send, 16); p[j] = (up_ ? p[j + 2] : p[j]) + recv; }
        { const bool up_ = (lane & 8) != 0; const float send = up_ ? p[0] : p[1]; const float recv = __shfl_xor(send, 8); p[0] = (up_ ? p[1] : p[0]) + recv; }
        float d = p[0]; d += __shfl_xor(d, 4); d += __shfl_xor(d, 2); d += __shfl_xor(d, 1);
        const int esel = 8 * bt + jl;
        const float gsel = __shfl(bt < 8 ? g0 : g1, esel & 63);
        const float wsel = gelu_exact(d) * gsel;
#pragma unroll
        for (int j = 0; j < 8; ++j) {
            const int src = ((j >> 2) & 1) * 32 + ((j >> 1) & 1) * 16 + (j & 1) * 8;
            const float wj = __builtin_bit_cast(float, __builtin_amdgcn_readlane(__builtin_bit_cast(int, wsel), src));
            axpy8(out, wj, va[j]); axpy8(out + 8, wj, vb[j]);
        }
    }
    const int lsel = last_layer ? 1 : 0; (void)lsel;
    float y[16];
    { const f32x4 a0 = *(const f32x4*)(hf + 8 * lane), a1 = *(const f32x4*)(hf + 8 * lane + 4), b0 = *(const f32x4*)(hf + 512 + 8 * lane), b1 = *(const f32x4*)(hf + 512 + 8 * lane + 4);
      const float hv[16] = {a0[0], a0[1], a0[2], a0[3], a1[0], a1[1], a1[2], a1[3], b0[0], b0[1], b0[2], b0[3], b1[0], b1[1], b1[2], b1[3]};
#pragma unroll
      for (int e = 0; e < 16; ++e) y[e] = DN_ALPHA * hv[e] + out[e]; }
    float s = 0.f;
#pragma unroll
    for (int e = 0; e < 16; ++e) s += y[e];
    const float mean = wave_sum(s) * (1.0f / 1024.0f);
    float s2 = 0.f;
#pragma unroll
    for (int e = 0; e < 16; ++e) { y[e] -= mean; s2 += y[e] * y[e]; }
    const float rstd = 1.0f / sqrtf(wave_sum(s2) * (1.0f / 1024.0f) + LN_EPS);
    const float* g = (const float*)P.in[22] + l * 1024; const float* bb = (const float*)P.in[23] + l * 1024;
#pragma unroll
    for (int half = 0; half < 2; ++half) {
        const int c0 = 512 * half + 8 * lane;
        const f32x4 ga = *(const f32x4*)(g + c0), gb = *(const f32x4*)(g + c0 + 4), ba = *(const f32x4*)(bb + c0), bc = *(const f32x4*)(bb + c0 + 4);
        float o[8];
#pragma unroll
        for (int e = 0; e < 4; ++e) { o[e] = y[8 * half + e] * rstd * ga[e] + ba[e]; o[4 + e] = y[8 * half + 4 + e] * rstd * gb[e] + bc[e]; }
        float* of = last_layer ? (P.out + m * DM + c0) : (hf + c0);
        *(f32x4*)of = (f32x4){o[0], o[1], o[2], o[3]}; *(f32x4*)(of + 4) = (f32x4){o[4], o[5], o[6], o[7]};
        if (!last_layer) *(u32x4*)((bf16*)(F.ws + OFF_HB) + m * DM + c0) = pack8(o);
    }
}

#ifndef STOP_AFTER
#define STOP_AFTER 99
#endif
constexpr int PTR_OFF = LDS_BYTES - 512;
__device__ __forceinline__ Frame make_frame(unsigned char* ws_) {
    extern __shared__ __attribute__((aligned(16))) unsigned char lds_raw[];
    Frame F; F.lds = (LAS unsigned char*)lds_raw; { int t_ = threadIdx.x; asm volatile("" : "+v"(t_)); F.tid = t_; } F.lane = F.tid & 63; F.wave = __builtin_amdgcn_readfirstlane(F.tid >> 6);
    { int g_ = gridDim.x, b_ = blockIdx.x; asm volatile("" : "+s"(g_), "+s"(b_)); F.G = g_; F.bid = b_; }
    F.ws = ws_;
    return F;
}
__device__ __forceinline__ int dequeue(const Frame& F, unsigned* ctr) {
    LAS int* slot = (LAS int*)(F.lds + LDS_BYTES - 64);
    __syncthreads();
    if (F.tid == 0) slot[0] = (int)atomicAdd(ctr, 1u);
    __syncthreads();
    const int v = slot[0];
    return v;
}
__device__ __noinline__ void grid_sync_fn() { cg::this_grid().sync(); }
typedef pg8::StaticOrder SO;
#ifndef PHASE_FN
#define PHASE_FN __device__ __forceinline__
#endif
__device__ __forceinline__ Params fresh_params() {
    const unsigned long long* ka = (const unsigned long long*)__builtin_amdgcn_kernarg_segment_ptr(); asm volatile("" : "+s"(ka));
    Params P;
#pragma unroll
    for (int i = 0; i < 24; ++i) P.in[i] = (const void*)ka[i];
    P.out = (float*)ka[24]; P.ws = (unsigned char*)ka[25]; P.pad0 = 0; P.pad1 = 0; return P;
}
__device__ __forceinline__ Frame relaunder(const Frame& F0) {
    Frame F = F0; int t_ = F0.tid; asm volatile("" : "+v"(t_)); F.tid = t_; F.lane = t_ & 63; return F;
}
#define PHASE_PROLOG() const Params P = fresh_params(); const Frame F = make_frame(P.ws); unsigned char* ws = F.ws; (void)ws;
#define WL(l) (ws + OFF_W + (size_t)(l) * W_LAYER)

PHASE_FN void ph_p0() { PHASE_PROLOG(); p0_prologue(F, P); }
PHASE_FN void ph_p1(int l) { PHASE_PROLOG();
    pg8::Gemm g{(const pg8::bf16_t*)(ws + OFF_HB), (const pg8::bf16_t*)(WL(l) + WO_IN), MROWS, 5120, 1024, 1024, 1024};
    SO S; S.init(MROWS, 5120, F.G, F.bid);
    epi::Proj E{(bf16*)(ws + OFF_PROJ1), (bf16*)(ws + OFF_PROJ2)};
    pg8::gemm_phase<epi::Proj, SO, true, true>(F.lds, g, S, E);
}
PHASE_FN void ph_p2a() { PHASE_PROLOG(); if (F.bid < 64) p2_moba_block(F, F.bid);
    const int gw = ((F.bid + F.G - 64) % F.G) * NWAVES + F.wave, NGW = F.G * NWAVES;
    for (int m = gw; m < MROWS; m += NGW) { const Frame Fi = relaunder(F); p2_row(Fi, m); } }
PHASE_FN void ph_p2b(int l) { PHASE_PROLOG();
    const int gw = ((F.bid + F.G - 64) % F.G) * NWAVES + F.wave, NGW = F.G * NWAVES;
    LAS float* Asm = (LAS float*)(F.lds + F.wave * 17408);
    for (int ch = gw; ch < 2048; ch += NGW) { const Frame Fi = relaunder(F); gdn_chunk_wave(Fi, P, l, ch, Asm); } }
PHASE_FN void ph_p3(int l, int which) { PHASE_PROLOG();
    if (which == 0) {
        pg8::Gemm g{(const pg8::bf16_t*)(ws + OFF_PROJ1), (const pg8::bf16_t*)(WL(l) + WO_UQ), MROWS, 768, 768, P1LD, 768};
        SO S; S.init(MROWS, 768, F.G, F.bid);
        epi::Store E{(bf16*)(ws + OFF_QMLA), 768, (const float*)(ws + OFF_RSTD), 0};
        pg8::gemm_phase<epi::Store, SO, true, true>(F.lds, g, S, E);
    } else {
        pg8::Gemm g{(const pg8::bf16_t*)(ws + OFF_PROJ1) + 768, (const pg8::bf16_t*)(WL(l) + WO_UKV), MROWS, 1024, 256, P1LD, 256};
        SO S; S.init(MROWS, 1024, F.G, (F.bid + 64) % F.G);
        epi::Store E{(bf16*)(ws + OFF_KVMLA), 1024, (const float*)(ws + OFF_RSTD), 1};
        pg8::gemm_phase<epi::Store, SO, true, true>(F.lds, g, S, E);
    }
}
PHASE_FN void ph_gdn(int l, int i) { PHASE_PROLOG(); gdn_scan_unit(F, P, l, i >> 3, i & 7); }
PHASE_FN void ph_mla(int bh, int qb) { PHASE_PROLOG(); attn_unit<96, false>(F, bh >> 3, bh & 7, qb); }
PHASE_FN void ph_moba(int bh, int qb) { PHASE_PROLOG(); attn_unit<64, true>(F, bh >> 3, bh & 7, qb); }
PHASE_FN void ph_brzero(int which) { PHASE_PROLOG();
    const int gt = F.bid * NTHREADS + F.tid, NGT = F.G * NTHREADS; bf16* BR = (bf16*)(ws + OFF_BR);
    for (int i = gt; i < MROWS * 64; i += NGT) { const int m = i >> 6, c8 = i & 63; *(u32x4*)(BR + (size_t)m * BRLD + which * 512 + 8 * c8) = (u32x4){0u, 0u, 0u, 0u}; } }
PHASE_FN void ph_p5a(int l) { PHASE_PROLOG();
    pg8::Gemm g{(const pg8::bf16_t*)(ws + OFF_HB), (const pg8::bf16_t*)(WL(l) + WO_G), MROWS, 3072, 1024, 1024, 1024};
    SO S; S.init(MROWS, 3072, F.G, F.bid);
    epi::Store E{(bf16*)(ws + OFF_GLG), 3072, nullptr, 0};
    pg8::gemm_phase<epi::Store, SO, true, true>(F.lds, g, S, E);
}
PHASE_FN void ph_p5b(int l) { PHASE_PROLOG();
    pg8::Gemm g{(const pg8::bf16_t*)(ws + OFF_BR), (const pg8::bf16_t*)(WL(l) + WO_BR), MROWS, 3072, 512, BRLD, 512};
    epi::MergeOrder S; S.init(F.G, F.bid);
    epi::Merge E{(bf16*)(ws + OFF_MERGED), (const bf16*)(ws + OFF_GLG), (const float*)P.in[13] + (size_t)l * 3072};
    pg8::gemm_phase<epi::Merge, epi::MergeOrder, true, true>(F.lds, g, S, E);
}
PHASE_FN void ph_p6(int l) { PHASE_PROLOG();
    pg8::Gemm g{(const pg8::bf16_t*)(ws + OFF_MERGED), (const pg8::bf16_t*)(WL(l) + WO_OUT), MROWS, 1024, 1024, 1024, 1024};
    SO S; S.init(MROWS, 1024, F.G, F.bid);
    epi::OutRes E{(float*)(ws + OFF_Y), (const float*)(ws + OFF_HF)};
    pg8::gemm_phase<epi::OutRes, SO, true, true>(F.lds, g, S, E);
}
PHASE_FN void ph_ln1(int l, int from_y) { PHASE_PROLOG();
    const int gw = F.bid * NWAVES + F.wave, NGW = F.G * NWAVES;
    for (int m = gw; m < MROWS; m += NGW)
        ln_row((const float*)(ws + (from_y ? OFF_Y : OFF_HF)) + (size_t)m * DM, (const float*)P.in[16] + l * 1024, (const float*)P.in[17] + l * 1024,
               (float*)(ws + OFF_HF) + (size_t)m * DM, (bf16*)(ws + OFF_HB) + (size_t)m * DM, F.lane, from_y ? 1.0f : DN_ALPHA);
}
PHASE_FN void ph_p7(int l) { PHASE_PROLOG();
    pg8::Gemm g{(const pg8::bf16_t*)(ws + OFF_HB), (const pg8::bf16_t*)(WL(l) + WO_PQ), MROWS, 2048, 1024, 1024, 1024};
    SO S; S.init(MROWS, 2048, F.G, F.bid);
    epi::Store E{(bf16*)(ws + OFF_QRY), 2048, nullptr, 0};
    pg8::gemm_phase<epi::Store, SO, true, true>(F.lds, g, S, E);
    peer_tables(F, P, l);
}
PHASE_FN void ph_p8(int l) { PHASE_PROLOG(); for (int u = F.bid; u < MROWS / 32; u += F.G) { const Frame Fi = relaunder(F); peer_topk_unit(Fi, l, u); } }
PHASE_FN void ph_p9(int l, int en_peer) { PHASE_PROLOG();
    const int gw = F.bid * NWAVES + F.wave, NGW = F.G * NWAVES;
    for (int m = gw; m < MROWS; m += NGW) { const Frame Fi = relaunder(F); peer_token(Fi, P, l, (size_t)m, l == NLAYER - 1, en_peer != 0); }
}

#ifndef EN_MIXER
#define EN_MIXER 1
#endif
#ifndef EN_MLA
#define EN_MLA 1
#endif
#ifndef EN_MOBA
#define EN_MOBA 1
#endif
#ifndef EN_GDN
#define EN_GDN 1
#endif
#ifndef EN_PEER
#define EN_PEER 1
#endif

#define GRID_BAR() grid_sync_fn()
template <int l> __device__ __forceinline__ void layer_body() {
    extern __shared__ __attribute__((aligned(16))) unsigned char lds_raw[];

        if (EN_MIXER) {
            ph_p1(l);
            GRID_BAR();
            ph_p2a(); ph_p2b(l);
            GRID_BAR();
            ph_p3(l, 0); ph_p3(l, 1);
            GRID_BAR();
            {
                unsigned* ctr = (unsigned*)(fresh_params().ws + OFF_CTL) + 64 * (1 + l);
                const int tid = threadIdx.x;
                LAS int* slot = (LAS int*)((LAS unsigned char*)lds_raw + LDS_BYTES - 64);
                for (;;) {
                    __syncthreads();
                    if (tid == 0) slot[0] = (int)atomicAdd(ctr, 1u);
                    __syncthreads();
                    const int i = __builtin_amdgcn_readfirstlane(slot[0]);
                    if (i >= 64 + 1024) break;
                    if (i < 64) { if (EN_GDN) ph_gdn(l, i); }
                    else { const int j = i - 64, qb = 7 - (j >> 7), typ = (j >> 6) & 1, bh = j & 63;
                        if (typ == 0) { if (EN_MLA) ph_mla(bh, qb); } else { if (EN_MOBA) ph_moba(bh, qb); } }
                }
                if (!EN_MLA) ph_brzero(0);
                if (!EN_MOBA) ph_brzero(1);
                if (!EN_GDN) ph_brzero(2);
            }
            GRID_BAR();
            ph_p5a(l);
            GRID_BAR();
            ph_p5b(l);
            GRID_BAR();
            ph_p6(l);
            GRID_BAR();
        }
        ph_ln1(l, EN_MIXER);
        GRID_BAR();
        if (EN_PEER) {
            ph_p7(l);
            GRID_BAR();
            ph_p8(l);
            GRID_BAR();
        }
        ph_p9(l, EN_PEER);
        if (l + 1 < NLAYER) GRID_BAR();
}
__global__ void __launch_bounds__(NTHREADS, 2) fwd_mega(Params Pk) {
    ph_p0();
    GRID_BAR();
    layer_body<0>();
    layer_body<1>();
}

extern "C" void kernel_launch(void* const* d_in, const int* in_sizes, int n_in, void* d_out, int out_size, void* d_ws, size_t ws_size, hipStream_t stream) {
    static int grid = 0;
    if (grid == 0) {
        if (n_in != 24 || out_size != MROWS * DM || ws_size < WS_END) { fprintf(stderr, "kernel_launch: unexpected shapes (n_in %d out %d ws %zu need %zu)\n", n_in, out_size, ws_size, (size_t)WS_END); grid = -1; return; }
        int dev = 0, cus = 0, per_cu = 0;
        if (hipGetDevice(&dev) != hipSuccess || hipDeviceGetAttribute(&cus, hipDeviceAttributeMultiprocessorCount, dev) != hipSuccess) { grid = -1; return; }
        if (hipFuncSetAttribute((const void*)fwd_mega, hipFuncAttributeMaxDynamicSharedMemorySize, LDS_BYTES) != hipSuccess) { fprintf(stderr, "kernel_launch: hipFuncSetAttribute failed\n"); grid = -1; return; }
        if (hipOccupancyMaxActiveBlocksPerMultiprocessor(&per_cu, (const void*)fwd_mega, NTHREADS, LDS_BYTES) != hipSuccess || per_cu < 1) { fprintf(stderr, "kernel_launch: occupancy query says %d\n", per_cu); per_cu = 1; }
        (void)hipGetLastError();
        grid = cus;
    }
    if (grid < 0) return;
    if (hipMemsetAsync((char*)d_ws + OFF_CTL, 0, CTL_BYTES, stream) != hipSuccess) { fprintf(stderr, "kernel_launch: memset failed\n"); return; }
    Params p{};
    for (int i = 0; i < 24; ++i) p.in[i] = d_in[i];
    p.out = (float*)d_out; p.ws = (unsigned char*)d_ws; p.pad0 = 0; p.pad1 = 0;
    void* args[] = {&p};
    hipError_t e = hipLaunchCooperativeKernel((void*)fwd_mega, dim3(grid), dim3(NTHREADS), args, LDS_BYTES, stream);
    if (e != hipSuccess) fprintf(stderr, "cooperative launch failed: %s (grid %d)\n", hipGetErrorString(e), grid);
}
```

```cpp
#include <hip/hip_runtime.h>
#include <hip/hip_cooperative_groups.h>
#include <cstdio>
#include <cstdint>
namespace cg = cooperative_groups;

namespace pg8 {
#define PG8_LAS __attribute__((address_space(3)))
typedef unsigned short bf16_t;
typedef short bf16x8 __attribute__((ext_vector_type(8)));
typedef float f32x4 __attribute__((ext_vector_type(4)));
typedef unsigned u32x4 __attribute__((ext_vector_type(4)));
constexpr int BM = 256, BK = 64, HALF = 128, HTB = HALF * BK * 2  , STAGE_BYTES = 8 * HTB, NXCD = 8, WGM = 8;

__host__ __device__ __forceinline__ int lds_byte(int r, int c) { const int st = (r >> 4) * 2 + (c >> 5), rr = r & 15, cc = c & 31, ob = rr * 64 + cc * 2; return st * 1024 + (ob ^ (((ob >> 9) & 1) << 5)); }
__host__ __device__ __forceinline__ void stage_rc(int b, int& R, int& C) { const int st = b / 1024, sb = b % 1024, swz = sb ^ (((sb >> 9) & 1) << 5); R = (st >> 1) * 16 + swz / 64; C = (st & 1) * 32 + (swz % 64) / 2; }
__host__ __device__ __forceinline__ int perm32(int rho) { const int n = rho >> 4, i = rho & 15; return 8 * (i >> 2) + 4 * n + (i & 3); }

struct Unit { int pm, pn, za, tag; };
struct Gemm { const bf16_t* A; const bf16_t* Bt; int M, N, K, lda, ldb; };

struct StaticOrder {
    int nM, nN, nwg, G, c;
    __host__ __device__ void init(int M, int N, int G_, int c_) { nM = M / BM; nN = N / BM; nwg = nM * nN; G = G_; c = c_; }
    __host__ __device__ bool next(int i, Unit& u) const {
        const long L = (long)i * G + c; if (L >= nwg) return false;
        int wgid = (int)L; { const int q = nwg / NXCD, r = nwg % NXCD, xcd = wgid % NXCD, off = wgid / NXCD; wgid = (xcd < r ? xcd * (q + 1) : r * (q + 1) + (xcd - r) * q) + off; }
        const int nig = WGM * nN, gid = wgid / nig, fm = gid * WGM, gsz = (nM - fm) < WGM ? (nM - fm) : WGM;
        u.pm = fm + ((wgid % nig) % gsz); u.pn = (wgid % nig) / gsz; u.za = 0; u.tag = 0; return true;
    }
    __device__ __forceinline__ void a_ready(const Unit&) const {}
    __device__ __forceinline__ void done(const Unit&) const {}
};

__device__ __forceinline__ unsigned cvt_pk_bf16(float lo, float hi) { unsigned r; asm volatile("v_cvt_pk_bf16_f32 %0, %1, %2" : "=v"(r) : "v"(lo), "v"(hi)); return r; }
typedef float f32x2 __attribute__((ext_vector_type(2)));
__device__ __forceinline__ f32x2 gelu_pk(f32x2 v) {
    const f32x2 av = __builtin_elementwise_abs(v), d = av * 0.2316418882f + 1.0f;
    f32x2 t; t.x = __builtin_amdgcn_rcpf(d.x); t.y = __builtin_amdgcn_rcpf(d.y);
    f32x2 q = t * 0.5307027145f + (-0.7265760135f); q = q * t + 0.7107068705f; q = q * t + (-0.142248368f); q = q * t + 0.127414796f; q = q * t;
    const f32x2 s = (v * v) * (-0.72134752044f);
    f32x2 e; e.x = __builtin_amdgcn_exp2f(s.x); e.y = __builtin_amdgcn_exp2f(s.y);
    const f32x2 m = v * (q * e), r = v - m;
    f32x2 o; o.x = v.x < 0.f ? m.x : r.x; o.y = v.y < 0.f ? m.y : r.y; return o;
}

template <int ACT  > struct EpiBf16 {
    static constexpr bool PERM = true, AFTER_DRAIN = false; static_assert(ACT == 0 || ACT == 1, "EpiBf16: ACT is 0 (none) or 1 (gelu_pk)");
    bf16_t* O; int ldc; const float* bias; int split_cols; size_t split_stride; float scale0;
    __device__ __forceinline__ void operator()(const f32x4 (&acc)[2][2][4][2], const Unit& u, int wr, int wc, int fr, int fq) const {
        const int row0 = u.pm * BM + wr * 64 + fr; int colt = u.pn * BM; bf16_t* base = O;
        float sc = 1.f; if (split_cols) { const int t = colt / split_cols; base += (size_t)t * split_stride; colt -= t * split_cols; if (t == 0) sc = scale0; }
        const int col0 = colt + wc * 32 + 8 * fq, bcol0 = u.pn * BM + wc * 32 + 8 * fq;
        f32x4 bv[2][2];
#pragma unroll
        for (int bj = 0; bj < 2; ++bj)
#pragma unroll
            for (int n = 0; n < 2; ++n) bv[bj][n] = bias ? *(const f32x4*)(bias + bcol0 + bj * HALF + 4 * n) : (f32x4){0.f, 0.f, 0.f, 0.f};
#pragma unroll
        for (int ai = 0; ai < 2; ++ai)
#pragma unroll
            for (int m = 0; m < 4; ++m) { bf16_t* rowp = base + (size_t)(row0 + ai * HALF + m * 16) * ldc + col0;
#pragma unroll
                for (int bj = 0; bj < 2; ++bj) { f32x4 v0 = acc[ai][bj][m][0] + bv[bj][0], v1 = acc[ai][bj][m][1] + bv[bj][1];
                    if (ACT == 1) { f32x2 a = gelu_pk((f32x2){v0[0], v0[1]}), b = gelu_pk((f32x2){v0[2], v0[3]}), c = gelu_pk((f32x2){v1[0], v1[1]}), d = gelu_pk((f32x2){v1[2], v1[3]});
                        v0 = (f32x4){a.x, a.y, b.x, b.y}; v1 = (f32x4){c.x, c.y, d.x, d.y}; }
                    v0 = v0 * sc; v1 = v1 * sc; u32x4 w; w.x = cvt_pk_bf16(v0[0], v0[1]); w.y = cvt_pk_bf16(v0[2], v0[3]); w.z = cvt_pk_bf16(v1[0], v1[1]); w.w = cvt_pk_bf16(v1[2], v1[3]);
                    *(u32x4*)(rowp + bj * HALF) = w; } }
    }
};

struct PanelStats {
    unsigned* xbuf;
    unsigned* cnt;
    unsigned* tmo;
    int ntn; float eps;
    unsigned code;
    __device__ __forceinline__ bool run(const f32x4 (&v)[2][2][4][2], const Unit& u, int wr, int wc, int fr, int fq, PG8_LAS unsigned char* lds, int wid, int lane) const {
        typedef float f32x2v __attribute__((ext_vector_type(2)));
        PG8_LAS f32x2v* P = (PG8_LAS f32x2v*)lds;
        PG8_LAS f32x2v* S = (PG8_LAS f32x2v*)(lds + 8192);
        PG8_LAS unsigned* flag = (PG8_LAS unsigned*)(lds + 8192 + 2048);
#pragma unroll
        for (int ai = 0; ai < 2; ++ai)
#pragma unroll
            for (int m = 0; m < 4; ++m) {
                float s = 0.f;
#pragma unroll
                for (int bj = 0; bj < 2; ++bj)
#pragma unroll
                    for (int n = 0; n < 2; ++n) { const f32x4 x = v[ai][bj][m][n]; s += (x[0] + x[1]) + (x[2] + x[3]); }
                s += __shfl_xor(s, 16); s += __shfl_xor(s, 32);
                const float mw = s * (1.0f / 64.0f); float q = 0.f;
#pragma unroll
                for (int bj = 0; bj < 2; ++bj)
#pragma unroll
                    for (int n = 0; n < 2; ++n) { const f32x4 d = v[ai][bj][m][n] - mw; q += (d[0] * d[0] + d[1] * d[1]) + (d[2] * d[2] + d[3] * d[3]); }
                q += __shfl_xor(q, 16); q += __shfl_xor(q, 32);
                if (fq == 0) P[(ai * HALF + wr * 64 + m * 16 + fr) * 4 + wc] = (f32x2v){mw, q};
            }
        asm volatile("s_waitcnt lgkmcnt(0)" ::: "memory"); __builtin_amdgcn_s_barrier(); asm volatile("" ::: "memory");
#if defined(BROKEN_EXCHANGE_NO_WAIT)
#warning BROKEN CONTROL BUILD: the row-statistics exchange does not wait; results are wrong by design
        if (blockIdx.x >= 64) { const long long t0_ = clock64(); while (clock64() - t0_ < 60000) __builtin_amdgcn_s_sleep(8); }
#endif
        const int row = wid * 32 + (lane & 31);
        if (lane < 32) {
            const f32x2v a = P[row * 4 + 0], b = P[row * 4 + 1], c = P[row * 4 + 2], d = P[row * 4 + 3];
            const float mt = (a.x + b.x + c.x + d.x) * 0.25f;
            const float da = a.x - mt, db = b.x - mt, dc = c.x - mt, dd = d.x - mt;
            const float m2 = (a.y + b.y) + (c.y + d.y) + 64.0f * ((da * da + db * db) + (dc * dc + dd * dd));
            unsigned long long* slot = (unsigned long long*)xbuf + ((size_t)(u.pm * BM + row) * 4 + u.pn);
            __hip_atomic_store(slot, ((unsigned long long)__float_as_uint(m2) << 32) | __float_as_uint(mt), __ATOMIC_RELAXED, __HIP_MEMORY_SCOPE_AGENT);
        }
        asm volatile("s_waitcnt vmcnt(0)" ::: "memory");
        if (lane == 0) __hip_atomic_fetch_add(cnt + 64 * u.pm, 1u, __ATOMIC_RELAXED, __HIP_MEMORY_SCOPE_AGENT);
        if (wid == 0) {
            bool dead = false; const unsigned long long t0 = __builtin_amdgcn_s_memrealtime(); const unsigned want = 8u * (unsigned)ntn;
            for (;;) {
#if defined(BROKEN_EXCHANGE_NO_WAIT)
                break;
#endif
                if ((unsigned)__builtin_amdgcn_readfirstlane(__hip_atomic_load(cnt + 64 * u.pm, __ATOMIC_RELAXED, __HIP_MEMORY_SCOPE_AGENT)) >= want) break;
                if (__builtin_amdgcn_s_memrealtime() - t0 > 2000000ull) {
                    if (lane == 0) { unsigned expect = 0u; __hip_atomic_compare_exchange_strong(tmo + 1, &expect, code | (unsigned)(u.pm & 0xff), __ATOMIC_RELAXED, __ATOMIC_RELAXED, __HIP_MEMORY_SCOPE_AGENT);
                                     __hip_atomic_store(tmo, 1u, __ATOMIC_RELAXED, __HIP_MEMORY_SCOPE_AGENT); }
                    dead = true; break; }
                __builtin_amdgcn_s_sleep(2);
            }
            __builtin_amdgcn_fence(__ATOMIC_ACQUIRE, "agent");
            if (lane == 0) flag[0] = dead ? 1u : 0u;
        }
        asm volatile("s_waitcnt vmcnt(0) lgkmcnt(0)" ::: "memory"); __builtin_amdgcn_s_barrier(); asm volatile("" ::: "memory");
        const bool bad = flag[0] != 0u;
        if (lane < 32) {
            const unsigned long long* slot = (const unsigned long long*)xbuf + (size_t)(u.pm * BM + row) * 4; float mt[4], m2[4]; float ms = 0.f;
#pragma unroll
            for (int t = 0; t < 4; ++t) { if (t < ntn) { const unsigned long long w = __hip_atomic_load(slot + t, __ATOMIC_RELAXED, __HIP_MEMORY_SCOPE_AGENT); mt[t] = __uint_as_float((unsigned)w); m2[t] = __uint_as_float((unsigned)(w >> 32)); } else { mt[t] = 0.f; m2[t] = 0.f; } ms += mt[t]; }
            const float mean = ms / (float)ntn; float q = 0.f;
#pragma unroll
            for (int t = 0; t < 4; ++t) if (t < ntn) { const float dm = mt[t] - mean; q += m2[t] + 256.0f * dm * dm; }
            S[row] = (f32x2v){mean, 1.0f / sqrtf(q / (256.0f * (float)ntn) + eps)};
        }
        asm volatile("s_waitcnt lgkmcnt(0)" ::: "memory"); __builtin_amdgcn_s_barrier(); asm volatile("" ::: "memory");
        return bad;
    }
};
struct EpiLnRes {
    static constexpr bool PERM = false, AFTER_DRAIN = true;
    const float* base; float* out; int ldc; const float* bias; PanelStats st; unsigned poison;
    __device__ __forceinline__ void fused(f32x4 (&acc)[2][2][4][2], const Unit& u, int wr, int wc, int fr, int fq, PG8_LAS unsigned char* lds, int wid, int lane) const {
        typedef float f32x2v __attribute__((ext_vector_type(2)));
        const PG8_LAS f32x2v* S = (const PG8_LAS f32x2v*)(lds + 8192);
        const int col0 = u.pn * BM + wc * 32 + 4 * fq;
#pragma unroll
        for (int bj = 0; bj < 2; ++bj)
#pragma unroll
            for (int n = 0; n < 2; ++n) { const f32x4 bv = bias ? *(const f32x4*)(bias + col0 + bj * HALF + n * 16) : (f32x4){0.f, 0.f, 0.f, 0.f};
#pragma unroll
                for (int ai = 0; ai < 2; ++ai)
#pragma unroll
                    for (int m = 0; m < 4; ++m) acc[ai][bj][m][n] += bv; }
        f32x4 pre[4][2][2];
#pragma unroll
        for (int m = 0; m < 4; ++m) { const size_t off = (size_t)(u.pm * BM + wr * 64 + m * 16 + fr) * ldc + col0;
#pragma unroll
            for (int bj = 0; bj < 2; ++bj)
#pragma unroll
                for (int n = 0; n < 2; ++n) pre[m][bj][n] = *(const f32x4*)(base + off + bj * HALF + n * 16); }
        const bool bad = st.run(acc, u, wr, wc, fr, fq, lds, wid, lane) || poison != 0u;
        const float qnan = __builtin_nanf("");
#pragma unroll
        for (int ai = 0; ai < 2; ++ai)
#pragma unroll
            for (int m = 0; m < 4; ++m) { const int r = ai * HALF + wr * 64 + m * 16 + fr; const f32x2v sr = S[r]; const size_t off = (size_t)(u.pm * BM + r) * ldc + col0;
#pragma unroll
                for (int bj = 0; bj < 2; ++bj)
#pragma unroll
                    for (int n = 0; n < 2; ++n) { const f32x4 bs = ai == 0 ? pre[m][bj][n] : *(const f32x4*)(base + off + bj * HALF + n * 16); f32x4 o = bs + (acc[ai][bj][m][n] - sr.x) * sr.y;
                        if (bad) o = (f32x4){qnan, qnan, qnan, qnan}; *(f32x4*)(out + off + bj * HALF + n * 16) = o; }
                if (m & 1) asm volatile("" ::: "memory"); }
    }
};
struct EpiLnResLn {
    static constexpr bool PERM = false, AFTER_DRAIN = true;
    const float* base; float* out; bf16_t* xn; int ldc; const float* bias; PanelStats st1, st2; unsigned poison;
    __device__ __forceinline__ void fused(f32x4 (&acc)[2][2][4][2], const Unit& u, int wr, int wc, int fr, int fq, PG8_LAS unsigned char* lds, int wid, int lane) const {
        typedef float f32x2v __attribute__((ext_vector_type(2))); typedef unsigned u32x2v __attribute__((ext_vector_type(2)));
        const PG8_LAS f32x2v* S = (const PG8_LAS f32x2v*)(lds + 8192);
        const int col0 = u.pn * BM + wc * 32 + 4 * fq;
#pragma unroll
        for (int bj = 0; bj < 2; ++bj)
#pragma unroll
            for (int n = 0; n < 2; ++n) { const f32x4 bv = bias ? *(const f32x4*)(bias + col0 + bj * HALF + n * 16) : (f32x4){0.f, 0.f, 0.f, 0.f};
#pragma unroll
                for (int ai = 0; ai < 2; ++ai)
#pragma unroll
                    for (int m = 0; m < 4; ++m) acc[ai][bj][m][n] += bv; }
        bool bad = st1.run(acc, u, wr, wc, fr, fq, lds, wid, lane) || poison != 0u;
        const float qnan = __builtin_nanf("");
#pragma unroll
        for (int ai = 0; ai < 2; ++ai)
#pragma unroll
            for (int m = 0; m < 4; ++m) { const int r = ai * HALF + wr * 64 + m * 16 + fr; const f32x2v sr = S[r]; const size_t off = (size_t)(u.pm * BM + r) * ldc + col0;
#pragma unroll
                for (int bj = 0; bj < 2; ++bj)
#pragma unroll
                    for (int n = 0; n < 2; ++n) { const f32x4 bs = *(const f32x4*)(base + off + bj * HALF + n * 16); acc[ai][bj][m][n] = bs + (acc[ai][bj][m][n] - sr.x) * sr.y; }
                asm volatile("" : "+v"(acc[ai][0][m][0]), "+v"(acc[ai][0][m][1]), "+v"(acc[ai][1][m][0]), "+v"(acc[ai][1][m][1]));
                if (m & 1) asm volatile("" ::: "memory"); }
        const bool bad1 = bad;
        bad = st2.run(acc, u, wr, wc, fr, fq, lds, wid, lane) || bad;
#pragma unroll
        for (int ai = 0; ai < 2; ++ai)
#pragma unroll
            for (int m = 0; m < 4; ++m) { const int r = ai * HALF + wr * 64 + m * 16 + fr; const f32x2v sr = S[r]; const size_t off = (size_t)(u.pm * BM + r) * ldc + col0;
#pragma unroll
                for (int bj = 0; bj < 2; ++bj)
#pragma unroll
                    for (int n = 0; n < 2; ++n) { const f32x4 x1 = acc[ai][bj][m][n]; *(f32x4*)(out + off + bj * HALF + n * 16) = bad1 ? (f32x4){qnan, qnan, qnan, qnan} : x1;
                        const f32x4 o = (x1 - sr.x) * sr.y; u32x2v w; w.x = cvt_pk_bf16(o[0], o[1]); w.y = cvt_pk_bf16(o[2], o[3]);
                        if (bad) { w.x = 0x7fc07fc0u; w.y = 0x7fc07fc0u; } *(u32x2v*)(xn + off + bj * HALF + n * 16) = w; }
                asm volatile("" ::: "memory"); }
    }
};

template <class Epi, class Sched, bool ALIGN_EPI = false, bool SP2 = false>
__device__ __forceinline__ void gemm_phase(PG8_LAS unsigned char* lds, const Gemm g, const Sched& S, const Epi& E) {
    const int tid = threadIdx.x, wid = __builtin_amdgcn_readfirstlane(tid >> 6), lane = tid & 63, wr = wid >> 2, wc = wid & 3, fr = lane & 15, fq = lane >> 4;
    const int K = g.K, nt = K / BK;
    unsigned voffA[2], voffB[2];
#pragma unroll
    for (int i = 0; i < 2; ++i) { int R, C; stage_rc(tid * 16 + i * 8192, R, C); const int Rb = Epi::PERM ? ((R & ~31) + perm32(R & 31)) : R;
        voffA[i] = (unsigned)(R * g.lda + C) * 2u; voffB[i] = (unsigned)(Rb * g.ldb + C) * 2u; }
    const size_t kstep = (size_t)(BK * 2);
    const size_t hstepA = (size_t)HALF * g.lda * 2, hstepB = (size_t)HALF * g.ldb * 2;
    const size_t tstepA = 2 * hstepA, tstepB = 2 * hstepB;
    const unsigned ldsw = (unsigned)wid * 1024u;
    const int aoff = lds_byte(wr * 64 + fr, fq * 8), boff = lds_byte(wc * 32 + fr, fq * 8);
#define PG8_SA(b, h) (((b) * 2 + (h)) * HTB)
#define PG8_SB(b, h) ((4 + (b) * 2 + (h)) * HTB)
#define PG8_STAGE(bufoff, gbase, voff) do { _Pragma("unroll") for (int _i = 0; _i < 2; ++_i) \
        __builtin_amdgcn_global_load_lds((const unsigned*)((const char*)(gbase) + (voff)[_i]), (PG8_LAS unsigned*)(lds + (bufoff) + ldsw + _i * 8192), 16, 0, 0); } while (0)
#define PG8_LDA(dst, b, h) do { _Pragma("unroll") for (int m = 0; m < 4; ++m) _Pragma("unroll") for (int k = 0; k < 2; ++k) dst[m][k] = *(const PG8_LAS bf16x8*)(lds + PG8_SA(b, h) + aoff + m * 2048 + k * 1024); } while (0)
#define PG8_LDB(dst, b, h) do { _Pragma("unroll") for (int n = 0; n < 2; ++n) _Pragma("unroll") for (int k = 0; k < 2; ++k) dst[n][k] = *(const PG8_LAS bf16x8*)(lds + PG8_SB(b, h) + boff + n * 2048 + k * 1024); } while (0)
#define PG8_MMA(ai, bj, At, Bt) do { __builtin_amdgcn_s_setprio(1); _Pragma("unroll") for (int m = 0; m < 4; ++m) _Pragma("unroll") for (int n = 0; n < 2; ++n) _Pragma("unroll") for (int k = 0; k < 2; ++k) \
        acc[ai][bj][m][n] = __builtin_amdgcn_mfma_f32_16x16x32_bf16(Bt[n][k], At[m][k], acc[ai][bj][m][n], 0, 0, 0); __builtin_amdgcn_s_setprio(0); } while (0)
#define PG8_WAIT_V(n) asm volatile("s_waitcnt vmcnt(" #n ")" ::: "memory")
#define PG8_WAIT_L(n) asm volatile("s_waitcnt lgkmcnt(" #n ")" ::: "memory")
#define PG8_BAR __builtin_amdgcn_s_barrier()
#define PG8_SCHED __builtin_amdgcn_sched_barrier(0)
    Unit cur, nxt; int ui = 0;
    if (!S.next(0, cur)) return;
    f32x4 acc[2][2][4][2];
#pragma unroll
    for (int a = 0; a < 2; ++a)
#pragma unroll
        for (int b = 0; b < 2; ++b)
#pragma unroll
            for (int m = 0; m < 4; ++m)
#pragma unroll
                for (int n = 0; n < 2; ++n) acc[a][b][m][n] = (f32x4){0.f, 0.f, 0.f, 0.f};
    bf16x8 At[4][2], B0[2][2], B1[2][2];
    const char* cA = (const char*)g.A + (size_t)cur.pm * tstepA + (size_t)cur.za * 2; const char* cB = (const char*)g.Bt + (size_t)cur.pn * tstepB;
    S.a_ready(cur);
    if constexpr (SP2) {
        PG8_STAGE(PG8_SB(0, 0), cB, voffB); PG8_STAGE(PG8_SB(0, 1), cB + hstepB, voffB); PG8_STAGE(PG8_SA(0, 0), cA, voffA); PG8_STAGE(PG8_SA(0, 1), cA + hstepA, voffA);
        if (wr == 1) PG8_BAR;
        PG8_WAIT_V(2); PG8_BAR;
        PG8_STAGE(PG8_SB(1, 0), cB + kstep, voffB); PG8_STAGE(PG8_SA(1, 0), cA + kstep, voffA); PG8_STAGE(PG8_SB(1, 1), cB + hstepB + kstep, voffB);
        PG8_WAIT_V(6); PG8_BAR;
    } else {
        PG8_STAGE(PG8_SB(0, 0), cB, voffB); PG8_STAGE(PG8_SA(0, 0), cA, voffA); PG8_STAGE(PG8_SB(0, 1), cB + hstepB, voffB); PG8_STAGE(PG8_SA(0, 1), cA + hstepA, voffA);
        if (wr == 1) PG8_BAR;
        PG8_WAIT_V(4); PG8_BAR;
        PG8_STAGE(PG8_SB(1, 0), cB + kstep, voffB); PG8_STAGE(PG8_SA(1, 0), cA + kstep, voffA); PG8_STAGE(PG8_SB(1, 1), cB + hstepB + kstep, voffB);
        PG8_WAIT_V(6); PG8_BAR;
    }
    for (;;) {
        const bool has_next = S.next(ui + 1, nxt);
        const char* nA = has_next ? (const char*)g.A + (size_t)nxt.pm * tstepA + (size_t)nxt.za * 2 : cA; const char* nB = has_next ? (const char*)g.Bt + (size_t)nxt.pn * tstepB : cB;
        for (int t = 0; t < nt; t += 2) {
            const bool last = (t == nt - 2);
            const char* a1 = cA + (size_t)(t + 1) * kstep;
            const char* a2 = last ? nA : cA + (size_t)(t + 2) * kstep; const char* b2 = last ? nB : cB + (size_t)(t + 2) * kstep;
            const char* a3 = a2 + kstep; const char* b3 = b2 + kstep;
            if (last && has_next) S.a_ready(nxt);
            if constexpr (SP2) {
            PG8_LDB(B0, 0, 0); PG8_LDB(B1, 0, 1); PG8_SCHED; PG8_LDA(At, 0, 0); PG8_STAGE(PG8_SA(1, 1), a1 + hstepA, voffA);
            PG8_WAIT_V(8); PG8_WAIT_L(0); PG8_BAR; PG8_MMA(0, 0, At, B0); PG8_MMA(0, 1, At, B1); PG8_BAR; PG8_SCHED;
            PG8_LDA(At, 0, 1); PG8_STAGE(PG8_SB(0, 0), b2, voffB); PG8_STAGE(PG8_SB(0, 1), b2 + hstepB, voffB); PG8_STAGE(PG8_SA(0, 0), a2, voffA);
            PG8_WAIT_V(8); PG8_WAIT_L(0); PG8_BAR; PG8_MMA(1, 0, At, B0); PG8_MMA(1, 1, At, B1); PG8_BAR; PG8_SCHED;
            PG8_LDB(B0, 1, 0); PG8_LDB(B1, 1, 1); PG8_SCHED; PG8_LDA(At, 1, 0); PG8_STAGE(PG8_SA(0, 1), a2 + hstepA, voffA);
            PG8_WAIT_V(8); PG8_WAIT_L(0); PG8_BAR; PG8_MMA(0, 0, At, B0); PG8_MMA(0, 1, At, B1); PG8_BAR; PG8_SCHED;
            PG8_LDA(At, 1, 1); PG8_STAGE(PG8_SB(1, 0), b3, voffB); PG8_STAGE(PG8_SB(1, 1), b3 + hstepB, voffB); PG8_STAGE(PG8_SA(1, 0), a3, voffA);
            PG8_WAIT_V(8); PG8_WAIT_L(0); PG8_BAR; PG8_MMA(1, 0, At, B0); PG8_MMA(1, 1, At, B1); PG8_BAR; PG8_SCHED;
            } else {
            PG8_LDB(B0, 0, 0); PG8_SCHED; PG8_LDA(At, 0, 0); PG8_STAGE(PG8_SA(1, 1), a1 + hstepA, voffA);
            PG8_WAIT_L(8); PG8_BAR; PG8_WAIT_L(0); PG8_MMA(0, 0, At, B0); PG8_BAR; PG8_SCHED;
            PG8_LDB(B1, 0, 1); PG8_STAGE(PG8_SB(0, 0), b2, voffB);
            PG8_BAR; PG8_WAIT_L(0); PG8_MMA(0, 1, At, B1); PG8_BAR;
            PG8_LDA(At, 0, 1); PG8_STAGE(PG8_SA(0, 0), a2, voffA);
            PG8_BAR; PG8_WAIT_L(0); PG8_MMA(1, 0, At, B0); PG8_BAR; PG8_SCHED;
            PG8_STAGE(PG8_SB(0, 1), b2 + hstepB, voffB);
            PG8_WAIT_V(6); PG8_BAR; PG8_MMA(1, 1, At, B1); PG8_BAR;
            PG8_LDB(B0, 1, 0); PG8_SCHED; PG8_LDA(At, 1, 0); PG8_STAGE(PG8_SA(0, 1), a2 + hstepA, voffA);
            PG8_WAIT_L(8); PG8_BAR; PG8_WAIT_L(0); PG8_MMA(0, 0, At, B0); PG8_BAR; PG8_SCHED;
            PG8_LDB(B1, 1, 1); PG8_STAGE(PG8_SB(1, 0), b3, voffB);
            PG8_BAR; PG8_WAIT_L(0); PG8_MMA(0, 1, At, B1); PG8_BAR;
            PG8_LDA(At, 1, 1); PG8_STAGE(PG8_SA(1, 0), a3, voffA);
            PG8_BAR; PG8_WAIT_L(0); PG8_MMA(1, 0, At, B0); PG8_BAR; PG8_SCHED;
            PG8_STAGE(PG8_SB(1, 1), b3 + hstepB, voffB);
            PG8_WAIT_V(6); PG8_BAR; PG8_MMA(1, 1, At, B1); PG8_BAR;
            }
        }
        if constexpr (ALIGN_EPI) { if (wr == 0) PG8_BAR; }
        if constexpr (!Epi::AFTER_DRAIN) { E(acc, cur, wr, wc, fr, fq); S.done(cur); }
        if (!has_next) break;
#pragma unroll
        for (int a = 0; a < 2; ++a)
#pragma unroll
            for (int b = 0; b < 2; ++b)
#pragma unroll
                for (int m = 0; m < 4; ++m)
#pragma unroll
                    for (int n = 0; n < 2; ++n) acc[a][b][m][n] = (f32x4){0.f, 0.f, 0.f, 0.f};
        cur = nxt; cA = nA; cB = nB; ++ui;
        if constexpr (ALIGN_EPI) { if (wr == 1) PG8_BAR; }
    }
    PG8_WAIT_V(0);
    if constexpr (!ALIGN_EPI) { if (wr == 0) PG8_BAR; }
    PG8_BAR;
    if constexpr (Epi::AFTER_DRAIN) { E.fused(acc, cur, wr, wc, fr, fq, lds, wid, lane); S.done(cur); }
#undef PG8_SA
#undef PG8_SB
#undef PG8_STAGE
#undef PG8_LDA
#undef PG8_LDB
#undef PG8_MMA
#undef PG8_WAIT_V
#undef PG8_WAIT_L
#undef PG8_BAR
#undef PG8_SCHED
}
}

constexpr int NB = 8, SEQ = 2048, DM = 1024, MROWS = NB * SEQ;
constexpr int NLAYER = 2;
constexpr int IN_COLS = 7728;
constexpr int P1LD = 1280, P2LD = 3840;
constexpr int C2_MQ = 0, C2_MK = 512, C2_MV = 1024, C2_GQ = 1536, C2_GK = 2048, C2_GV = 2560, C2_GZ = 3072, C2_GA = 3584, C2_GB = 3592;
constexpr int BRLD = 1536;
constexpr float LN_EPS = 1e-5f, RMS_EPS = 1e-6f;
constexpr float DN_ALPHA = 1.4142135623730951f;
constexpr int NWAVES = 8, NTHREADS = 512;

constexpr size_t KiB = 1024, MiB = 1024 * 1024;
constexpr size_t OFF_CTL = 0, CTL_BYTES = 1 * MiB;
constexpr size_t OFF_MISC = 1 * MiB;
constexpr size_t OFF_KMEAN = OFF_MISC;
constexpr size_t OFF_RSTD = OFF_MISC + 128 * KiB;
constexpr size_t OFF_GLS = OFF_MISC + 256 * KiB;
constexpr size_t OFF_TAB = 2 * MiB;
constexpr size_t OFF_COSA = OFF_TAB, OFF_SINA = OFF_TAB + 1 * MiB, OFF_COSB = OFF_TAB + 2 * MiB, OFF_SINB = OFF_TAB + 2 * MiB + 512 * KiB;
constexpr size_t OFF_W = 5 * MiB, W_LAYER = 28 * MiB;
constexpr size_t WO_IN = 0, WO_G = 10 * MiB, WO_UQ = 16 * MiB, WO_UKV = 17 * MiB + 256 * KiB, WO_BR = 17 * MiB + 768 * KiB,
                 WO_OUT = 20 * MiB + 768 * KiB, WO_PQ = 22 * MiB + 768 * KiB, WO_SK = 26 * MiB + 768 * KiB;
constexpr size_t OFF_HF = 61 * MiB, OFF_HB = 125 * MiB, OFF_RA = 157 * MiB, OFF_RB = 205 * MiB, OFF_RC = 325 * MiB, OFF_RD = 383 * MiB, WS_END = 480 * MiB;
constexpr size_t OFF_PROJ1 = OFF_RA, OFF_BR = OFF_RA;
constexpr size_t OFF_PROJ2 = OFF_RB, OFF_Y = OFF_RB, OFF_QRY = OFF_RB;
constexpr size_t OFF_QMLA = OFF_RC, OFF_KVMLA = OFF_RC + 24 * MiB, OFF_KR = OFF_RC + 56 * MiB, OFF_MERGED = OFF_RC, OFF_IDX = OFF_RC, OFF_GATE = OFF_RC + 8 * MiB;
constexpr size_t OFF_GDN = OFF_RD, OFF_GLG = OFF_RD, OFF_PU = OFF_RD, OFF_PV = OFF_RD + 32 * MiB;
constexpr int GDN_MAT = 4096;

#define GAS __attribute__((address_space(1)))
#define LAS __attribute__((address_space(3)))
typedef unsigned short bf16;
typedef short bf16x8 __attribute__((ext_vector_type(8)));
typedef short s16x4 __attribute__((ext_vector_type(4)));
typedef float f32x4 __attribute__((ext_vector_type(4)));
typedef float f32x2 __attribute__((ext_vector_type(2)));
typedef float f32x16 __attribute__((ext_vector_type(16)));
typedef unsigned u32x4 __attribute__((ext_vector_type(4)));
typedef unsigned u32x2 __attribute__((ext_vector_type(2)));

__device__ __forceinline__ unsigned f2bf(float f) { unsigned u = __builtin_bit_cast(unsigned, f); return (u + 0x7fffu + ((u >> 16) & 1u)) >> 16; }
__device__ __forceinline__ unsigned pk2(float lo, float hi) { return f2bf(lo) | (f2bf(hi) << 16); }
__device__ __forceinline__ float bflo(unsigned w) { return __builtin_bit_cast(float, w << 16); }
__device__ __forceinline__ float bfhi(unsigned w) { return __builtin_bit_cast(float, w & 0xffff0000u); }
__device__ __forceinline__ float bf1(bf16 h) { return __builtin_bit_cast(float, (unsigned)h << 16); }
__device__ __forceinline__ float wave_sum(float v) {
#pragma unroll
    for (int o = 1; o < 64; o <<= 1) v += __shfl_xor(v, o);
    return v;
}
__device__ __forceinline__ float sigmoidf_(float x) { return 1.0f / (1.0f + __expf(-x)); }
__device__ __forceinline__ float siluf_(float x) { return x / (1.0f + __expf(-x)); }
__device__ __forceinline__ float softplusf_(float x) { return x > 20.f ? x : log1pf(__expf(x)); }
__device__ __forceinline__ void unpack8(const u32x4 v, float* f) {
    f[0] = bflo(v.x); f[1] = bfhi(v.x); f[2] = bflo(v.y); f[3] = bfhi(v.y); f[4] = bflo(v.z); f[5] = bfhi(v.z); f[6] = bflo(v.w); f[7] = bfhi(v.w);
}
__device__ __forceinline__ u32x4 pack8(const float* f) { u32x4 v; v.x = pk2(f[0], f[1]); v.y = pk2(f[2], f[3]); v.z = pk2(f[4], f[5]); v.w = pk2(f[6], f[7]); return v; }

struct Params { const void* in[24]; float* out; unsigned char* ws; int pad0, pad1; };

constexpr int RING_BYTES = 131072;
constexpr int LDS_BYTES = 147456;

struct Frame {
    LAS unsigned char* lds;
    int tid, lane, wave, G, bid;
    unsigned char* ws;
};

typedef GAS unsigned gu32;
constexpr int CW_BAR = 4096;
constexpr int XB_LDS_OFF = LDS_BYTES - 32;
#define XB_TMO      128
#define XB_XCNT(j)  (256  + 64 * (j))
#define XB_XSUB(j)  (1280 + 64 * (j))
#define XB_XGEN(j)  (2304 + 64 * (j))
#define XB_TOP      3328
#define XB_TOPGEN   3392
#define XCD_BAR_WORDS 3456
#define XB_SPIN_CAP (1u << 22)

__device__ __forceinline__ unsigned xb_ld(unsigned* p)              { return __hip_atomic_load(p, __ATOMIC_RELAXED, __HIP_MEMORY_SCOPE_AGENT); }
__device__ __forceinline__ unsigned xb_add(unsigned* p, unsigned v) { return __hip_atomic_fetch_add(p, v, __ATOMIC_RELAXED, __HIP_MEMORY_SCOPE_AGENT); }
__device__ __forceinline__ unsigned xb_xcc_id() { return (unsigned)__builtin_amdgcn_s_getreg((3 << 11) | 20) & 0xFu; }
#define XB_SPIN(cond, bar) do { unsigned _sp = 0; while (cond) { __builtin_amdgcn_s_sleep(1); \
    if ((++_sp & 255u) == 0u) { if (xb_ld(&(bar)[XB_TMO])) break; if (_sp > XB_SPIN_CAP) { atomicAdd(&(bar)[XB_TMO], 1u); break; } } } } while (0)

struct XcdBarrier {
    unsigned* bar; unsigned x;
    volatile LAS unsigned* st;
};

__device__ __forceinline__ XcdBarrier xcd_barrier_post(unsigned* bar, volatile LAS unsigned* st) {
    XcdBarrier b; b.bar = bar; b.x = xb_xcc_id(); b.st = st;
    if (threadIdx.x == 0) (void)xb_add(&bar[XB_XCNT(b.x)], 1u);
    return b;
}
__device__ __forceinline__ void xcd_barrier_complete(unsigned* bar, unsigned x, unsigned& nloc, unsigned& nx) {
    const unsigned G = gridDim.x * gridDim.y * gridDim.z;
    unsigned sum, cnt, mine, sp = 0u;
    for (;;) {
        sum = 0u; cnt = 0u; mine = 0u;
#pragma unroll
        for (unsigned j = 0; j < 16; ++j) { const unsigned c = xb_ld(&bar[XB_XCNT(j)]); sum += c; cnt += (c > 0u) ? 1u : 0u; mine = (j == x) ? c : mine; }
        if (sum == G) break;
        __builtin_amdgcn_s_sleep(1);
        if ((++sp & 255u) == 0u) { if (xb_ld(&bar[XB_TMO])) break; if (sp > XB_SPIN_CAP) { atomicAdd(&bar[XB_TMO], 1u); break; } }
    }
    nloc = mine > 0u ? mine : 1u; nx = cnt > 0u ? cnt : 1u;
}

__device__ __forceinline__ void xcd_barrier(const XcdBarrier& b) {
    asm volatile("s_waitcnt vmcnt(0)" ::: "memory");
    __syncthreads();
    if (threadIdx.x == 0) {
        unsigned* bar = b.bar;
        __builtin_amdgcn_s_waitcnt(0);
        unsigned nloc = b.st[0], nx = b.st[1];
        if (nloc == 0u) { xcd_barrier_complete(bar, b.x, nloc, nx); b.st[0] = nloc; b.st[1] = nx; }
        const unsigned old = xb_add(&bar[XB_XSUB(b.x)], 1u);
        const unsigned gen = old / nloc;
        if (old + 1u == (gen + 1u) * nloc) {
            __builtin_amdgcn_fence(__ATOMIC_RELEASE, "agent");
            asm volatile("s_waitcnt vmcnt(0)" ::: "memory");
            const unsigned og = xb_add(&bar[XB_TOP], 1u);
            const unsigned tg = og / nx;
            if (og + 1u == (tg + 1u) * nx) xb_add(&bar[XB_TOPGEN], 1u);
            else XB_SPIN(xb_ld(&bar[XB_TOPGEN]) == tg, bar);
            __builtin_amdgcn_fence(__ATOMIC_ACQUIRE, "agent");
            xb_add(&bar[XB_XGEN(b.x)], 1u);
            asm volatile("s_waitcnt vmcnt(0)" ::: "memory");
        } else {
            XB_SPIN(xb_ld(&bar[XB_XGEN(b.x)]) == gen, bar);
            __builtin_amdgcn_fence(__ATOMIC_ACQUIRE, "agent");
            asm volatile("s_waitcnt vmcnt(0)" ::: "memory");
        }
    }
    __syncthreads();
}

#define LDS_WAIT() asm volatile("s_waitcnt lgkmcnt(0)" ::: "memory")
#define VM_WAIT() asm volatile("s_waitcnt vmcnt(0)" ::: "memory")
__device__ __forceinline__ float ld_coh_f32(float* p) { return __hip_atomic_load(p, __ATOMIC_RELAXED, __HIP_MEMORY_SCOPE_AGENT); }

__device__ __forceinline__ void ln_row(const float* xrow, const float* g, const float* bta, float* of32, bf16* obf, int lane, float pre = 1.0f) {
    const f32x4* xr = (const f32x4*)xrow + lane;
    f32x4 v[4]; float s = 0.f;
#pragma unroll
    for (int j = 0; j < 4; ++j) { v[j] = xr[64 * j] * pre; s += (v[j].x + v[j].y) + (v[j].z + v[j].w); }
    const float mean = wave_sum(s) * (1.f / 1024.f); float s2 = 0.f;
#pragma unroll
    for (int j = 0; j < 4; ++j) { v[j] = v[j] - mean; s2 += (v[j].x * v[j].x + v[j].y * v[j].y) + (v[j].z * v[j].z + v[j].w * v[j].w); }
    const float rstd = 1.f / sqrtf(wave_sum(s2) * (1.f / 1024.f) + LN_EPS);
    const f32x4* gr = (const f32x4*)g + lane; const f32x4* br = (const f32x4*)bta + lane;
    f32x4* o4 = (f32x4*)of32 + lane; u32x2* o8 = (u32x2*)obf + lane;
#pragma unroll
    for (int j = 0; j < 4; ++j) { const f32x4 o = v[j] * rstd * gr[64 * j] + br[64 * j]; if (of32) o4[64 * j] = o; u32x2 w; w.x = pk2(o.x, o.y); w.y = pk2(o.z, o.w); o8[64 * j] = w; }
}

__device__ __forceinline__ void transpose_item(const float* W, int ldw, int c_off, int n_valid, const float* kscale, bf16* WT, int K, int row0, LAS float* scr, int kb, int nb, int lane) {
    const int k0 = 64 * kb, n0 = 32 * nb;
#pragma unroll 8
    for (int i = 0; i < 32; ++i) { const int kk = 2 * i + (lane >> 5), n = n0 + (lane & 31);
        float v = (n < n_valid) ? W[(size_t)(k0 + kk) * ldw + c_off + n] : 0.f; if (kscale) v *= kscale[k0 + kk];
        scr[kk * 33 + (lane & 31)] = v; }
    LDS_WAIT(); asm volatile("" ::: "memory");
    const int c = lane & 7;
#pragma unroll
    for (int j = 0; j < 4; ++j) { const int n = (lane >> 3) + 8 * j; const LAS float* s = scr + (8 * c) * 33 + n;
        u32x4 o; o.x = pk2(s[0 * 33], s[1 * 33]); o.y = pk2(s[2 * 33], s[3 * 33]); o.z = pk2(s[4 * 33], s[5 * 33]); o.w = pk2(s[6 * 33], s[7 * 33]);
        *(u32x4*)(WT + (size_t)(row0 + n0 + n) * K + k0 + 8 * c) = o; }
    LDS_WAIT(); asm volatile("" ::: "memory");
}

__device__ __forceinline__ void p0_prologue(const Frame& F, const Params& P) {
    LAS float* scr = (LAS float*)(F.lds + F.wave * 16384);
    const int gw = F.bid * NWAVES + F.wave, NGW = F.G * NWAVES;
    constexpr int I_IN1 = 16 * 40, I_IN2 = 16 * 120, I_G = 16 * 96, I_UQ = 12 * 24, I_UKV = 4 * 32, I_BR = 8 * 32, I_OUT = 16 * 32, I_PQ = 16 * 64;
    constexpr int I_LAYER = I_IN1 + I_IN2 + I_G + I_UQ + I_UKV + 3 * I_BR + I_OUT + I_PQ;
    for (int it = gw; it < NLAYER * I_LAYER; it += NGW) {
        const int l = it / I_LAYER; int r = it % I_LAYER;
        unsigned char* wl = F.ws + OFF_W + (size_t)l * W_LAYER;
        const float* w_in = (const float*)P.in[4] + (size_t)l * 1024 * IN_COLS;
        if (r < I_IN1) { transpose_item(w_in, IN_COLS, 0, 1056, nullptr, (bf16*)(wl + WO_IN), 1024, 0, scr, r / 40, r % 40, F.lane); continue; } r -= I_IN1;
        if (r < I_IN2) { transpose_item(w_in, IN_COLS, 1056, 3600, nullptr, (bf16*)(wl + WO_IN), 1024, 1280, scr, r / 120, r % 120, F.lane); continue; } r -= I_IN2;
        if (r < I_G) { transpose_item(w_in, IN_COLS, 4656, 3072, nullptr, (bf16*)(wl + WO_G), 1024, 0, scr, r / 96, r % 96, F.lane); continue; } r -= I_G;
        if (r < I_UQ) { transpose_item((const float*)P.in[7] + (size_t)l * 768 * 768, 768, 0, 768, (const float*)P.in[5] + l * 768, (bf16*)(wl + WO_UQ), 768, 0, scr, r / 24, r % 24, F.lane); continue; } r -= I_UQ;
        if (r < I_UKV) { transpose_item((const float*)P.in[8] + (size_t)l * 256 * 1024, 1024, 0, 1024, (const float*)P.in[6] + l * 256, (bf16*)(wl + WO_UKV), 256, 0, scr, r / 32, r % 32, F.lane); continue; } r -= I_UKV;
        if (r < 3 * I_BR) { const int n = r / I_BR; r %= I_BR;
            transpose_item((const float*)P.in[14] + ((size_t)l * 3 + n) * 512 * 1024, 1024, 0, 1024, nullptr, (bf16*)(wl + WO_BR) + (size_t)n * 1024 * 512, 512, 0, scr, r / 32, r % 32, F.lane); continue; } r -= 3 * I_BR;
        if (r < I_OUT) { transpose_item((const float*)P.in[15] + (size_t)l * 1024 * 1024, 1024, 0, 1024, nullptr, (bf16*)(wl + WO_OUT), 1024, 0, scr, r / 32, r % 32, F.lane); continue; } r -= I_OUT;
        transpose_item((const float*)P.in[18] + (size_t)l * 1024 * 2048, 2048, 0, 2048, nullptr, (bf16*)(wl + WO_PQ), 1024, 0, scr, r / 64, r % 64, F.lane);
    }
    const int gt = F.bid * NTHREADS + F.tid, NGT = F.G * NTHREADS;
    for (int i = gt; i < NLAYER * 65536; i += NGT) {
        const int l = i / 65536, e = (i % 65536) * 4;
        const f32x4 v = *(const f32x4*)((const float*)P.in[19] + (size_t)l * 262144 + e);
        u32x2 w; w.x = pk2(v.x, v.y); w.y = pk2(v.z, v.w);
        *(u32x2*)((bf16*)(F.ws + OFF_W + (size_t)l * W_LAYER + WO_SK) + e) = w;
    }
    {
        float* cosA = (float*)(F.ws + OFF_COSA); float* sinA = (float*)(F.ws + OFF_SINA); float* cosB = (float*)(F.ws + OFF_COSB); float* sinB = (float*)(F.ws + OFF_SINB);
        const int* pos = (const int*)P.in[1];
        for (int i = gt; i < MROWS * 24; i += NGT) {
            const int m = i / 24, j = i % 24; const float p = (float)pos[m];
            if (j < 16) { const float inv = powf(500000.0f, -(float)(2 * j) / 32.0f); const float a = p * inv; cosA[m * 16 + j] = cosf(a); sinA[m * 16 + j] = sinf(a); }
            else { const int jj = j - 16; const float inv = powf(500000.0f, -(float)(2 * jj) / 16.0f); const float a = p * inv; cosB[m * 8 + jj] = cosf(a); sinB[m * 8 + jj] = sinf(a); }
        }
    }
    for (int m = gw; m < MROWS; m += NGW)
        ln_row((const float*)P.in[0] + (size_t)m * DM, (const float*)P.in[2], (const float*)P.in[3], (float*)(F.ws + OFF_HF) + (size_t)m * DM, (bf16*)(F.ws + OFF_HB) + (size_t)m * DM, F.lane);
}

__device__ __forceinline__ void peer_tables(const Frame& F, const Params& P, int l) {
    const int gt = F.bid * NTHREADS + F.tid, NGT = F.G * NTHREADS;
    const float* u = (const float*)P.in[20] + (size_t)l * 16384 * 1024; const float* v = (const float*)P.in[21] + (size_t)l * 16384 * 1024;
    bf16* pu = (bf16*)(F.ws + OFF_PU); bf16* pv = (bf16*)(F.ws + OFF_PV);
    for (int i = gt; i < 2 * 2097152; i += NGT) {
        const bool isv = i >= 2097152; const size_t e = (size_t)(isv ? i - 2097152 : i) * 8;
        const float* s = (isv ? v : u) + e; const f32x4 a = *(const f32x4*)s, b = *(const f32x4*)(s + 4);
        u32x4 w; w.x = pk2(a.x, a.y); w.y = pk2(a.z, a.w); w.z = pk2(b.x, b.y); w.w = pk2(b.z, b.w);
        *(u32x4*)((isv ? pv : pu) + e) = w;
    }
}

namespace epi {
using pg8::Unit; using pg8::HALF; using pg8::BM;

struct Proj {
    static constexpr bool PERM = true, AFTER_DRAIN = false;
    bf16* P1; bf16* P2;
    __device__ __forceinline__ void operator()(const f32x4 (&acc)[2][2][4][2], const Unit& u, int wr, int wc, int fr, int fq) const {
        const int row0 = u.pm * BM + wr * 64 + fr;
        bf16* base; int ldc, colt;
        if (u.pn < 5) { base = P1; ldc = P1LD; colt = u.pn * BM; } else { base = P2; ldc = P2LD; colt = (u.pn - 5) * BM; }
        const int col0 = colt + wc * 32 + 8 * fq;
#pragma unroll
        for (int ai = 0; ai < 2; ++ai)
#pragma unroll
            for (int m = 0; m < 4; ++m) { bf16* rowp = base + (size_t)(row0 + ai * HALF + m * 16) * ldc + col0;
#pragma unroll
                for (int bj = 0; bj < 2; ++bj) { const f32x4 v0 = acc[ai][bj][m][0], v1 = acc[ai][bj][m][1];
                    u32x4 w; w.x = pk2(v0[0], v0[1]); w.y = pk2(v0[2], v0[3]); w.z = pk2(v1[0], v1[1]); w.w = pk2(v1[2], v1[3]);
                    *(u32x4*)(rowp + bj * HALF) = w; } }
    }
};
struct Store {
    static constexpr bool PERM = true, AFTER_DRAIN = false;
    bf16* O; int ldc; const float* rs; int rsel;
    __device__ __forceinline__ void operator()(const f32x4 (&acc)[2][2][4][2], const Unit& u, int wr, int wc, int fr, int fq) const {
        const int row0 = u.pm * BM + wr * 64 + fr; const int col0 = u.pn * BM + wc * 32 + 8 * fq;
#pragma unroll
        for (int ai = 0; ai < 2; ++ai)
#pragma unroll
            for (int m = 0; m < 4; ++m) { const int row = row0 + ai * HALF + m * 16; bf16* rowp = O + (size_t)row * ldc + col0;
                const float sc = rs ? rs[(size_t)row * 2 + rsel] : 1.0f;
#pragma unroll
                for (int bj = 0; bj < 2; ++bj) { const f32x4 v0 = acc[ai][bj][m][0] * sc, v1 = acc[ai][bj][m][1] * sc;
                    u32x4 w; w.x = pk2(v0[0], v0[1]); w.y = pk2(v0[2], v0[3]); w.z = pk2(v1[0], v1[1]); w.w = pk2(v1[2], v1[3]);
                    *(u32x4*)(rowp + bj * HALF) = w; } }
    }
};
struct Merge {
    static constexpr bool PERM = true, AFTER_DRAIN = false;
    bf16* MG; const bf16* GLG; const float* gbias;
    __device__ __forceinline__ void operator()(const f32x4 (&acc)[2][2][4][2], const Unit& u, int wr, int wc, int fr, int fq) const {
        const int n = u.tag; const int row0 = u.pm * BM + wr * 64 + fr; const int col0 = (u.pn & 3) * BM + wc * 32 + 8 * fq;
        if (n > 0) asm volatile("s_waitcnt vmcnt(0)" ::: "memory");
#pragma unroll
        for (int ai = 0; ai < 2; ++ai)
#pragma unroll
            for (int m = 0; m < 4; ++m) { const int row = row0 + ai * HALF + m * 16;
#pragma unroll
                for (int bj = 0; bj < 2; ++bj) { const int col = col0 + bj * HALF;
                    const u32x4 gl = *(const u32x4*)(GLG + (size_t)row * 3072 + n * 1024 + col);
                    const f32x4 b0 = *(const f32x4*)(gbias + n * 1024 + col), b1 = *(const f32x4*)(gbias + n * 1024 + col + 4);
                    float g[8]; unpack8(gl, g);
                    float v[8];
                    const f32x4 a0 = acc[ai][bj][m][0], a1 = acc[ai][bj][m][1];
                    v[0] = a0[0] * sigmoidf_(g[0] + b0[0]); v[1] = a0[1] * sigmoidf_(g[1] + b0[1]); v[2] = a0[2] * sigmoidf_(g[2] + b0[2]); v[3] = a0[3] * sigmoidf_(g[3] + b0[3]);
                    v[4] = a1[0] * sigmoidf_(g[4] + b1[0]); v[5] = a1[1] * sigmoidf_(g[5] + b1[1]); v[6] = a1[2] * sigmoidf_(g[6] + b1[2]); v[7] = a1[3] * sigmoidf_(g[7] + b1[3]);
                    bf16* mp = MG + (size_t)row * 1024 + col;
                    if (n > 0) {
                        const unsigned long long p0 = __hip_atomic_load((const unsigned long long*)mp, __ATOMIC_RELAXED, __HIP_MEMORY_SCOPE_AGENT);
                        const unsigned long long p1 = __hip_atomic_load((const unsigned long long*)mp + 1, __ATOMIC_RELAXED, __HIP_MEMORY_SCOPE_AGENT);
                        u32x4 pv; pv.x = (unsigned)p0; pv.y = (unsigned)(p0 >> 32); pv.z = (unsigned)p1; pv.w = (unsigned)(p1 >> 32);
                        float pf[8]; unpack8(pv, pf);
#pragma unroll
                        for (int e = 0; e < 8; ++e) v[e] += pf[e];
                    }
                    *(u32x4*)mp = pack8(v); } }
    }
};
struct OutRes {
    static constexpr bool PERM = true, AFTER_DRAIN = false;
    float* Y; const float* H;
    __device__ __forceinline__ void operator()(const f32x4 (&acc)[2][2][4][2], const Unit& u, int wr, int wc, int fr, int fq) const {
        const int row0 = u.pm * BM + wr * 64 + fr; const int col0 = u.pn * BM + wc * 32 + 8 * fq;
#pragma unroll
        for (int ai = 0; ai < 2; ++ai)
#pragma unroll
            for (int m = 0; m < 4; ++m) { const size_t off = (size_t)(row0 + ai * HALF + m * 16) * 1024 + col0;
#pragma unroll
                for (int bj = 0; bj < 2; ++bj) {
                    const f32x4 h0 = *(const f32x4*)(H + off + bj * HALF), h1 = *(const f32x4*)(H + off + bj * HALF + 4);
                    *(f32x4*)(Y + off + bj * HALF) = h0 * DN_ALPHA + acc[ai][bj][m][0]; *(f32x4*)(Y + off + bj * HALF + 4) = h1 * DN_ALPHA + acc[ai][bj][m][1]; } }
    }
};
struct MergeOrder {
    pg8::StaticOrder so;
    __device__ void init(int G, int c) { so.init(MROWS, 1024, G, c); }
    __device__ bool next(int i, Unit& u) const {
        Unit b; if (!so.next(i / 3, b)) return false; const int n = i % 3;
        u.pm = b.pm; u.pn = 4 * n + b.pn; u.za = 512 * n; u.tag = n; return true;
    }
    __device__ __forceinline__ void a_ready(const Unit&) const {}
    __device__ __forceinline__ void done(const Unit&) const {}
};
}

__device__ __forceinline__ void p2_moba_block(const Frame& F, int u) {
    bf16* P2 = (bf16*)(F.ws + OFF_PROJ2);
    const float* cosB = (const float*)(F.ws + OFF_COSB); const float* sinB = (const float*)(F.ws + OFF_SINB);
    const int c = F.tid & 63, rg = F.tid >> 6;
    const int hh = c >> 3, cc = c & 7;
    float acc[16];
#pragma unroll
    for (int e = 0; e < 16; ++e) acc[e] = 0.f;
    for (int r = rg; r < 256; r += 8) {
        const size_t m = (size_t)u * 256 + r;
        if (cc <= 1) {
            bf16* p = P2 + m * P2LD + (cc == 0 ? C2_MK : C2_MQ) + hh * 64;
            const u32x4 a = *(const u32x4*)p, b = *(const u32x4*)(p + 8);
            float x1[8], x2[8], o1[8], o2[8]; unpack8(a, x1); unpack8(b, x2);
            const f32x4 c0 = *(const f32x4*)(cosB + m * 8), c1 = *(const f32x4*)(cosB + m * 8 + 4), s0 = *(const f32x4*)(sinB + m * 8), s1 = *(const f32x4*)(sinB + m * 8 + 4);
            const float cs[8] = {c0[0], c0[1], c0[2], c0[3], c1[0], c1[1], c1[2], c1[3]}, sn[8] = {s0[0], s0[1], s0[2], s0[3], s1[0], s1[1], s1[2], s1[3]};
#pragma unroll
            for (int e = 0; e < 8; ++e) { o1[e] = x1[e] * cs[e] - x2[e] * sn[e]; o2[e] = x2[e] * cs[e] + x1[e] * sn[e]; }
            const u32x4 w1 = pack8(o1), w2 = pack8(o2);
            *(u32x4*)p = w1; *(u32x4*)(p + 8) = w2;
            if (cc == 0) { float r1[8], r2[8]; unpack8(w1, r1); unpack8(w2, r2);
#pragma unroll
                for (int e = 0; e < 8; ++e) { acc[e] += r1[e]; acc[8 + e] += r2[e]; } }
        } else {
            const u32x4 a = *(const u32x4*)(P2 + m * P2LD + C2_MK + 8 * c);
            float x[8]; unpack8(a, x);
#pragma unroll
            for (int e = 0; e < 8; ++e) acc[e] += x[e];
        }
    }
    LAS float* red = (LAS float*)F.lds;
    __syncthreads();
    if (cc == 0) {
#pragma unroll
        for (int e = 0; e < 16; ++e) red[rg * 512 + hh * 64 + e] = acc[e];
    } else if (cc >= 2) {
#pragma unroll
        for (int e = 0; e < 8; ++e) red[rg * 512 + 8 * c + e] = acc[e];
    }
    __syncthreads();
    {
        float s = 0.f;
#pragma unroll
        for (int g = 0; g < 8; ++g) s += red[g * 512 + F.tid];
        const int b = u >> 3, blk = u & 7, h = F.tid >> 6, d = F.tid & 63;
        ((float*)(F.ws + OFF_KMEAN))[((b * 8 + blk) * 8 + h) * 64 + d] = s * (1.0f / 256.0f);
    }
    __syncthreads();
}

__device__ __forceinline__ void p2_row(const Frame& F, int m) {
    const bf16* P1 = (const bf16*)(F.ws + OFF_PROJ1) + (size_t)m * P1LD;
    const int lane = F.lane;
    float sq = 0.f, skv = 0.f;
    {
        const u32x4 a = *(const u32x4*)(P1 + 8 * lane); float x[8]; unpack8(a, x);
#pragma unroll
        for (int e = 0; e < 8; ++e) sq += x[e] * x[e];
        if (lane < 32) { const u32x4 b = *(const u32x4*)(P1 + 512 + 8 * lane); unpack8(b, x);
#pragma unroll
            for (int e = 0; e < 8; ++e) sq += x[e] * x[e]; }
        else { const u32x4 b = *(const u32x4*)(P1 + 768 + 8 * (lane - 32)); unpack8(b, x);
#pragma unroll
            for (int e = 0; e < 8; ++e) skv += x[e] * x[e]; }
    }
    sq = wave_sum(sq); skv = wave_sum(skv);
    if (lane == 0) { float* rs = (float*)(F.ws + OFF_RSTD) + (size_t)m * 2; rs[0] = 1.0f / sqrtf(sq * (1.0f / 768.0f) + RMS_EPS); rs[1] = 1.0f / sqrtf(skv * (1.0f / 256.0f) + RMS_EPS); }
    if (lane < 16) {
        const float x1 = bf1(P1[1024 + lane]), x2 = bf1(P1[1040 + lane]);
        const float c = ((const float*)(F.ws + OFF_COSA))[(size_t)m * 16 + lane], s = ((const float*)(F.ws + OFF_SINA))[(size_t)m * 16 + lane];
        bf16* kr = (bf16*)(F.ws + OFF_KR) + (size_t)m * 32;
        kr[lane] = (bf16)f2bf(x1 * c - x2 * s); kr[16 + lane] = (bf16)f2bf(x2 * c + x1 * s);
    }
}

template <int I> struct SubstRow {
    static __device__ __forceinline__ void run(float (&t)[64], const LAS float* A, int c) {
        float s0 = (I == c) ? 1.0f : 0.0f, s1 = 0.f, s2 = 0.f, s3 = 0.f;
        const LAS float* row = A + I * 68;
#pragma unroll
        for (int j = 0; j + 3 < I; j += 4) { const f32x4 a = *(const LAS f32x4*)(row + j); s0 -= a[0] * t[j]; s1 -= a[1] * t[j + 1]; s2 -= a[2] * t[j + 2]; s3 -= a[3] * t[j + 3]; }
#pragma unroll
        for (int j = (I / 4) * 4; j < I; ++j) s0 -= row[j] * t[j];
        t[I] = (s0 + s1) + (s2 + s3);
        SubstRow<I + 1>::run(t, A, c);
    }
};
template <> struct SubstRow<64> { static __device__ __forceinline__ void run(float (&)[64], const LAS float*, int) {} };

__device__ __forceinline__ void gdn_chunk_wave(const Frame& F, const Params& P, int l, int ch, LAS float* Asm) {
    const int lane = F.lane, i16 = lane & 15, kq = lane >> 4;
    const int h = ch & 7, c = (ch >> 3) & 31, b = ch >> 8;
    const size_t t0 = (size_t)b * SEQ + c * 64;
    const bf16* P2 = (const bf16*)(F.ws + OFF_PROJ2);
    bf16* G = (bf16*)(F.ws + OFF_GDN) + (size_t)ch * 6 * GDN_MAT;
    const float* convw = (const float*)P.in[9] + (size_t)l * 4 * 1536;
    float g, beta;
    {
        const float ga = bf1(P2[(t0 + lane) * P2LD + C2_GA + h]), gb = bf1(P2[(t0 + lane) * P2LD + C2_GB + h]);
        const float Al = ((const float*)P.in[10])[l * 8 + h], dtb = ((const float*)P.in[11])[l * 8 + h];
        g = -__expf(Al) * softplusf_(ga + dtb); beta = sigmoidf_(gb);
    }
    float gc = g;
#pragma unroll
    for (int o = 1; o < 64; o <<= 1) { const float t = __shfl_up(gc, o); if (lane >= o) gc += t; }
    const float glast = __shfl(gc, 63);
    if (lane == 0) ((float*)(F.ws + OFF_GLS))[ch] = __expf(glast);
    bf16x8 qf[4][2], kf[4][2];
    float gct[4], btk[4];
#pragma unroll
    for (int mt = 0; mt < 4; ++mt) { gct[mt] = __shfl(gc, 16 * mt + i16); btk[mt] = __shfl(beta, 16 * mt + i16); }
    float ssq_q[4], ssq_k[4];
#pragma unroll
    for (int mt = 0; mt < 4; ++mt) { ssq_q[mt] = 0.f; ssq_k[mt] = 0.f; }
    LAS u32x4* raw = (LAS u32x4*)Asm;
#pragma unroll 1
    for (int blk = 0; blk < 6; ++blk) {
        const int w3 = blk >> 1, ks = blk & 1;
        const int c0 = 32 * ks + 8 * kq;
        const int pcol = C2_GQ + w3 * 512 + h * 64 + c0, wcol = w3 * 512 + h * 64 + c0;
        float wt[4][8];
#pragma unroll
        for (int j = 0; j < 4; ++j) { const f32x4 w0 = *(const f32x4*)(convw + j * 1536 + wcol), w1 = *(const f32x4*)(convw + j * 1536 + wcol + 4);
            wt[j][0] = w0[0]; wt[j][1] = w0[1]; wt[j][2] = w0[2]; wt[j][3] = w0[3]; wt[j][4] = w1[0]; wt[j][5] = w1[1]; wt[j][6] = w1[2]; wt[j][7] = w1[3]; }
#pragma unroll
        for (int mt = 0; mt < 4; ++mt) {
            const int tok = 16 * mt + i16;
            float a8[8];
#pragma unroll
            for (int e = 0; e < 8; ++e) a8[e] = 0.f;
#pragma unroll
            for (int j = 0; j < 4; ++j) {
                const int s = c * 64 + tok - 3 + j;
                u32x4 xv = (u32x4){0u, 0u, 0u, 0u};
                if (s >= 0) xv = *(const u32x4*)(P2 + ((size_t)b * SEQ + s) * P2LD + pcol);
                float x[8]; unpack8(xv, x);
#pragma unroll
                for (int e = 0; e < 8; ++e) a8[e] += x[e] * wt[j][e];
            }
#pragma unroll
            for (int e = 0; e < 8; ++e) a8[e] = siluf_(a8[e]);
            if (w3 == 2) {
#pragma unroll
                for (int e = 0; e < 8; ++e) G[3 * GDN_MAT + (c0 + e) * 64 + tok] = (bf16)f2bf(a8[e] * btk[mt]);
            } else {
                float ss = 0.f;
#pragma unroll
                for (int e = 0; e < 8; ++e) ss += a8[e] * a8[e];
                ssq_q[mt] += (w3 == 0) ? ss : 0.f; ssq_k[mt] += (w3 == 1) ? ss : 0.f;
                raw[((w3 * 4 + mt) * 2 + ks) * 64 + lane] = pack8(a8);
            }
        }
    }
    LDS_WAIT(); asm volatile("" ::: "memory");
#pragma unroll
    for (int mt = 0; mt < 4; ++mt) {
        const int tok = 16 * mt + i16;
        float sq = ssq_q[mt], sk = ssq_k[mt];
        sq += __shfl_xor(sq, 16); sq += __shfl_xor(sq, 32); sk += __shfl_xor(sk, 16); sk += __shfl_xor(sk, 32);
        const float rq = 0.125f / sqrtf(sq + RMS_EPS), rk = 1.0f / sqrtf(sk + RMS_EPS);
        const float eg = __expf(gct[mt]), ed = __expf(glast - gct[mt]), bt = btk[mt];
#pragma unroll
        for (int ks = 0; ks < 2; ++ks) {
            const int c0 = 32 * ks + 8 * kq;
            float q[8], k[8], tq[8], tk[8];
            unpack8(raw[((0 * 4 + mt) * 2 + ks) * 64 + lane], q); unpack8(raw[((1 * 4 + mt) * 2 + ks) * 64 + lane], k);
#pragma unroll
            for (int e = 0; e < 8; ++e) { q[e] *= rq; k[e] *= rk; }
            qf[mt][ks] = __builtin_bit_cast(bf16x8, pack8(q)); kf[mt][ks] = __builtin_bit_cast(bf16x8, pack8(k));
#pragma unroll
            for (int e = 0; e < 8; ++e) { tq[e] = q[e] * eg; tk[e] = -k[e] * bt * eg; }
            *(u32x4*)(G + 0 * GDN_MAT + tok * 64 + c0) = pack8(tq);
            *(u32x4*)(G + 1 * GDN_MAT + tok * 64 + c0) = pack8(tk);
#pragma unroll
            for (int e = 0; e < 8; ++e) G[2 * GDN_MAT + (c0 + e) * 64 + tok] = (bf16)f2bf(k[e] * ed);
        }
    }
    LDS_WAIT(); asm volatile("" ::: "memory");
#pragma unroll
    for (int mt = 0; mt < 4; ++mt) {
        const int i = 16 * mt + i16; const float bti = __shfl(beta, i);
#pragma unroll
        for (int nt = 0; nt < 4; ++nt) {
            f32x4 sqk = {0.f, 0.f, 0.f, 0.f}, skk = {0.f, 0.f, 0.f, 0.f};
            if (nt <= mt) {
#pragma unroll
                for (int ks = 0; ks < 2; ++ks) {
                    sqk = __builtin_amdgcn_mfma_f32_16x16x32_bf16(kf[nt][ks], qf[mt][ks], sqk, 0, 0, 0);
                    skk = __builtin_amdgcn_mfma_f32_16x16x32_bf16(kf[nt][ks], kf[mt][ks], skk, 0, 0, 0);
                }
            }
            float oq[4], oa[4];
#pragma unroll
            for (int r = 0; r < 4; ++r) {
                const int j = 16 * nt + 4 * kq + r; const float gcj = __shfl(gc, j);
                const float dec = (j <= i) ? __expf(gct[mt] - gcj) : 0.f;
                oq[r] = sqk[r] * dec; oa[r] = (j < i) ? skk[r] * dec * bti : 0.f;
            }
            u32x2 w; w.x = pk2(oq[0], oq[1]); w.y = pk2(oq[2], oq[3]);
            *(u32x2*)(G + 5 * GDN_MAT + i * 64 + 16 * nt + 4 * kq) = w;
            *(LAS f32x4*)(Asm + i * 68 + 16 * nt + 4 * kq) = (f32x4){oa[0], oa[1], oa[2], oa[3]};
        }
    }
    LDS_WAIT(); asm volatile("" ::: "memory");
#ifndef NO_SUBST
    float t[64];
    SubstRow<0>::run(t, Asm, lane);
#pragma unroll
    for (int i = 0; i < 64; ++i) G[4 * GDN_MAT + i * 64 + lane] = (bf16)f2bf(t[i]);
#endif
    LDS_WAIT(); asm volatile("" ::: "memory");
}

__device__ __forceinline__ void p2_phase(const Frame& F, const Params& P, int l) {
    if (F.bid < 64) p2_moba_block(F, F.bid);
    const int gw = ((F.bid + F.G - 64) % F.G) * NWAVES + F.wave, NGW = F.G * NWAVES;
    for (int m = gw; m < MROWS; m += NGW) p2_row(F, m);
    LAS float* Asm = (LAS float*)(F.lds + F.wave * 17408);
    for (int ch = gw; ch < 2048; ch += NGW) gdn_chunk_wave(F, P, l, ch, Asm);
}

typedef short v4i16_t __attribute__((ext_vector_type(4)));
__device__ __forceinline__ s16x4 ds_tr16(const LAS bf16* p) { return __builtin_bit_cast(s16x4, __builtin_amdgcn_ds_read_tr16_b64_v4i16((LAS v4i16_t*)p)); }
__device__ __forceinline__ int crow(int r, int hi) { return (r & 3) + 8 * (r >> 2) + 4 * hi; }

template <int DK, bool MOBA>
__device__ __forceinline__ void attn_unit(const Frame& F, int b, int h, int qb) {
    constexpr int KSTR = (DK == 96) ? 104 : 72;
    constexpr int VSTR = 96;
    constexpr int BUF = 64 * KSTR + 64 * VSTR;
    constexpr int NS = DK / 16;
    const int tid = F.tid, lane = F.lane, w = F.wave, ql = lane & 31, hh = lane >> 5;
    LAS bf16* L = (LAS bf16*)F.lds;
    const bf16* Qs; const bf16* Ks; const bf16* Vs; int ldq, ldk; float scale;
    if (MOBA) { const bf16* P2 = (const bf16*)(F.ws + OFF_PROJ2); Qs = P2 + C2_MQ + h * 64; Ks = P2 + C2_MK + h * 64; Vs = P2 + C2_MV + h * 64; ldq = P2LD; ldk = P2LD; scale = 0.125f * 1.4426950408889634f; }
    else { Qs = (const bf16*)(F.ws + OFF_QMLA) + h * 96; const bf16* KV = (const bf16*)(F.ws + OFF_KVMLA) + h * 128; Ks = KV; Vs = KV + 64; ldq = 768; ldk = 1024; scale = 0.10206207261596575f * 1.4426950408889634f; }
    const bf16* KR = (const bf16*)(F.ws + OFF_KR);
    const size_t mb = (size_t)b * SEQ;
    const size_t mq = mb + qb * 256 + w * 32 + ql;

    unsigned selbits = 0;
    if (MOBA) {
        if (qb <= 3) selbits = (1u << qb) - 1u;
        else {
            LAS float* kml = (LAS float*)(F.lds + 2 * BUF * 2);
            __syncthreads();
            if (tid < qb * 64) kml[tid] = ((const float*)(F.ws + OFF_KMEAN))[((b * 8 + (tid >> 6)) * 8 + h) * 64 + (tid & 63)];
            __syncthreads();
            float qv[64];
#pragma unroll
            for (int c8 = 0; c8 < 8; ++c8) { const u32x4 a = *(const u32x4*)(Qs + mq * ldq + 8 * c8); unpack8(a, qv + 8 * c8); }
            float g0 = -3e38f, g1 = -3e38f, g2 = -3e38f; int i0 = 0, i1 = 0, i2 = 0;
            for (int j = 0; j < qb; ++j) {
                float s = 0.f;
#pragma unroll
                for (int d = 0; d < 64; ++d) s += qv[d] * kml[j * 64 + d];
                if (s > g0) { g2 = g1; i2 = i1; g1 = g0; i1 = i0; g0 = s; i0 = j; }
                else if (s > g1) { g2 = g1; i2 = i1; g1 = s; i1 = j; }
                else if (s > g2) { g2 = s; i2 = j; }
            }
            selbits = (1u << i0) | (1u << i1) | (1u << i2);
        }
    }
    bf16x8 qf[NS];
    {
        float qx[NS][8];
#pragma unroll
        for (int s = 0; s < NS; ++s) { const u32x4 a = *(const u32x4*)(Qs + mq * ldq + 16 * s + 8 * hh); unpack8(a, qx[s]); }
        if (!MOBA) {
            const float* cp = (const float*)(F.ws + OFF_COSA) + mq * 16 + 8 * hh; const float* sp = (const float*)(F.ws + OFF_SINA) + mq * 16 + 8 * hh;
            const f32x4 c0 = *(const f32x4*)cp, c1 = *(const f32x4*)(cp + 4), s0 = *(const f32x4*)sp, s1 = *(const f32x4*)(sp + 4);
            const float cs[8] = {c0[0], c0[1], c0[2], c0[3], c1[0], c1[1], c1[2], c1[3]}, sn[8] = {s0[0], s0[1], s0[2], s0[3], s1[0], s1[1], s1[2], s1[3]};
#pragma unroll
            for (int e = 0; e < 8; ++e) { const float x1 = qx[NS - 2][e], x2 = qx[NS - 1][e]; qx[NS - 2][e] = x1 * cs[e] - x2 * sn[e]; qx[NS - 1][e] = x2 * cs[e] + x1 * sn[e]; }
        }
#pragma unroll
        for (int s = 0; s < NS; ++s) {
#pragma unroll
            for (int e = 0; e < 8; ++e) qx[s][e] *= scale;
            qf[s] = __builtin_bit_cast(bf16x8, pack8(qx[s]));
        }
    }
    const int skr = tid >> 3, sc8 = tid & 7;
    const int rkr = tid >> 2, rc4 = tid & 3;
    const int ntile = 4 * (qb + 1);
    auto tile_of = [&](int it) -> int { return MOBA ? (it < 4 ? 4 * qb + it : it - 4) : it; };
    u32x4 rk, rv, rr;
    auto gload = [&](int t) {
        const size_t kb = mb + (size_t)t * 64;
        rk = *(const u32x4*)(Ks + (kb + skr) * ldk + 8 * sc8);
        rv = *(const u32x4*)(Vs + (kb + skr) * ldk + 8 * sc8);
        if (DK == 96 && tid < 256) rr = *(const u32x4*)(KR + (kb + rkr) * 32 + 8 * rc4);
    };
    auto lstore = [&](int buf) {
        LAS bf16* Kt = L + buf * BUF; LAS bf16* Vt = Kt + 64 * KSTR;
        *(LAS u32x4*)(Kt + skr * KSTR + 8 * sc8) = rk;
        *(LAS u32x4*)(Vt + skr * VSTR + 8 * sc8) = rv;
        if (DK == 96 && tid < 256) *(LAS u32x4*)(Kt + rkr * KSTR + 64 + 8 * rc4) = rr;
    };
    float mrun = -1e30f, lrun = 0.f;
    f32x16 o0 = {}, o1 = {};
    __syncthreads();
    gload(tile_of(0)); lstore(0);
    __syncthreads();
    for (int it = 0; it < ntile; ++it) {
        const int t = tile_of(it);
        if (it + 1 < ntile) gload(tile_of(it + 1));
        const bool diag = t >= 4 * qb; const int tb = t - 4 * qb;
        bool active = true;
        if (diag) active = tb <= (w >> 1);
        bool rowsel = true;
        if (MOBA && !diag) { rowsel = (selbits >> (t >> 2)) & 1u; active = __any(rowsel) != 0; }
        if (active) {
            const LAS bf16* Kt = L + (it & 1) * BUF; const LAS bf16* Vt = Kt + 64 * KSTR;
            f32x16 p0 = {}, p1 = {};
#pragma unroll
            for (int s = 0; s < NS; ++s) {
                const bf16x8 a0 = *(const LAS bf16x8*)(Kt + ql * KSTR + 16 * s + 8 * hh);
                const bf16x8 a1 = *(const LAS bf16x8*)(Kt + (32 + ql) * KSTR + 16 * s + 8 * hh);
                p0 = __builtin_amdgcn_mfma_f32_32x32x16_bf16(a0, qf[s], p0, 0, 0, 0);
                p1 = __builtin_amdgcn_mfma_f32_32x32x16_bf16(a1, qf[s], p1, 0, 0, 0);
            }
            if (diag) {
                const int qloc = 32 * w + ql;
#pragma unroll
                for (int r = 0; r < 16; ++r) { const int kl = 64 * tb + crow(r, hh); if (kl > qloc) p0[r] = -1e30f; if (kl + 32 > qloc) p1[r] = -1e30f; }
            }
            if (MOBA && !diag && !rowsel) {
#pragma unroll
                for (int r = 0; r < 16; ++r) { p0[r] = -1e30f; p1[r] = -1e30f; }
            }
            float mx = p0[0];
#pragma unroll
            for (int r = 1; r < 16; ++r) mx = fmaxf(mx, p0[r]);
#pragma unroll
            for (int r = 0; r < 16; ++r) mx = fmaxf(mx, p1[r]);
            mx = fmaxf(mx, __shfl_xor(mx, 32));
            const float mnew = fmaxf(mrun, mx);
            const float alpha = __builtin_amdgcn_exp2f(mrun - mnew);
            mrun = mnew;
            float ps = 0.f;
#pragma unroll
            for (int r = 0; r < 16; ++r) { p0[r] = __builtin_amdgcn_exp2f(p0[r] - mnew); p1[r] = __builtin_amdgcn_exp2f(p1[r] - mnew); ps += p0[r] + p1[r]; }
            lrun = lrun * alpha + ps;
#pragma unroll
            for (int r = 0; r < 16; ++r) { o0[r] *= alpha; o1[r] *= alpha; }
            bf16x8 pf[4];
            { float tmp[8];
#pragma unroll
              for (int e = 0; e < 8; ++e) tmp[e] = p0[e];
              pf[0] = __builtin_bit_cast(bf16x8, pack8(tmp));
#pragma unroll
              for (int e = 0; e < 8; ++e) tmp[e] = p0[8 + e];
              pf[1] = __builtin_bit_cast(bf16x8, pack8(tmp));
#pragma unroll
              for (int e = 0; e < 8; ++e) tmp[e] = p1[e];
              pf[2] = __builtin_bit_cast(bf16x8, pack8(tmp));
#pragma unroll
              for (int e = 0; e < 8; ++e) tmp[e] = p1[8 + e];
              pf[3] = __builtin_bit_cast(bf16x8, pack8(tmp)); }
            const int i15 = lane & 15, dblk = (lane >> 4) & 1;
#pragma unroll
            for (int s4 = 0; s4 < 4; ++s4) {
                const int key0 = 16 * s4 + 4 * hh;
#pragma unroll
                for (int dt = 0; dt < 2; ++dt) {
                    const LAS bf16* va = Vt + (key0 + (i15 >> 2)) * VSTR + 32 * dt + 16 * dblk + 4 * (i15 & 3);
                    const s16x4 lo = ds_tr16(va), hi2 = ds_tr16(va + 8 * VSTR);
                    const bf16x8 vf = (bf16x8){lo[0], lo[1], lo[2], lo[3], hi2[0], hi2[1], hi2[2], hi2[3]};
                    if (dt == 0) o0 = __builtin_amdgcn_mfma_f32_32x32x16_bf16(vf, pf[s4], o0, 0, 0, 0);
                    else o1 = __builtin_amdgcn_mfma_f32_32x32x16_bf16(vf, pf[s4], o1, 0, 0, 0);
                }
            }
        }
        if (it + 1 < ntile) lstore((it + 1) & 1);
        __syncthreads();
    }
    const float ltot = lrun + __shfl_xor(lrun, 32);
    const float inv = 1.0f / ltot;
    bf16* op = (bf16*)(F.ws + OFF_BR) + mq * BRLD + (MOBA ? 512 : 0) + h * 64;
#pragma unroll
    for (int g = 0; g < 4; ++g) {
        u32x2 w0, w1;
        w0.x = pk2(o0[4 * g] * inv, o0[4 * g + 1] * inv); w0.y = pk2(o0[4 * g + 2] * inv, o0[4 * g + 3] * inv);
        w1.x = pk2(o1[4 * g] * inv, o1[4 * g + 1] * inv); w1.y = pk2(o1[4 * g + 2] * inv, o1[4 * g + 3] * inv);
        *(u32x2*)(op + 8 * g + 4 * hh) = w0; *(u32x2*)(op + 32 + 8 * g + 4 * hh) = w1;
    }
}

__device__ __forceinline__ void gdn_scan_unit(const Frame& F, const Params& P, int l, int b, int h) {
    constexpr int BSTR = 72;
    constexpr int OSTR = 68;
    const int lane = F.lane, w = F.wave, i16 = lane & 15, kq = lane >> 4;
    LAS bf16* Sb = (LAS bf16*)F.lds;
    LAS bf16* XT = Sb + 64 * BSTR;
    LAS bf16* VT = XT + 64 * BSTR;
    LAS float* Ob = (LAS float*)(F.lds + 3 * 64 * BSTR * 2);
    const bf16* Gb = (const bf16*)(F.ws + OFF_GDN);
    const float* gls = (const float*)(F.ws + OFF_GLS);
    const bf16* P2 = (const bf16*)(F.ws + OFF_PROJ2);
    bf16* BR = (bf16*)(F.ws + OFF_BR);
    const float* onorm = (const float*)P.in[12] + l * 64;
    __syncthreads();
    f32x4 Sacc[4];
#pragma unroll
    for (int m = 0; m < 4; ++m) Sacc[m] = (f32x4){0.f, 0.f, 0.f, 0.f};
    if (w < 4) {
#pragma unroll
        for (int m = 0; m < 4; ++m) *(LAS u32x2*)(Sb + (16 * w + i16) * BSTR + 16 * m + 4 * kq) = (u32x2){0u, 0u};
    }
    for (int c = 0; c <= 32; ++c) {
        if (w < 4 && c < 32) {
            const int ch = (b * 32 + c) * 8 + h;
            const bf16* G = Gb + (size_t)ch * 6 * GDN_MAT;
            const float gl = ld_coh_f32((float*)gls + ch);
            const int dvr = 16 * w + i16;
#define AFRAG(mat, mt, ks) (*(const bf16x8*)(G + (mat) * GDN_MAT + (16 * (mt) + i16) * 64 + 32 * (ks) + 8 * kq))
#define BFRAG(img, ks) (*(const LAS bf16x8*)((img) + dvr * BSTR + 32 * (ks) + 8 * kq))
            f32x4 acc[4];
#pragma unroll
            for (int m = 0; m < 4; ++m) { const u32x2 vb = *(const u32x2*)(G + 3 * GDN_MAT + dvr * 64 + 16 * m + 4 * kq); acc[m] = (f32x4){bflo(vb.x), bfhi(vb.x), bflo(vb.y), bfhi(vb.y)}; }
            {
                const bf16x8 s0 = BFRAG(Sb, 0), s1 = BFRAG(Sb, 1);
#pragma unroll
                for (int m = 0; m < 4; ++m) { acc[m] = __builtin_amdgcn_mfma_f32_16x16x32_bf16(AFRAG(1, m, 0), s0, acc[m], 0, 0, 0); acc[m] = __builtin_amdgcn_mfma_f32_16x16x32_bf16(AFRAG(1, m, 1), s1, acc[m], 0, 0, 0); }
                f32x4 oacc[4];
#pragma unroll
                for (int m = 0; m < 4; ++m) { oacc[m] = __builtin_amdgcn_mfma_f32_16x16x32_bf16(AFRAG(0, m, 0), s0, (f32x4){0.f, 0.f, 0.f, 0.f}, 0, 0, 0); oacc[m] = __builtin_amdgcn_mfma_f32_16x16x32_bf16(AFRAG(0, m, 1), s1, oacc[m], 0, 0, 0); }
#pragma unroll
                for (int m = 0; m < 4; ++m) { u32x2 wv; wv.x = pk2(acc[m][0], acc[m][1]); wv.y = pk2(acc[m][2], acc[m][3]); *(LAS u32x2*)(XT + dvr * BSTR + 16 * m + 4 * kq) = wv; }
                const bf16x8 x0 = BFRAG(XT, 0), x1 = BFRAG(XT, 1);
#pragma unroll
                for (int m = 0; m < 4; ++m) { acc[m] = __builtin_amdgcn_mfma_f32_16x16x32_bf16(AFRAG(4, m, 0), x0, (f32x4){0.f, 0.f, 0.f, 0.f}, 0, 0, 0); acc[m] = __builtin_amdgcn_mfma_f32_16x16x32_bf16(AFRAG(4, m, 1), x1, acc[m], 0, 0, 0); }
#pragma unroll
                for (int m = 0; m < 4; ++m) { u32x2 wv; wv.x = pk2(acc[m][0], acc[m][1]); wv.y = pk2(acc[m][2], acc[m][3]); *(LAS u32x2*)(VT + dvr * BSTR + 16 * m + 4 * kq) = wv; }
                const bf16x8 v0 = BFRAG(VT, 0), v1 = BFRAG(VT, 1);
#pragma unroll
                for (int m = 0; m < 4; ++m) { oacc[m] = __builtin_amdgcn_mfma_f32_16x16x32_bf16(AFRAG(5, m, 0), v0, oacc[m], 0, 0, 0); oacc[m] = __builtin_amdgcn_mfma_f32_16x16x32_bf16(AFRAG(5, m, 1), v1, oacc[m], 0, 0, 0); }
                LAS float* Oc = Ob + (c & 1) * 64 * OSTR;
#pragma unroll
                for (int m = 0; m < 4; ++m)
#pragma unroll
                    for (int r = 0; r < 4; ++r) Oc[(16 * m + 4 * kq + r) * OSTR + dvr] = oacc[m][r];
#pragma unroll
                for (int m = 0; m < 4; ++m) { Sacc[m] = Sacc[m] * gl; Sacc[m] = __builtin_amdgcn_mfma_f32_16x16x32_bf16(AFRAG(2, m, 0), v0, Sacc[m], 0, 0, 0); Sacc[m] = __builtin_amdgcn_mfma_f32_16x16x32_bf16(AFRAG(2, m, 1), v1, Sacc[m], 0, 0, 0); }
#pragma unroll
                for (int m = 0; m < 4; ++m) { u32x2 wv; wv.x = pk2(Sacc[m][0], Sacc[m][1]); wv.y = pk2(Sacc[m][2], Sacc[m][3]); *(LAS u32x2*)(Sb + dvr * BSTR + 16 * m + 4 * kq) = wv; }
            }
#undef AFRAG
#undef BFRAG
        }
        if (w >= 4 && c >= 1) {
            const int cc = c - 1; const LAS float* Oc = Ob + (cc & 1) * 64 * OSTR;
            const int tok = 16 * (w - 4) + i16; const size_t m = (size_t)b * SEQ + cc * 64 + tok;
            float o[16];
#pragma unroll
            for (int q4 = 0; q4 < 4; ++q4) { const f32x4 v = *(const LAS f32x4*)(Oc + tok * OSTR + 16 * kq + 4 * q4); o[4 * q4] = v[0]; o[4 * q4 + 1] = v[1]; o[4 * q4 + 2] = v[2]; o[4 * q4 + 3] = v[3]; }
            float ss = 0.f;
#pragma unroll
            for (int e = 0; e < 16; ++e) ss += o[e] * o[e];
            ss += __shfl_xor(ss, 16); ss += __shfl_xor(ss, 32);
            const float rs = 1.0f / sqrtf(ss * (1.0f / 64.0f) + RMS_EPS);
            const bf16* zp = P2 + m * P2LD + C2_GZ + h * 64 + 16 * kq;
            float z[16]; unpack8(*(const u32x4*)zp, z); unpack8(*(const u32x4*)(zp + 8), z + 8);
            float r16[16];
#pragma unroll
            for (int e = 0; e < 16; ++e) r16[e] = o[e] * rs * onorm[16 * kq + e] * siluf_(z[e]);
            bf16* op = BR + m * BRLD + 1024 + h * 64 + 16 * kq;
            *(u32x4*)op = pack8(r16); *(u32x4*)(op + 8) = pack8(r16 + 8);
        }
        __syncthreads();
    }
}

__device__ __forceinline__ unsigned f2key(float f) { unsigned u = __builtin_bit_cast(unsigned, f); return (u & 0x80000000u) ? ~u : (u | 0x80000000u); }
__device__ __forceinline__ float key2f(unsigned k) { const unsigned u = (k & 0x80000000u) ? (k & 0x7fffffffu) : ~k; return __builtin_bit_cast(float, u); }

__device__ __forceinline__ void peer_topk_unit(const Frame& F, int l, int tt) {
    const int lane = F.lane, h = F.wave, tk = lane & 31, hh = lane >> 5;
    const size_t m = (size_t)tt * 32 + tk;
    const bf16* QRY = (const bf16*)(F.ws + OFF_QRY);
    const bf16* SK = (const bf16*)(F.ws + OFF_W + (size_t)l * W_LAYER + WO_SK);
    LAS int* li = (LAS int*)F.lds + F.tid * 33;
    unsigned top[2][16];
#pragma unroll
    for (int p = 0; p < 2; ++p) {
        bf16x8 qf[8];
#pragma unroll
        for (int s = 0; s < 8; ++s) qf[s] = *(const bf16x8*)(QRY + m * 2048 + (2 * h + p) * 128 + 16 * s + 8 * hh);
        unsigned key[64];
#pragma unroll
        for (int kt = 0; kt < 4; ++kt) {
            f32x16 acc = {};
            const bf16* kp = SK + ((size_t)(h * 2 + p) * 128 + 32 * kt + tk) * 128 + 8 * hh;
#pragma unroll
            for (int s = 0; s < 8; ++s) acc = __builtin_amdgcn_mfma_f32_32x32x16_bf16(*(const bf16x8*)(kp + 16 * s), qf[s], acc, 0, 0, 0);
#pragma unroll
            for (int r = 0; r < 16; ++r) { const int kidx = 32 * kt + crow(r, hh); key[16 * kt + r] = (f2key(acc[r]) & ~0x7fu) | (unsigned)(127 - kidx); }
        }
#pragma unroll
        for (int rd = 0; rd < 16; ++rd) {
            unsigned mx = key[0];
#pragma unroll
            for (int e = 1; e < 64; ++e) mx = mx > key[e] ? mx : key[e];
            const unsigned ox = (unsigned)__shfl_xor((int)mx, 32);
            mx = mx > ox ? mx : ox;
            top[p][rd] = mx;
#pragma unroll
            for (int e = 0; e < 64; ++e) key[e] = (key[e] == mx) ? 0u : key[e];
        }
    }
    float v1[16], v2[16];
#pragma unroll
    for (int a = 0; a < 16; ++a) { li[a] = 127 - (int)(top[0][a] & 0x7fu); li[16 + a] = 127 - (int)(top[1][a] & 0x7fu); v1[a] = key2f(top[0][a] & ~0x7fu); v2[a] = key2f(top[1][a] & ~0x7fu); }
    unsigned ck[25];
#pragma unroll
    for (int e = 0; e < 25; ++e) ck[e] = 0u;
    {
        int n = 0;
#pragma unroll
        for (int a = 0; a < 16; ++a)
#pragma unroll
            for (int bb = 0; bb < 16; ++bb)
                if ((a + 1) * (bb + 1) <= 16) {
                    const int slot = n % 25, owner = n / 25;
                    const unsigned kv = (f2key(v1[a] + v2[bb]) & ~0xffu) | (unsigned)(255 - (16 * a + bb));
                    if (owner == 0) ck[slot] = (hh == 0) ? kv : ck[slot]; else ck[slot] = (hh == 1) ? kv : ck[slot];
                    ++n;
                }
    }
    unsigned win[16];
#pragma unroll
    for (int rd = 0; rd < 16; ++rd) {
        unsigned mx = ck[0];
#pragma unroll
        for (int e = 1; e < 25; ++e) mx = mx > ck[e] ? mx : ck[e];
        const unsigned ox = (unsigned)__shfl_xor((int)mx, 32);
        mx = mx > ox ? mx : ox;
        win[rd] = mx;
#pragma unroll
        for (int e = 0; e < 25; ++e) ck[e] = (ck[e] == mx) ? 0u : ck[e];
    }
    LDS_WAIT();
    float sv[16]; int ids[16];
#pragma unroll
    for (int rd = 0; rd < 16; ++rd) {
        const int flat = 255 - (int)(win[rd] & 0xffu), a = flat >> 4, bb = flat & 15;
        const int ia = li[a], ib = li[16 + bb];
        ids[rd] = ia * 128 + ib;
        float sa = 0.f, sb = 0.f;
#pragma unroll
        for (int e = 0; e < 16; ++e) { sa = (e == a) ? v1[e] : sa; sb = (e == bb) ? v2[e] : sb; }
        sv[rd] = sa + sb;
    }
    float mxv = sv[0];
#pragma unroll
    for (int e = 1; e < 16; ++e) mxv = fmaxf(mxv, sv[e]);
    float den = 0.f;
#pragma unroll
    for (int e = 0; e < 16; ++e) { sv[e] = __expf(sv[e] - mxv); den += sv[e]; }
    const float inv = 1.0f / den;
    if (hh == 0) { int* ip = (int*)(F.ws + OFF_IDX) + m * 128 + h * 16;
#pragma unroll
        for (int q4 = 0; q4 < 4; ++q4) *(u32x4*)(ip + 4 * q4) = (u32x4){(unsigned)ids[4 * q4], (unsigned)ids[4 * q4 + 1], (unsigned)ids[4 * q4 + 2], (unsigned)ids[4 * q4 + 3]}; }
    else { float* gp = (float*)(F.ws + OFF_GATE) + m * 128 + h * 16;
#pragma unroll
        for (int q4 = 0; q4 < 4; ++q4) *(f32x4*)(gp + 4 * q4) = (f32x4){sv[4 * q4] * inv, sv[4 * q4 + 1] * inv, sv[4 * q4 + 2] * inv, sv[4 * q4 + 3] * inv}; }
    LDS_WAIT();
}

__device__ __forceinline__ float gelu_exact(float x) { return 0.5f * x * (1.0f + erff(x * 0.7071067811865475f)); }
__device__ __forceinline__ float dot8(const u32x4 a, const u32x4 b) {
    float s = bflo(a.x) * bflo(b.x); s += bfhi(a.x) * bfhi(b.x); s += bflo(a.y) * bflo(b.y); s += bfhi(a.y) * bfhi(b.y);
    s += bflo(a.z) * bflo(b.z); s += bfhi(a.z) * bfhi(b.z); s += bflo(a.w) * bflo(b.w); s += bfhi(a.w) * bfhi(b.w); return s;
}
__device__ __forceinline__ void axpy8(float* o, float w, const u32x4 v) {
    o[0] += w * bflo(v.x); o[1] += w * bfhi(v.x); o[2] += w * bflo(v.y); o[3] += w * bfhi(v.y); o[4] += w * bflo(v.z); o[5] += w * bfhi(v.z); o[6] += w * bflo(v.w); o[7] += w * bfhi(v.w);
}
__device__ __forceinline__ void peer_token(const Frame& F, const Params& P, int l, size_t m, bool last_layer, bool en_peer) {
    const int lane = F.lane;
    const bf16* PU = (const bf16*)(F.ws + OFF_PU); const bf16* PV = (const bf16*)(F.ws + OFF_PV);
    const bf16* hb = (const bf16*)(F.ws + OFF_HB) + m * DM;
    float* hf = (float*)(F.ws + OFF_HF) + m * DM;
    const u32x4 xa = *(const u32x4*)(hb + 8 * lane), xb = *(const u32x4*)(hb + 512 + 8 * lane);
    const int id0 = ((const int*)(F.ws + OFF_IDX))[m * 128 + lane], id1 = ((const int*)(F.ws + OFF_IDX))[m * 128 + 64 + lane];
    const float g0 = ((const float*)(F.ws + OFF_GATE))[m * 128 + lane], g1 = ((const float*)(F.ws + OFF_GATE))[m * 128 + 64 + lane];
    float out[16];
#pragma unroll
    for (int e = 0; e < 16; ++e) out[e] = 0.f;
    const int jl = ((lane >> 5) & 1) * 4 + ((lane >> 4) & 1) * 2 + ((lane >> 3) & 1);
#pragma unroll 1
    for (int bt = 0; bt < (en_peer ? 16 : 0); ++bt) {
        u32x4 ua[8], ub[8], va[8], vb[8];
#pragma unroll
        for (int j = 0; j < 8; ++j) {
            const int e = 8 * bt + j;
            const int id = __builtin_amdgcn_readlane(bt < 8 ? id0 : id1, e & 63);
            const bf16* up = PU + (size_t)id * 1024 + 8 * lane; const bf16* vp = PV + (size_t)id * 1024 + 8 * lane;
            ua[j] = *(const u32x4*)up; ub[j] = *(const u32x4*)(up + 512); va[j] = *(const u32x4*)vp; vb[j] = *(const u32x4*)(vp + 512);
        }
        float p[8];
#pragma unroll
        for (int j = 0; j < 8; ++j) p[j] = dot8(ua[j], xa) + dot8(ub[j], xb);
#pragma unroll
        for (int j = 0; j < 4; ++j) { const bool up_ = (lane & 32) != 0; const float send = up_ ? p[j] : p[j + 4]; const float recv = __shfl_xor(send, 32); p[j] = (up_ ? p[j + 4] : p[j]) + recv; }
#pragma unroll
        for (int j = 0; j < 2; ++j) { const bool up_ = (lane & 16) != 0; const float send = up_ ? p[j] : p[j + 2]; const float recv = __shfl_xor(send, 16); p[j] = (up_ ? p[j + 2] : p[j]) + recv; }
        { const bool up_ = (lane & 8) != 0; const float send = up_ ? p[0] : p[1]; const float recv = __shfl_xor(send, 8); p[0] = (up_ ? p[1] : p[0]) + recv; }
        float d = p[0]; d += __shfl_xor(d, 4); d += __shfl_xor(d, 2); d += __shfl_xor(d, 1);
        const int esel = 8 * bt + jl;
        const float gsel = __shfl(bt < 8 ? g0 : g1, esel & 63);
        const float wsel = gelu_exact(d) * gsel;
#pragma unroll
        for (int j = 0; j < 8; ++j) {
            const int src = ((j >> 2) & 1) * 32 + ((j >> 1) & 1) * 16 + (j & 1) * 8;
            const float wj = __builtin_bit_cast(float, __builtin_amdgcn_readlane(__builtin_bit_cast(int, wsel), src));
            axpy8(out, wj, va[j]); axpy8(out + 8, wj, vb[j]);
        }
    }
    const int lsel = last_layer ? 1 : 0; (void)lsel;
    float y[16];
    { const f32x4 a0 = *(const f32x4*)(hf + 8 * lane), a1 = *(const f32x4*)(hf + 8 * lane + 4), b0 = *(const f32x4*)(hf + 512 + 8 * lane), b1 = *(const f32x4*)(hf + 512 + 8 * lane + 4);
      const float hv[16] = {a0[0], a0[1], a0[2], a0[3], a1[0], a1[1], a1[2], a1[3], b0[0], b0[1], b0[2], b0[3], b1[0], b1[1], b1[2], b1[3]};
#pragma unroll
      for (int e = 0; e < 16; ++e) y[e] = DN_ALPHA * hv[e] + out[e]; }
    float s = 0.f;
#pragma unroll
    for (int e = 0; e < 16; ++e) s += y[e];
    const float mean = wave_sum(s) * (1.0f / 1024.0f);
    float s2 = 0.f;
#pragma unroll
    for (int e = 0; e < 16; ++e) { y[e] -= mean; s2 += y[e] * y[e]; }
    const float rstd = 1.0f / sqrtf(wave_sum(s2) * (1.0f / 1024.0f) + LN_EPS);
    const float* g = (const float*)P.in[22] + l * 1024; const float* bb = (const float*)P.in[23] + l * 1024;
#pragma unroll
    for (int half = 0; half < 2; ++half) {
        const int c0 = 512 * half + 8 * lane;
        const f32x4 ga = *(const f32x4*)(g + c0), gb = *(const f32x4*)(g + c0 + 4), ba = *(const f32x4*)(bb + c0), bc = *(const f32x4*)(bb + c0 + 4);
        float o[8];
#pragma unroll
        for (int e = 0; e < 4; ++e) { o[e] = y[8 * half + e] * rstd * ga[e] + ba[e]; o[4 + e] = y[8 * half + 4 + e] * rstd * gb[e] + bc[e]; }
        float* of = last_layer ? (P.out + m * DM + c0) : (hf + c0);
        *(f32x4*)of = (f32x4){o[0], o[1], o[2], o[3]}; *(f32x4*)(of + 4) = (f32x4){o[4], o[5], o[6], o[7]};
        if (!last_layer) *(u32x4*)((bf16*)(F.ws + OFF_HB) + m * DM + c0) = pack8(o);
    }
}

#ifndef STOP_AFTER
#define STOP_AFTER 99
#endif
constexpr int PTR_OFF = LDS_BYTES - 512;
__device__ __forceinline__ Frame make_frame(unsigned char* ws_) {
    extern __shared__ __attribute__((aligned(16))) unsigned char lds_raw[];
    Frame F; F.lds = (LAS unsigned char*)lds_raw; { int t_ = threadIdx.x; asm volatile("" : "+v"(t_)); F.tid = t_; } F.lane = F.tid & 63; F.wave = __builtin_amdgcn_readfirstlane(F.tid >> 6);
    { int g_ = gridDim.x, b_ = blockIdx.x; asm volatile("" : "+s"(g_), "+s"(b_)); F.G = g_; F.bid = b_; }
    F.ws = ws_;
    return F;
}
__device__ __forceinline__ int dequeue(const Frame& F, unsigned* ctr) {
    LAS int* slot = (LAS int*)(F.lds + LDS_BYTES - 64);
    __syncthreads();
    if (F.tid == 0) slot[0] = (int)atomicAdd(ctr, 1u);
    __syncthreads();
    const int v = slot[0];
    return v;
}
__device__ __noinline__ void grid_sync_fn() { cg::this_grid().sync(); }
__device__ __noinline__ void bar_fn(unsigned char* ws_) {
    extern __shared__ __attribute__((aligned(16))) unsigned char lds_raw[];
    XcdBarrier b; b.bar = (unsigned*)(ws_ + OFF_CTL) + CW_BAR; b.x = xb_xcc_id(); b.st = (volatile LAS unsigned*)((LAS unsigned char*)lds_raw + XB_LDS_OFF);
    xcd_barrier(b);
}
typedef pg8::StaticOrder SO;
#ifndef PHASE_FN
#define PHASE_FN __device__ __forceinline__
#endif
__device__ __forceinline__ Params fresh_params() {
    const unsigned long long* ka = (const unsigned long long*)__builtin_amdgcn_kernarg_segment_ptr(); asm volatile("" : "+s"(ka));
    Params P;
#pragma unroll
    for (int i = 0; i < 24; ++i) P.in[i] = (const void*)ka[i];
    P.out = (float*)ka[24]; P.ws = (unsigned char*)ka[25]; P.pad0 = 0; P.pad1 = 0; return P;
}
__device__ __forceinline__ Frame relaunder(const Frame& F0) {
    Frame F = F0; int t_ = F0.tid; asm volatile("" : "+v"(t_)); F.tid = t_; F.lane = t_ & 63; return F;
}
#define PHASE_PROLOG() const Params P = fresh_params(); const Frame F = make_frame(P.ws); unsigned char* ws = F.ws; (void)ws;
#define WL(l) (ws + OFF_W + (size_t)(l) * W_LAYER)

PHASE_FN void ph_p0() { PHASE_PROLOG(); p0_prologue(F, P); }
PHASE_FN void ph_p1(int l) { PHASE_PROLOG();
    pg8::Gemm g{(const pg8::bf16_t*)(ws + OFF_HB), (const pg8::bf16_t*)(WL(l) + WO_IN), MROWS, 5120, 1024, 1024, 1024};
    SO S; S.init(MROWS, 5120, F.G, F.bid);
    epi::Proj E{(bf16*)(ws + OFF_PROJ1), (bf16*)(ws + OFF_PROJ2)};
    pg8::gemm_phase<epi::Proj, SO, true, true>(F.lds, g, S, E);
}
PHASE_FN void ph_p2a() { PHASE_PROLOG(); if (F.bid < 64) p2_moba_block(F, F.bid);
    const int gw = ((F.bid + F.G - 64) % F.G) * NWAVES + F.wave, NGW = F.G * NWAVES;
    for (int m = gw; m < MROWS; m += NGW) { const Frame Fi = relaunder(F); p2_row(Fi, m); } }
PHASE_FN void ph_p2b(int l) { PHASE_PROLOG();
    const int gw = ((F.bid + F.G - 64) % F.G) * NWAVES + F.wave, NGW = F.G * NWAVES;
    LAS float* Asm = (LAS float*)(F.lds + F.wave * 17408);
    for (int ch = gw; ch < 2048; ch += NGW) { const Frame Fi = relaunder(F); gdn_chunk_wave(Fi, P, l, ch, Asm); } }
PHASE_FN void ph_p3(int l, int which) { PHASE_PROLOG();
    if (which == 0) {
        pg8::Gemm g{(const pg8::bf16_t*)(ws + OFF_PROJ1), (const pg8::bf16_t*)(WL(l) + WO_UQ), MROWS, 768, 768, P1LD, 768};
        SO S; S.init(MROWS, 768, F.G, F.bid);
        epi::Store E{(bf16*)(ws + OFF_QMLA), 768, (const float*)(ws + OFF_RSTD), 0};
        pg8::gemm_phase<epi::Store, SO, true, true>(F.lds, g, S, E);
    } else {
        pg8::Gemm g{(const pg8::bf16_t*)(ws + OFF_PROJ1) + 768, (const pg8::bf16_t*)(WL(l) + WO_UKV), MROWS, 1024, 256, P1LD, 256};
        SO S; S.init(MROWS, 1024, F.G, (F.bid + 64) % F.G);
        epi::Store E{(bf16*)(ws + OFF_KVMLA), 1024, (const float*)(ws + OFF_RSTD), 1};
        pg8::gemm_phase<epi::Store, SO, true, true>(F.lds, g, S, E);
    }
}
PHASE_FN void ph_gdn(int l, int i) { PHASE_PROLOG(); gdn_scan_unit(F, P, l, i >> 3, i & 7); }
PHASE_FN void ph_mla(int bh, int qb) { PHASE_PROLOG(); attn_unit<96, false>(F, bh >> 3, bh & 7, qb); }
PHASE_FN void ph_moba(int bh, int qb) { PHASE_PROLOG(); attn_unit<64, true>(F, bh >> 3, bh & 7, qb); }
PHASE_FN void ph_brzero(int which) { PHASE_PROLOG();
    const int gt = F.bid * NTHREADS + F.tid, NGT = F.G * NTHREADS; bf16* BR = (bf16*)(ws + OFF_BR);
    for (int i = gt; i < MROWS * 64; i += NGT) { const int m = i >> 6, c8 = i & 63; *(u32x4*)(BR + (size_t)m * BRLD + which * 512 + 8 * c8) = (u32x4){0u, 0u, 0u, 0u}; } }
PHASE_FN void ph_p5a(int l) { PHASE_PROLOG();
    pg8::Gemm g{(const pg8::bf16_t*)(ws + OFF_HB), (const pg8::bf16_t*)(WL(l) + WO_G), MROWS, 3072, 1024, 1024, 1024};
    SO S; S.init(MROWS, 3072, F.G, F.bid);
    epi::Store E{(bf16*)(ws + OFF_GLG), 3072, nullptr, 0};
    pg8::gemm_phase<epi::Store, SO, true, true>(F.lds, g, S, E);
}
PHASE_FN void ph_p5b(int l) { PHASE_PROLOG();
    pg8::Gemm g{(const pg8::bf16_t*)(ws + OFF_BR), (const pg8::bf16_t*)(WL(l) + WO_BR), MROWS, 3072, 512, BRLD, 512};
    epi::MergeOrder S; S.init(F.G, F.bid);
    epi::Merge E{(bf16*)(ws + OFF_MERGED), (const bf16*)(ws + OFF_GLG), (const float*)P.in[13] + (size_t)l * 3072};
    pg8::gemm_phase<epi::Merge, epi::MergeOrder, true, true>(F.lds, g, S, E);
}
PHASE_FN void ph_p6(int l) { PHASE_PROLOG();
    pg8::Gemm g{(const pg8::bf16_t*)(ws + OFF_MERGED), (const pg8::bf16_t*)(WL(l) + WO_OUT), MROWS, 1024, 1024, 1024, 1024};
    SO S; S.init(MROWS, 1024, F.G, F.bid);
    epi::OutRes E{(float*)(ws + OFF_Y), (const float*)(ws + OFF_HF)};
    pg8::gemm_phase<epi::OutRes, SO, true, true>(F.lds, g, S, E);
}
PHASE_FN void ph_ln1(int l, int from_y) { PHASE_PROLOG();
    const int gw = F.bid * NWAVES + F.wave, NGW = F.G * NWAVES;
    for (int m = gw; m < MROWS; m += NGW)
        ln_row((const float*)(ws + (from_y ? OFF_Y : OFF_HF)) + (size_t)m * DM, (const float*)P.in[16] + l * 1024, (const float*)P.in[17] + l * 1024,
               (float*)(ws + OFF_HF) + (size_t)m * DM, (bf16*)(ws + OFF_HB) + (size_t)m * DM, F.lane, from_y ? 1.0f : DN_ALPHA);
}
PHASE_FN void ph_p7(int l) { PHASE_PROLOG();
    pg8::Gemm g{(const pg8::bf16_t*)(ws + OFF_HB), (const pg8::bf16_t*)(WL(l) + WO_PQ), MROWS, 2048, 1024, 1024, 1024};
    SO S; S.init(MROWS, 2048, F.G, F.bid);
    epi::Store E{(bf16*)(ws + OFF_QRY), 2048, nullptr, 0};
    pg8::gemm_phase<epi::Store, SO, true, true>(F.lds, g, S, E);
    peer_tables(F, P, l);
}
PHASE_FN void ph_p8(int l) { PHASE_PROLOG(); for (int u = F.bid; u < MROWS / 32; u += F.G) { const Frame Fi = relaunder(F); peer_topk_unit(Fi, l, u); } }
PHASE_FN void ph_p9(int l, int en_peer) { PHASE_PROLOG();
    const int gw = F.bid * NWAVES + F.wave, NGW = F.G * NWAVES;
    for (int m = gw; m < MROWS; m += NGW) { const Frame Fi = relaunder(F); peer_token(Fi, P, l, (size_t)m, l == NLAYER - 1, en_peer != 0); }
}

#ifndef EN_MIXER
#define EN_MIXER 1
#endif
#ifndef EN_MLA
#define EN_MLA 1
#endif
#ifndef EN_MOBA
#define EN_MOBA 1
#endif
#ifndef EN_GDN
#define EN_GDN 1
#endif
#ifndef EN_PEER
#define EN_PEER 1
#endif

#define GRID_BAR() bar_fn(fresh_params().ws)
template <int l> __device__ __forceinline__ void layer_body() {
    extern __shared__ __attribute__((aligned(16))) unsigned char lds_raw[];

        if (EN_MIXER) {
            ph_p1(l);
            GRID_BAR();
            ph_p2a(); ph_p2b(l);
            GRID_BAR();
            ph_p3(l, 0); ph_p3(l, 1);
            GRID_BAR();
            {
                unsigned* ctr = (unsigned*)(fresh_params().ws + OFF_CTL) + 64 * (1 + l);
                const int tid = threadIdx.x;
                LAS int* slot = (LAS int*)((LAS unsigned char*)lds_raw + LDS_BYTES - 64);
                for (;;) {
                    __syncthreads();
                    if (tid == 0) slot[0] = (int)atomicAdd(ctr, 1u);
                    __syncthreads();
                    const int i = __builtin_amdgcn_readfirstlane(slot[0]);
                    if (i >= 64 + 1024) break;
                    if (i < 64) { if (EN_GDN) ph_gdn(l, i); }
                    else { const int j = i - 64, qb = 7 - (j >> 7), typ = (j >> 6) & 1, bh = j & 63;
                        if (typ == 0) { if (EN_MLA) ph_mla(bh, qb); } else { if (EN_MOBA) ph_moba(bh, qb); } }
                }
                if (!EN_MLA) ph_brzero(0);
                if (!EN_MOBA) ph_brzero(1);
                if (!EN_GDN) ph_brzero(2);
            }
            GRID_BAR();
            ph_p5a(l);
            GRID_BAR();
            ph_p5b(l);
            GRID_BAR();
            ph_p6(l);
            GRID_BAR();
        }
        ph_ln1(l, EN_MIXER);
        GRID_BAR();
        if (EN_PEER) {
            ph_p7(l);
            GRID_BAR();
            ph_p8(l);
            GRID_BAR();
        }
        ph_p9(l, EN_PEER);
        if (l + 1 < NLAYER) GRID_BAR();
}
__global__ void __launch_bounds__(NTHREADS, 2) fwd_mega(Params Pk) {
    {
        extern __shared__ __attribute__((aligned(16))) unsigned char lds_raw[];
        volatile LAS unsigned* st = (volatile LAS unsigned*)((LAS unsigned char*)lds_raw + XB_LDS_OFF);
        if (threadIdx.x == 0) { st[0] = 0u; st[1] = 0u; }
        __syncthreads();
        (void)xcd_barrier_post((unsigned*)(Pk.ws + OFF_CTL) + CW_BAR, st);
    }
    ph_p0();
    grid_sync_fn();
    layer_body<0>();
    layer_body<1>();
}

extern "C" void kernel_launch(void* const* d_in, const int* in_sizes, int n_in, void* d_out, int out_size, void* d_ws, size_t ws_size, hipStream_t stream) {
    static int grid = 0;
    if (grid == 0) {
        if (n_in != 24 || out_size != MROWS * DM || ws_size < WS_END) { fprintf(stderr, "kernel_launch: unexpected shapes (n_in %d out %d ws %zu need %zu)\n", n_in, out_size, ws_size, (size_t)WS_END); grid = -1; return; }
        int dev = 0, cus = 0, per_cu = 0;
        if (hipGetDevice(&dev) != hipSuccess || hipDeviceGetAttribute(&cus, hipDeviceAttributeMultiprocessorCount, dev) != hipSuccess) { grid = -1; return; }
        if (hipFuncSetAttribute((const void*)fwd_mega, hipFuncAttributeMaxDynamicSharedMemorySize, LDS_BYTES) != hipSuccess) { fprintf(stderr, "kernel_launch: hipFuncSetAttribute failed\n"); grid = -1; return; }
        if (hipOccupancyMaxActiveBlocksPerMultiprocessor(&per_cu, (const void*)fwd_mega, NTHREADS, LDS_BYTES) != hipSuccess || per_cu < 1) { fprintf(stderr, "kernel_launch: occupancy query says %d\n", per_cu); per_cu = 1; }
        (void)hipGetLastError();
        grid = cus;
    }
    if (grid < 0) return;
    if (hipMemsetAsync((char*)d_ws + OFF_CTL, 0, CTL_BYTES, stream) != hipSuccess) { fprintf(stderr, "kernel_launch: memset failed\n"); return; }
    Params p{};
    for (int i = 0; i < 24; ++i) p.in[i] = d_in[i];
    p.out = (float*)d_out; p.ws = (unsigned char*)d_ws; p.pad0 = 0; p.pad1 = 0;
    void* args[] = {&p};
    hipError_t e = hipLaunchCooperativeKernel((void*)fwd_mega, dim3(grid), dim3(NTHREADS), args, LDS_BYTES, stream);
    if (e != hipSuccess) fprintf(stderr, "cooperative launch failed: %s (grid %d)\n", hipGetErrorString(e), grid);
}
```

```cpp
#include <hip/hip_runtime.h>
#include <hip/hip_cooperative_groups.h>
#include <cstdio>
#include <cstdint>
namespace cg = cooperative_groups;

namespace pg8 {
#define PG8_LAS __attribute__((address_space(3)))
typedef unsigned short bf16_t;
typedef short bf16x8 __attribute__((ext_vector_type(8)));
typedef float f32x4 __attribute__((ext_vector_type(4)));
typedef unsigned u32x4 __attribute__((ext_vector_type(4)));
constexpr int BM = 256, BK = 64, HALF = 128, HTB = HALF * BK * 2  , STAGE_BYTES = 8 * HTB, NXCD = 8, WGM = 8;

__host__ __device__ __forceinline__ int lds_byte(int r, int c) { const int st = (r >> 4) * 2 + (c >> 5), rr = r & 15, cc = c & 31, ob = rr * 64 + cc * 2; return st * 1024 + (ob ^ (((ob >> 9) & 1) << 5)); }
__host__ __device__ __forceinline__ void stage_rc(int b, int& R, int& C) { const int st = b / 1024, sb = b % 1024, swz = sb ^ (((sb >> 9) & 1) << 5); R = (st >> 1) * 16 + swz / 64; C = (st & 1) * 32 + (swz % 64) / 2; }
__host__ __device__ __forceinline__ int perm32(int rho) { const int n = rho >> 4, i = rho & 15; return 8 * (i >> 2) + 4 * n + (i & 3); }

struct Unit { int pm, pn, za, tag; };
struct Gemm { const bf16_t* A; const bf16_t* Bt; int M, N, K, lda, ldb; };

struct StaticOrder {
    int nM, nN, nwg, G, c;
    __host__ __device__ void init(int M, int N, int G_, int c_) { nM = M / BM; nN = N / BM; nwg = nM * nN; G = G_; c = c_; }
    __host__ __device__ bool next(int i, Unit& u) const {
        const long L = (long)i * G + c; if (L >= nwg) return false;
        int wgid = (int)L; { const int q = nwg / NXCD, r = nwg % NXCD, xcd = wgid % NXCD, off = wgid / NXCD; wgid = (xcd < r ? xcd * (q + 1) : r * (q + 1) + (xcd - r) * q) + off; }
        const int nig = WGM * nN, gid = wgid / nig, fm = gid * WGM, gsz = (nM - fm) < WGM ? (nM - fm) : WGM;
        u.pm = fm + ((wgid % nig) % gsz); u.pn = (wgid % nig) / gsz; u.za = 0; u.tag = 0; return true;
    }
    __device__ __forceinline__ void a_ready(const Unit&) const {}
    __device__ __forceinline__ void done(const Unit&) const {}
};

__device__ __forceinline__ unsigned cvt_pk_bf16(float lo, float hi) { unsigned r; asm volatile("v_cvt_pk_bf16_f32 %0, %1, %2" : "=v"(r) : "v"(lo), "v"(hi)); return r; }
typedef float f32x2 __attribute__((ext_vector_type(2)));
__device__ __forceinline__ f32x2 gelu_pk(f32x2 v) {
    const f32x2 av = __builtin_elementwise_abs(v), d = av * 0.2316418882f + 1.0f;
    f32x2 t; t.x = __builtin_amdgcn_rcpf(d.x); t.y = __builtin_amdgcn_rcpf(d.y);
    f32x2 q = t * 0.5307027145f + (-0.7265760135f); q = q * t + 0.7107068705f; q = q * t + (-0.142248368f); q = q * t + 0.127414796f; q = q * t;
    const f32x2 s = (v * v) * (-0.72134752044f);
    f32x2 e; e.x = __builtin_amdgcn_exp2f(s.x); e.y = __builtin_amdgcn_exp2f(s.y);
    const f32x2 m = v * (q * e), r = v - m;
    f32x2 o; o.x = v.x < 0.f ? m.x : r.x; o.y = v.y < 0.f ? m.y : r.y; return o;
}

template <int ACT  > struct EpiBf16 {
    static constexpr bool PERM = true, AFTER_DRAIN = false; static_assert(ACT == 0 || ACT == 1, "EpiBf16: ACT is 0 (none) or 1 (gelu_pk)");
    bf16_t* O; int ldc; const float* bias; int split_cols; size_t split_stride; float scale0;
    __device__ __forceinline__ void operator()(const f32x4 (&acc)[2][2][4][2], const Unit& u, int wr, int wc, int fr, int fq) const {
        const int row0 = u.pm * BM + wr * 64 + fr; int colt = u.pn * BM; bf16_t* base = O;
        float sc = 1.f; if (split_cols) { const int t = colt / split_cols; base += (size_t)t * split_stride; colt -= t * split_cols; if (t == 0) sc = scale0; }
        const int col0 = colt + wc * 32 + 8 * fq, bcol0 = u.pn * BM + wc * 32 + 8 * fq;
        f32x4 bv[2][2];
#pragma unroll
        for (int bj = 0; bj < 2; ++bj)
#pragma unroll
            for (int n = 0; n < 2; ++n) bv[bj][n] = bias ? *(const f32x4*)(bias + bcol0 + bj * HALF + 4 * n) : (f32x4){0.f, 0.f, 0.f, 0.f};
#pragma unroll
        for (int ai = 0; ai < 2; ++ai)
#pragma unroll
            for (int m = 0; m < 4; ++m) { bf16_t* rowp = base + (size_t)(row0 + ai * HALF + m * 16) * ldc + col0;
#pragma unroll
                for (int bj = 0; bj < 2; ++bj) { f32x4 v0 = acc[ai][bj][m][0] + bv[bj][0], v1 = acc[ai][bj][m][1] + bv[bj][1];
                    if (ACT == 1) { f32x2 a = gelu_pk((f32x2){v0[0], v0[1]}), b = gelu_pk((f32x2){v0[2], v0[3]}), c = gelu_pk((f32x2){v1[0], v1[1]}), d = gelu_pk((f32x2){v1[2], v1[3]});
                        v0 = (f32x4){a.x, a.y, b.x, b.y}; v1 = (f32x4){c.x, c.y, d.x, d.y}; }
                    v0 = v0 * sc; v1 = v1 * sc; u32x4 w; w.x = cvt_pk_bf16(v0[0], v0[1]); w.y = cvt_pk_bf16(v0[2], v0[3]); w.z = cvt_pk_bf16(v1[0], v1[1]); w.w = cvt_pk_bf16(v1[2], v1[3]);
                    *(u32x4*)(rowp + bj * HALF) = w; } }
    }
};

struct PanelStats {
    unsigned* xbuf;
    unsigned* cnt;
    unsigned* tmo;
    int ntn; float eps;
    unsigned code;
    __device__ __forceinline__ bool run(const f32x4 (&v)[2][2][4][2], const Unit& u, int wr, int wc, int fr, int fq, PG8_LAS unsigned char* lds, int wid, int lane) const {
        typedef float f32x2v __attribute__((ext_vector_type(2)));
        PG8_LAS f32x2v* P = (PG8_LAS f32x2v*)lds;
        PG8_LAS f32x2v* S = (PG8_LAS f32x2v*)(lds + 8192);
        PG8_LAS unsigned* flag = (PG8_LAS unsigned*)(lds + 8192 + 2048);
#pragma unroll
        for (int ai = 0; ai < 2; ++ai)
#pragma unroll
            for (int m = 0; m < 4; ++m) {
                float s = 0.f;
#pragma unroll
                for (int bj = 0; bj < 2; ++bj)
#pragma unroll
                    for (int n = 0; n < 2; ++n) { const f32x4 x = v[ai][bj][m][n]; s += (x[0] + x[1]) + (x[2] + x[3]); }
                s += __shfl_xor(s, 16); s += __shfl_xor(s, 32);
                const float mw = s * (1.0f / 64.0f); float q = 0.f;
#pragma unroll
                for (int bj = 0; bj < 2; ++bj)
#pragma unroll
                    for (int n = 0; n < 2; ++n) { const f32x4 d = v[ai][bj][m][n] - mw; q += (d[0] * d[0] + d[1] * d[1]) + (d[2] * d[2] + d[3] * d[3]); }
                q += __shfl_xor(q, 16); q += __shfl_xor(q, 32);
                if (fq == 0) P[(ai * HALF + wr * 64 + m * 16 + fr) * 4 + wc] = (f32x2v){mw, q};
            }
        asm volatile("s_waitcnt lgkmcnt(0)" ::: "memory"); __builtin_amdgcn_s_barrier(); asm volatile("" ::: "memory");
#if defined(BROKEN_EXCHANGE_NO_WAIT)
#warning BROKEN CONTROL BUILD: the row-statistics exchange does not wait; results are wrong by design
        if (blockIdx.x >= 64) { const long long t0_ = clock64(); while (clock64() - t0_ < 60000) __builtin_amdgcn_s_sleep(8); }
#endif
        const int row = wid * 32 + (lane & 31);
        if (lane < 32) {
            const f32x2v a = P[row * 4 + 0], b = P[row * 4 + 1], c = P[row * 4 + 2], d = P[row * 4 + 3];
            const float mt = (a.x + b.x + c.x + d.x) * 0.25f;
            const float da = a.x - mt, db = b.x - mt, dc = c.x - mt, dd = d.x - mt;
            const float m2 = (a.y + b.y) + (c.y + d.y) + 64.0f * ((da * da + db * db) + (dc * dc + dd * dd));
            unsigned long long* slot = (unsigned long long*)xbuf + ((size_t)(u.pm * BM + row) * 4 + u.pn);
            __hip_atomic_store(slot, ((unsigned long long)__float_as_uint(m2) << 32) | __float_as_uint(mt), __ATOMIC_RELAXED, __HIP_MEMORY_SCOPE_AGENT);
        }
        asm volatile("s_waitcnt vmcnt(0)" ::: "memory");
        if (lane == 0) __hip_atomic_fetch_add(cnt + 64 * u.pm, 1u, __ATOMIC_RELAXED, __HIP_MEMORY_SCOPE_AGENT);
        if (wid == 0) {
            bool dead = false; const unsigned long long t0 = __builtin_amdgcn_s_memrealtime(); const unsigned want = 8u * (unsigned)ntn;
            for (;;) {
#if defined(BROKEN_EXCHANGE_NO_WAIT)
                break;
#endif
                if ((unsigned)__builtin_amdgcn_readfirstlane(__hip_atomic_load(cnt + 64 * u.pm, __ATOMIC_RELAXED, __HIP_MEMORY_SCOPE_AGENT)) >= want) break;
                if (__builtin_amdgcn_s_memrealtime() - t0 > 2000000ull) {
                    if (lane == 0) { unsigned expect = 0u; __hip_atomic_compare_exchange_strong(tmo + 1, &expect, code | (unsigned)(u.pm & 0xff), __ATOMIC_RELAXED, __ATOMIC_RELAXED, __HIP_MEMORY_SCOPE_AGENT);
                                     __hip_atomic_store(tmo, 1u, __ATOMIC_RELAXED, __HIP_MEMORY_SCOPE_AGENT); }
                    dead = true; break; }
                __builtin_amdgcn_s_sleep(2);
            }
            __builtin_amdgcn_fence(__ATOMIC_ACQUIRE, "agent");
            if (lane == 0) flag[0] = dead ? 1u : 0u;
        }
        asm volatile("s_waitcnt vmcnt(0) lgkmcnt(0)" ::: "memory"); __builtin_amdgcn_s_barrier(); asm volatile("" ::: "memory");
        const bool bad = flag[0] != 0u;
        if (lane < 32) {
            const unsigned long long* slot = (const unsigned long long*)xbuf + (size_t)(u.pm * BM + row) * 4; float mt[4], m2[4]; float ms = 0.f;
#pragma unroll
            for (int t = 0; t < 4; ++t) { if (t < ntn) { const unsigned long long w = __hip_atomic_load(slot + t, __ATOMIC_RELAXED, __HIP_MEMORY_SCOPE_AGENT); mt[t] = __uint_as_float((unsigned)w); m2[t] = __uint_as_float((unsigned)(w >> 32)); } else { mt[t] = 0.f; m2[t] = 0.f; } ms += mt[t]; }
            const float mean = ms / (float)ntn; float q = 0.f;
#pragma unroll
            for (int t = 0; t < 4; ++t) if (t < ntn) { const float dm = mt[t] - mean; q += m2[t] + 256.0f * dm * dm; }
            S[row] = (f32x2v){mean, 1.0f / sqrtf(q / (256.0f * (float)ntn) + eps)};
        }
        asm volatile("s_waitcnt lgkmcnt(0)" ::: "memory"); __builtin_amdgcn_s_barrier(); asm volatile("" ::: "memory");
        return bad;
    }
};
struct EpiLnRes {
    static constexpr bool PERM = false, AFTER_DRAIN = true;
    const float* base; float* out; int ldc; const float* bias; PanelStats st; unsigned poison;
    __device__ __forceinline__ void fused(f32x4 (&acc)[2][2][4][2], const Unit& u, int wr, int wc, int fr, int fq, PG8_LAS unsigned char* lds, int wid, int lane) const {
        typedef float f32x2v __attribute__((ext_vector_type(2)));
        const PG8_LAS f32x2v* S = (const PG8_LAS f32x2v*)(lds + 8192);
        const int col0 = u.pn * BM + wc * 32 + 4 * fq;
#pragma unroll
        for (int bj = 0; bj < 2; ++bj)
#pragma unroll
            for (int n = 0; n < 2; ++n) { const f32x4 bv = bias ? *(const f32x4*)(bias + col0 + bj * HALF + n * 16) : (f32x4){0.f, 0.f, 0.f, 0.f};
#pragma unroll
                for (int ai = 0; ai < 2; ++ai)
#pragma unroll
                    for (int m = 0; m < 4; ++m) acc[ai][bj][m][n] += bv; }
        f32x4 pre[4][2][2];
#pragma unroll
        for (int m = 0; m < 4; ++m) { const size_t off = (size_t)(u.pm * BM + wr * 64 + m * 16 + fr) * ldc + col0;
#pragma unroll
            for (int bj = 0; bj < 2; ++bj)
#pragma unroll
                for (int n = 0; n < 2; ++n) pre[m][bj][n] = *(const f32x4*)(base + off + bj * HALF + n * 16); }
        const bool bad = st.run(acc, u, wr, wc, fr, fq, lds, wid, lane) || poison != 0u;
        const float qnan = __builtin_nanf("");
#pragma unroll
        for (int ai = 0; ai < 2; ++ai)
#pragma unroll
            for (int m = 0; m < 4; ++m) { const int r = ai * HALF + wr * 64 + m * 16 + fr; const f32x2v sr = S[r]; const size_t off = (size_t)(u.pm * BM + r) * ldc + col0;
#pragma unroll
                for (int bj = 0; bj < 2; ++bj)
#pragma unroll
                    for (int n = 0; n < 2; ++n) { const f32x4 bs = ai == 0 ? pre[m][bj][n] : *(const f32x4*)(base + off + bj * HALF + n * 16); f32x4 o = bs + (acc[ai][bj][m][n] - sr.x) * sr.y;
                        if (bad) o = (f32x4){qnan, qnan, qnan, qnan}; *(f32x4*)(out + off + bj * HALF + n * 16) = o; }
                if (m & 1) asm volatile("" ::: "memory"); }
    }
};
struct EpiLnResLn {
    static constexpr bool PERM = false, AFTER_DRAIN = true;
    const float* base; float* out; bf16_t* xn; int ldc; const float* bias; PanelStats st1, st2; unsigned poison;
    __device__ __forceinline__ void fused(f32x4 (&acc)[2][2][4][2], const Unit& u, int wr, int wc, int fr, int fq, PG8_LAS unsigned char* lds, int wid, int lane) const {
        typedef float f32x2v __attribute__((ext_vector_type(2))); typedef unsigned u32x2v __attribute__((ext_vector_type(2)));
        const PG8_LAS f32x2v* S = (const PG8_LAS f32x2v*)(lds + 8192);
        const int col0 = u.pn * BM + wc * 32 + 4 * fq;
#pragma unroll
        for (int bj = 0; bj < 2; ++bj)
#pragma unroll
            for (int n = 0; n < 2; ++n) { const f32x4 bv = bias ? *(const f32x4*)(bias + col0 + bj * HALF + n * 16) : (f32x4){0.f, 0.f, 0.f, 0.f};
#pragma unroll
                for (int ai = 0; ai < 2; ++ai)
#pragma unroll
                    for (int m = 0; m < 4; ++m) acc[ai][bj][m][n] += bv; }
        bool bad = st1.run(acc, u, wr, wc, fr, fq, lds, wid, lane) || poison != 0u;
        const float qnan = __builtin_nanf("");
#pragma unroll
        for (int ai = 0; ai < 2; ++ai)
#pragma unroll
            for (int m = 0; m < 4; ++m) { const int r = ai * HALF + wr * 64 + m * 16 + fr; const f32x2v sr = S[r]; const size_t off = (size_t)(u.pm * BM + r) * ldc + col0;
#pragma unroll
                for (int bj = 0; bj < 2; ++bj)
#pragma unroll
                    for (int n = 0; n < 2; ++n) { const f32x4 bs = *(const f32x4*)(base + off + bj * HALF + n * 16); acc[ai][bj][m][n] = bs + (acc[ai][bj][m][n] - sr.x) * sr.y; }
                asm volatile("" : "+v"(acc[ai][0][m][0]), "+v"(acc[ai][0][m][1]), "+v"(acc[ai][1][m][0]), "+v"(acc[ai][1][m][1]));
                if (m & 1) asm volatile("" ::: "memory"); }
        const bool bad1 = bad;
        bad = st2.run(acc, u, wr, wc, fr, fq, lds, wid, lane) || bad;
#pragma unroll
        for (int ai = 0; ai < 2; ++ai)
#pragma unroll
            for (int m = 0; m < 4; ++m) { const int r = ai * HALF + wr * 64 + m * 16 + fr; const f32x2v sr = S[r]; const size_t off = (size_t)(u.pm * BM + r) * ldc + col0;
#pragma unroll
                for (int bj = 0; bj < 2; ++bj)
#pragma unroll
                    for (int n = 0; n < 2; ++n) { const f32x4 x1 = acc[ai][bj][m][n]; *(f32x4*)(out + off + bj * HALF + n * 16) = bad1 ? (f32x4){qnan, qnan, qnan, qnan} : x1;
                        const f32x4 o = (x1 - sr.x) * sr.y; u32x2v w; w.x = cvt_pk_bf16(o[0], o[1]); w.y = cvt_pk_bf16(o[2], o[3]);
                        if (bad) { w.x = 0x7fc07fc0u; w.y = 0x7fc07fc0u; } *(u32x2v*)(xn + off + bj * HALF + n * 16) = w; }
                asm volatile("" ::: "memory"); }
    }
};

template <class Epi, class Sched, bool ALIGN_EPI = false, bool SP2 = false>
__device__ __forceinline__ void gemm_phase(PG8_LAS unsigned char* lds, const Gemm g, const Sched& S, const Epi& E) {
    const int tid = threadIdx.x, wid = __builtin_amdgcn_readfirstlane(tid >> 6), lane = tid & 63, wr = wid >> 2, wc = wid & 3, fr = lane & 15, fq = lane >> 4;
    const int K = g.K, nt = K / BK;
    unsigned voffA[2], voffB[2];
#pragma unroll
    for (int i = 0; i < 2; ++i) { int R, C; stage_rc(tid * 16 + i * 8192, R, C); const int Rb = Epi::PERM ? ((R & ~31) + perm32(R & 31)) : R;
        voffA[i] = (unsigned)(R * g.lda + C) * 2u; voffB[i] = (unsigned)(Rb * g.ldb + C) * 2u; }
    const size_t kstep = (size_t)(BK * 2);
    const size_t hstepA = (size_t)HALF * g.lda * 2, hstepB = (size_t)HALF * g.ldb * 2;
    const size_t tstepA = 2 * hstepA, tstepB = 2 * hstepB;
    const unsigned ldsw = (unsigned)wid * 1024u;
    const int aoff = lds_byte(wr * 64 + fr, fq * 8), boff = lds_byte(wc * 32 + fr, fq * 8);
#define PG8_SA(b, h) (((b) * 2 + (h)) * HTB)
#define PG8_SB(b, h) ((4 + (b) * 2 + (h)) * HTB)
#define PG8_STAGE(bufoff, gbase, voff) do { _Pragma("unroll") for (int _i = 0; _i < 2; ++_i) \
        __builtin_amdgcn_global_load_lds((const unsigned*)((const char*)(gbase) + (voff)[_i]), (PG8_LAS unsigned*)(lds + (bufoff) + ldsw + _i * 8192), 16, 0, 0); } while (0)
#define PG8_LDA(dst, b, h) do { _Pragma("unroll") for (int m = 0; m < 4; ++m) _Pragma("unroll") for (int k = 0; k < 2; ++k) dst[m][k] = *(const PG8_LAS bf16x8*)(lds + PG8_SA(b, h) + aoff + m * 2048 + k * 1024); } while (0)
#define PG8_LDB(dst, b, h) do { _Pragma("unroll") for (int n = 0; n < 2; ++n) _Pragma("unroll") for (int k = 0; k < 2; ++k) dst[n][k] = *(const PG8_LAS bf16x8*)(lds + PG8_SB(b, h) + boff + n * 2048 + k * 1024); } while (0)
#define PG8_MMA(ai, bj, At, Bt) do { __builtin_amdgcn_s_setprio(1); _Pragma("unroll") for (int m = 0; m < 4; ++m) _Pragma("unroll") for (int n = 0; n < 2; ++n) _Pragma("unroll") for (int k = 0; k < 2; ++k) \
        acc[ai][bj][m][n] = __builtin_amdgcn_mfma_f32_16x16x32_bf16(Bt[n][k], At[m][k], acc[ai][bj][m][n], 0, 0, 0); __builtin_amdgcn_s_setprio(0); } while (0)
#define PG8_WAIT_V(n) asm volatile("s_waitcnt vmcnt(" #n ")" ::: "memory")
#define PG8_WAIT_L(n) asm volatile("s_waitcnt lgkmcnt(" #n ")" ::: "memory")
#define PG8_BAR __builtin_amdgcn_s_barrier()
#define PG8_SCHED __builtin_amdgcn_sched_barrier(0)
    Unit cur, nxt; int ui = 0;
    if (!S.next(0, cur)) return;
    f32x4 acc[2][2][4][2];
#pragma unroll
    for (int a = 0; a < 2; ++a)
#pragma unroll
        for (int b = 0; b < 2; ++b)
#pragma unroll
            for (int m = 0; m < 4; ++m)
#pragma unroll
                for (int n = 0; n < 2; ++n) acc[a][b][m][n] = (f32x4){0.f, 0.f, 0.f, 0.f};
    bf16x8 At[4][2], B0[2][2], B1[2][2];
    const char* cA = (const char*)g.A + (size_t)cur.pm * tstepA + (size_t)cur.za * 2; const char* cB = (const char*)g.Bt + (size_t)cur.pn * tstepB;
    S.a_ready(cur);
    if constexpr (SP2) {
        PG8_STAGE(PG8_SB(0, 0), cB, voffB); PG8_STAGE(PG8_SB(0, 1), cB + hstepB, voffB); PG8_STAGE(PG8_SA(0, 0), cA, voffA); PG8_STAGE(PG8_SA(0, 1), cA + hstepA, voffA);
        if (wr == 1) PG8_BAR;
        PG8_WAIT_V(2); PG8_BAR;
        PG8_STAGE(PG8_SB(1, 0), cB + kstep, voffB); PG8_STAGE(PG8_SA(1, 0), cA + kstep, voffA); PG8_STAGE(PG8_SB(1, 1), cB + hstepB + kstep, voffB);
        PG8_WAIT_V(6); PG8_BAR;
    } else {
        PG8_STAGE(PG8_SB(0, 0), cB, voffB); PG8_STAGE(PG8_SA(0, 0), cA, voffA); PG8_STAGE(PG8_SB(0, 1), cB + hstepB, voffB); PG8_STAGE(PG8_SA(0, 1), cA + hstepA, voffA);
        if (wr == 1) PG8_BAR;
        PG8_WAIT_V(4); PG8_BAR;
        PG8_STAGE(PG8_SB(1, 0), cB + kstep, voffB); PG8_STAGE(PG8_SA(1, 0), cA + kstep, voffA); PG8_STAGE(PG8_SB(1, 1), cB + hstepB + kstep, voffB);
        PG8_WAIT_V(6); PG8_BAR;
    }
    for (;;) {
        const bool has_next = S.next(ui + 1, nxt);
        const char* nA = has_next ? (const char*)g.A + (size_t)nxt.pm * tstepA + (size_t)nxt.za * 2 : cA; const char* nB = has_next ? (const char*)g.Bt + (size_t)nxt.pn * tstepB : cB;
        for (int t = 0; t < nt; t += 2) {
            const bool last = (t == nt - 2);
            const char* a1 = cA + (size_t)(t + 1) * kstep;
            const char* a2 = last ? nA : cA + (size_t)(t + 2) * kstep; const char* b2 = last ? nB : cB + (size_t)(t + 2) * kstep;
            const char* a3 = a2 + kstep; const char* b3 = b2 + kstep;
            if (last && has_next) S.a_ready(nxt);
            if constexpr (SP2) {
            PG8_LDB(B0, 0, 0); PG8_LDB(B1, 0, 1); PG8_SCHED; PG8_LDA(At, 0, 0); PG8_STAGE(PG8_SA(1, 1), a1 + hstepA, voffA);
            PG8_WAIT_V(8); PG8_WAIT_L(0); PG8_BAR; PG8_MMA(0, 0, At, B0); PG8_MMA(0, 1, At, B1); PG8_BAR; PG8_SCHED;
            PG8_LDA(At, 0, 1); PG8_STAGE(PG8_SB(0, 0), b2, voffB); PG8_STAGE(PG8_SB(0, 1), b2 + hstepB, voffB); PG8_STAGE(PG8_SA(0, 0), a2, voffA);
            PG8_WAIT_V(8); PG8_WAIT_L(0); PG8_BAR; PG8_MMA(1, 0, At, B0); PG8_MMA(1, 1, At, B1); PG8_BAR; PG8_SCHED;
            PG8_LDB(B0, 1, 0); PG8_LDB(B1, 1, 1); PG8_SCHED; PG8_LDA(At, 1, 0); PG8_STAGE(PG8_SA(0, 1), a2 + hstepA, voffA);
            PG8_WAIT_V(8); PG8_WAIT_L(0); PG8_BAR; PG8_MMA(0, 0, At, B0); PG8_MMA(0, 1, At, B1); PG8_BAR; PG8_SCHED;
            PG8_LDA(At, 1, 1); PG8_STAGE(PG8_SB(1, 0), b3, voffB); PG8_STAGE(PG8_SB(1, 1), b3 + hstepB, voffB); PG8_STAGE(PG8_SA(1, 0), a3, voffA);
            PG8_WAIT_V(8); PG8_WAIT_L(0); PG8_BAR; PG8_MMA(1, 0, At, B0); PG8_MMA(1, 1, At, B1); PG8_BAR; PG8_SCHED;
            } else {
            PG8_LDB(B0, 0, 0); PG8_SCHED; PG8_LDA(At, 0, 0); PG8_STAGE(PG8_SA(1, 1), a1 + hstepA, voffA);
            PG8_WAIT_L(8); PG8_BAR; PG8_WAIT_L(0); PG8_MMA(0, 0, At, B0); PG8_BAR; PG8_SCHED;
            PG8_LDB(B1, 0, 1); PG8_STAGE(PG8_SB(0, 0), b2, voffB);
            PG8_BAR; PG8_WAIT_L(0); PG8_MMA(0, 1, At, B1); PG8_BAR;
            PG8_LDA(At, 0, 1); PG8_STAGE(PG8_SA(0, 0), a2, voffA);
            PG8_BAR; PG8_WAIT_L(0); PG8_MMA(1, 0, At, B0); PG8_BAR; PG8_SCHED;
            PG8_STAGE(PG8_SB(0, 1), b2 + hstepB, voffB);
            PG8_WAIT_V(6); PG8_BAR; PG8_MMA(1, 1, At, B1); PG8_BAR;
            PG8_LDB(B0, 1, 0); PG8_SCHED; PG8_LDA(At, 1, 0); PG8_STAGE(PG8_SA(0, 1), a2 + hstepA, voffA);
            PG8_WAIT_L(8); PG8_BAR; PG8_WAIT_L(0); PG8_MMA(0, 0, At, B0); PG8_BAR; PG8_SCHED;
            PG8_LDB(B1, 1, 1); PG8_STAGE(PG8_SB(1, 0), b3, voffB);
            PG8_BAR; PG8_WAIT_L(0); PG8_MMA(0, 1, At, B1); PG8_BAR;
            PG8_LDA(At, 1, 1); PG8_STAGE(PG8_SA(1, 0), a3, voffA);
            PG8_BAR; PG8_WAIT_L(0); PG8_MMA(1, 0, At, B0); PG8_BAR; PG8_SCHED;
            PG8_STAGE(PG8_SB(1, 1), b3 + hstepB, voffB);
            PG8_WAIT_V(6); PG8_BAR; PG8_MMA(1, 1, At, B1); PG8_BAR;
            }
        }
        if constexpr (ALIGN_EPI) { if (wr == 0) PG8_BAR; }
        if constexpr (!Epi::AFTER_DRAIN) { E(acc, cur, wr, wc, fr, fq); S.done(cur); }
        if (!has_next) break;
#pragma unroll
        for (int a = 0; a < 2; ++a)
#pragma unroll
            for (int b = 0; b < 2; ++b)
#pragma unroll
                for (int m = 0; m < 4; ++m)
#pragma unroll
                    for (int n = 0; n < 2; ++n) acc[a][b][m][n] = (f32x4){0.f, 0.f, 0.f, 0.f};
        cur = nxt; cA = nA; cB = nB; ++ui;
        if constexpr (ALIGN_EPI) { if (wr == 1) PG8_BAR; }
    }
    PG8_WAIT_V(0);
    if constexpr (!ALIGN_EPI) { if (wr == 0) PG8_BAR; }
    PG8_BAR;
    if constexpr (Epi::AFTER_DRAIN) { E.fused(acc, cur, wr, wc, fr, fq, lds, wid, lane); S.done(cur); }
#undef PG8_SA
#undef PG8_SB
#undef PG8_STAGE
#undef PG8_LDA
#undef PG8_LDB
#undef PG8_MMA
#undef PG8_WAIT_V
#undef PG8_WAIT_L
#undef PG8_BAR
#undef PG8_SCHED
}
}

constexpr int NB = 8, SEQ = 2048, DM = 1024, MROWS = NB * SEQ;
constexpr int NLAYER = 2;
constexpr int IN_COLS = 7728;
constexpr int P1LD = 1280, P2LD = 3840;
constexpr int C2_MQ = 0, C2_MK = 512, C2_MV = 1024, C2_GQ = 1536, C2_GK = 2048, C2_GV = 2560, C2_GZ = 3072, C2_GA = 3584, C2_GB = 3592;
constexpr int BRLD = 1536;
constexpr float LN_EPS = 1e-5f, RMS_EPS = 1e-6f;
constexpr float DN_ALPHA = 1.4142135623730951f;
constexpr int NWAVES = 8, NTHREADS = 512;

constexpr size_t KiB = 1024, MiB = 1024 * 1024;
constexpr size_t OFF_CTL = 0, CTL_BYTES = 1 * MiB;
constexpr size_t OFF_MISC = 1 * MiB;
constexpr size_t OFF_KMEAN = OFF_MISC;
constexpr size_t OFF_RSTD = OFF_MISC + 128 * KiB;
constexpr size_t OFF_GLS = OFF_MISC + 256 * KiB;
constexpr size_t OFF_TAB = 2 * MiB;
constexpr size_t OFF_COSA = OFF_TAB, OFF_SINA = OFF_TAB + 1 * MiB, OFF_COSB = OFF_TAB + 2 * MiB, OFF_SINB = OFF_TAB + 2 * MiB + 512 * KiB;
constexpr size_t OFF_W = 5 * MiB, W_LAYER = 28 * MiB;
constexpr size_t WO_IN = 0, WO_G = 10 * MiB, WO_UQ = 16 * MiB, WO_UKV = 17 * MiB + 256 * KiB, WO_BR = 17 * MiB + 768 * KiB,
                 WO_OUT = 20 * MiB + 768 * KiB, WO_PQ = 22 * MiB + 768 * KiB, WO_SK = 26 * MiB + 768 * KiB;
constexpr size_t OFF_HF = 61 * MiB, OFF_HB = 125 * MiB, OFF_RA = 157 * MiB, OFF_RB = 205 * MiB, OFF_RC = 325 * MiB, OFF_RD = 383 * MiB, WS_END = 480 * MiB;
constexpr size_t OFF_PROJ1 = OFF_RA, OFF_BR = OFF_RA;
constexpr size_t OFF_PROJ2 = OFF_RB, OFF_Y = OFF_RB, OFF_QRY = OFF_RB;
constexpr size_t OFF_QMLA = OFF_RC, OFF_KVMLA = OFF_RC + 24 * MiB, OFF_KR = OFF_RC + 56 * MiB, OFF_MERGED = OFF_RC, OFF_IDX = OFF_RC, OFF_GATE = OFF_RC + 8 * MiB;
constexpr size_t OFF_GDN = OFF_RD, OFF_GLG = OFF_RD, OFF_PU = OFF_RD, OFF_PV = OFF_RD + 32 * MiB;
constexpr int GDN_MAT = 4096;

#define GAS __attribute__((address_space(1)))
#define LAS __attribute__((address_space(3)))
typedef unsigned short bf16;
typedef short bf16x8 __attribute__((ext_vector_type(8)));
typedef short s16x4 __attribute__((ext_vector_type(4)));
typedef float f32x4 __attribute__((ext_vector_type(4)));
typedef float f32x2 __attribute__((ext_vector_type(2)));
typedef float f32x16 __attribute__((ext_vector_type(16)));
typedef unsigned u32x4 __attribute__((ext_vector_type(4)));
typedef unsigned u32x2 __attribute__((ext_vector_type(2)));

__device__ __forceinline__ unsigned f2bf(float f) { unsigned u = __builtin_bit_cast(unsigned, f); return (u + 0x7fffu + ((u >> 16) & 1u)) >> 16; }
__device__ __forceinline__ unsigned pk2(float lo, float hi) { return f2bf(lo) | (f2bf(hi) << 16); }
__device__ __forceinline__ float bflo(unsigned w) { return __builtin_bit_cast(float, w << 16); }
__device__ __forceinline__ float bfhi(unsigned w) { return __builtin_bit_cast(float, w & 0xffff0000u); }
__device__ __forceinline__ float bf1(bf16 h) { return __builtin_bit_cast(float, (unsigned)h << 16); }
__device__ __forceinline__ float wave_sum(float v) {
#pragma unroll
    for (int o = 1; o < 64; o <<= 1) v += __shfl_xor(v, o);
    return v;
}
__device__ __forceinline__ float sigmoidf_(float x) { return 1.0f / (1.0f + __expf(-x)); }
__device__ __forceinline__ float siluf_(float x) { return x / (1.0f + __expf(-x)); }
__device__ __forceinline__ float softplusf_(float x) { return x > 20.f ? x : log1pf(__expf(x)); }
__device__ __forceinline__ void unpack8(const u32x4 v, float* f) {
    f[0] = bflo(v.x); f[1] = bfhi(v.x); f[2] = bflo(v.y); f[3] = bfhi(v.y); f[4] = bflo(v.z); f[5] = bfhi(v.z); f[6] = bflo(v.w); f[7] = bfhi(v.w);
}
__device__ __forceinline__ u32x4 pack8(const float* f) { u32x4 v; v.x = pk2(f[0], f[1]); v.y = pk2(f[2], f[3]); v.z = pk2(f[4], f[5]); v.w = pk2(f[6], f[7]); return v; }

struct Params { const void* in[24]; float* out; unsigned char* ws; int pad0, pad1; };

constexpr int RING_BYTES = 131072;
constexpr int LDS_BYTES = 147456;

struct Frame {
    LAS unsigned char* lds;
    int tid, lane, wave, G, bid;
    unsigned char* ws;
};

typedef GAS unsigned gu32;
constexpr int CW_BAR = 4096;
constexpr int XB_LDS_OFF = LDS_BYTES - 32;
#define XB_TMO      128
#define XB_XCNT(j)  (256  + 64 * (j))
#define XB_XSUB(j)  (1280 + 64 * (j))
#define XB_XGEN(j)  (2304 + 64 * (j))
#define XB_TOP      3328
#define XB_TOPGEN   3392
#define XCD_BAR_WORDS 3456
#define XB_SPIN_CAP (1u << 22)

__device__ __forceinline__ unsigned xb_ld(unsigned* p)              { return __hip_atomic_load(p, __ATOMIC_RELAXED, __HIP_MEMORY_SCOPE_AGENT); }
__device__ __forceinline__ unsigned xb_add(unsigned* p, unsigned v) { return __hip_atomic_fetch_add(p, v, __ATOMIC_RELAXED, __HIP_MEMORY_SCOPE_AGENT); }
__device__ __forceinline__ unsigned xb_xcc_id() { return (unsigned)__builtin_amdgcn_s_getreg((3 << 11) | 20) & 0xFu; }
#define XB_SPIN(cond, bar) do { unsigned _sp = 0; while (cond) { __builtin_amdgcn_s_sleep(1); \
    if ((++_sp & 255u) == 0u) { if (xb_ld(&(bar)[XB_TMO])) break; if (_sp > XB_SPIN_CAP) { atomicAdd(&(bar)[XB_TMO], 1u); break; } } } } while (0)

struct XcdBarrier {
    unsigned* bar; unsigned x;
    volatile LAS unsigned* st;
};

__device__ __forceinline__ XcdBarrier xcd_barrier_post(unsigned* bar, volatile LAS unsigned* st) {
    XcdBarrier b; b.bar = bar; b.x = xb_xcc_id(); b.st = st;
    if (threadIdx.x == 0) (void)xb_add(&bar[XB_XCNT(b.x)], 1u);
    return b;
}
__device__ __forceinline__ void xcd_barrier_complete(unsigned* bar, unsigned x, unsigned& nloc, unsigned& nx) {
    const unsigned G = gridDim.x * gridDim.y * gridDim.z;
    unsigned sum, cnt, mine, sp = 0u;
    for (;;) {
        sum = 0u; cnt = 0u; mine = 0u;
#pragma unroll
        for (unsigned j = 0; j < 16; ++j) { const unsigned c = xb_ld(&bar[XB_XCNT(j)]); sum += c; cnt += (c > 0u) ? 1u : 0u; mine = (j == x) ? c : mine; }
        if (sum == G) break;
        __builtin_amdgcn_s_sleep(1);
        if ((++sp & 255u) == 0u) { if (xb_ld(&bar[XB_TMO])) break; if (sp > XB_SPIN_CAP) { atomicAdd(&bar[XB_TMO], 1u); break; } }
    }
    nloc = mine > 0u ? mine : 1u; nx = cnt > 0u ? cnt : 1u;
}

__device__ __forceinline__ void xcd_barrier(const XcdBarrier& b) {
    asm volatile("s_waitcnt vmcnt(0)" ::: "memory");
    __syncthreads();
    if (threadIdx.x == 0) {
        unsigned* bar = b.bar;
        __builtin_amdgcn_s_waitcnt(0);
        unsigned nloc = b.st[0], nx = b.st[1];
        if (nloc == 0u) { xcd_barrier_complete(bar, b.x, nloc, nx); b.st[0] = nloc; b.st[1] = nx; }
        const unsigned old = xb_add(&bar[XB_XSUB(b.x)], 1u);
        const unsigned gen = old / nloc;
        if (old + 1u == (gen + 1u) * nloc) {
            __builtin_amdgcn_fence(__ATOMIC_RELEASE, "agent");
            asm volatile("s_waitcnt vmcnt(0)" ::: "memory");
            const unsigned og = xb_add(&bar[XB_TOP], 1u);
            const unsigned tg = og / nx;
            if (og + 1u == (tg + 1u) * nx) xb_add(&bar[XB_TOPGEN], 1u);
            else XB_SPIN(xb_ld(&bar[XB_TOPGEN]) == tg, bar);
            __builtin_amdgcn_fence(__ATOMIC_ACQUIRE, "agent");
            xb_add(&bar[XB_XGEN(b.x)], 1u);
            asm volatile("s_waitcnt vmcnt(0)" ::: "memory");
        } else {
            XB_SPIN(xb_ld(&bar[XB_XGEN(b.x)]) == gen, bar);
            __builtin_amdgcn_fence(__ATOMIC_ACQUIRE, "agent");
            asm volatile("s_waitcnt vmcnt(0)" ::: "memory");
        }
    }
    __syncthreads();
}

#define LDS_WAIT() asm volatile("s_waitcnt lgkmcnt(0)" ::: "memory")
#define VM_WAIT() asm volatile("s_waitcnt vmcnt(0)" ::: "memory")
__device__ __forceinline__ float ld_coh_f32(float* p) { return __hip_atomic_load(p, __ATOMIC_RELAXED, __HIP_MEMORY_SCOPE_AGENT); }

__device__ __forceinline__ void ln_row(const float* xrow, const float* g, const float* bta, float* of32, bf16* obf, int lane, float pre = 1.0f) {
    const f32x4* xr = (const f32x4*)xrow + lane;
    f32x4 v[4]; float s = 0.f;
#pragma unroll
    for (int j = 0; j < 4; ++j) { v[j] = xr[64 * j] * pre; s += (v[j].x + v[j].y) + (v[j].z + v[j].w); }
    const float mean = wave_sum(s) * (1.f / 1024.f); float s2 = 0.f;
#pragma unroll
    for (int j = 0; j < 4; ++j) { v[j] = v[j] - mean; s2 += (v[j].x * v[j].x + v[j].y * v[j].y) + (v[j].z * v[j].z + v[j].w * v[j].w); }
    const float rstd = 1.f / sqrtf(wave_sum(s2) * (1.f / 1024.f) + LN_EPS);
    const f32x4* gr = (const f32x4*)g + lane; const f32x4* br = (const f32x4*)bta + lane;
    f32x4* o4 = (f32x4*)of32 + lane; u32x2* o8 = (u32x2*)obf + lane;
#pragma unroll
    for (int j = 0; j < 4; ++j) { const f32x4 o = v[j] * rstd * gr[64 * j] + br[64 * j]; if (of32) o4[64 * j] = o; u32x2 w; w.x = pk2(o.x, o.y); w.y = pk2(o.z, o.w); o8[64 * j] = w; }
}

__device__ __forceinline__ void transpose_item(const float* W, int ldw, int c_off, int n_valid, const float* kscale, bf16* WT, int K, int row0, LAS float* scr, int kb, int nb, int lane) {
    const int k0 = 64 * kb, n0 = 32 * nb;
#pragma unroll 8
    for (int i = 0; i < 32; ++i) { const int kk = 2 * i + (lane >> 5), n = n0 + (lane & 31);
        float v = (n < n_valid) ? W[(size_t)(k0 + kk) * ldw + c_off + n] : 0.f; if (kscale) v *= kscale[k0 + kk];
        scr[kk * 33 + (lane & 31)] = v; }
    LDS_WAIT(); asm volatile("" ::: "memory");
    const int c = lane & 7;
#pragma unroll
    for (int j = 0; j < 4; ++j) { const int n = (lane >> 3) + 8 * j; const LAS float* s = scr + (8 * c) * 33 + n;
        u32x4 o; o.x = pk2(s[0 * 33], s[1 * 33]); o.y = pk2(s[2 * 33], s[3 * 33]); o.z = pk2(s[4 * 33], s[5 * 33]); o.w = pk2(s[6 * 33], s[7 * 33]);
        *(u32x4*)(WT + (size_t)(row0 + n0 + n) * K + k0 + 8 * c) = o; }
    LDS_WAIT(); asm volatile("" ::: "memory");
}

__device__ __forceinline__ void p0_prologue(const Frame& F, const Params& P) {
    LAS float* scr = (LAS float*)(F.lds + F.wave * 16384);
    const int gw = F.bid * NWAVES + F.wave, NGW = F.G * NWAVES;
    constexpr int I_IN1 = 16 * 40, I_IN2 = 16 * 120, I_G = 16 * 96, I_UQ = 12 * 24, I_UKV = 4 * 32, I_BR = 8 * 32, I_OUT = 16 * 32, I_PQ = 16 * 64;
    constexpr int I_LAYER = I_IN1 + I_IN2 + I_G + I_UQ + I_UKV + 3 * I_BR + I_OUT + I_PQ;
    for (int it = gw; it < NLAYER * I_LAYER; it += NGW) {
        const int l = it / I_LAYER; int r = it % I_LAYER;
        unsigned char* wl = F.ws + OFF_W + (size_t)l * W_LAYER;
        const float* w_in = (const float*)P.in[4] + (size_t)l * 1024 * IN_COLS;
        if (r < I_IN1) { transpose_item(w_in, IN_COLS, 0, 1056, nullptr, (bf16*)(wl + WO_IN), 1024, 0, scr, r / 40, r % 40, F.lane); continue; } r -= I_IN1;
        if (r < I_IN2) { transpose_item(w_in, IN_COLS, 1056, 3600, nullptr, (bf16*)(wl + WO_IN), 1024, 1280, scr, r / 120, r % 120, F.lane); continue; } r -= I_IN2;
        if (r < I_G) { transpose_item(w_in, IN_COLS, 4656, 3072, nullptr, (bf16*)(wl + WO_G), 1024, 0, scr, r / 96, r % 96, F.lane); continue; } r -= I_G;
        if (r < I_UQ) { transpose_item((const float*)P.in[7] + (size_t)l * 768 * 768, 768, 0, 768, (const float*)P.in[5] + l * 768, (bf16*)(wl + WO_UQ), 768, 0, scr, r / 24, r % 24, F.lane); continue; } r -= I_UQ;
        if (r < I_UKV) { transpose_item((const float*)P.in[8] + (size_t)l * 256 * 1024, 1024, 0, 1024, (const float*)P.in[6] + l * 256, (bf16*)(wl + WO_UKV), 256, 0, scr, r / 32, r % 32, F.lane); continue; } r -= I_UKV;
        if (r < 3 * I_BR) { const int n = r / I_BR; r %= I_BR;
            transpose_item((const float*)P.in[14] + ((size_t)l * 3 + n) * 512 * 1024, 1024, 0, 1024, nullptr, (bf16*)(wl + WO_BR) + (size_t)n * 1024 * 512, 512, 0, scr, r / 32, r % 32, F.lane); continue; } r -= 3 * I_BR;
        if (r < I_OUT) { transpose_item((const float*)P.in[15] + (size_t)l * 1024 * 1024, 1024, 0, 1024, nullptr, (bf16*)(wl + WO_OUT), 1024, 0, scr, r / 32, r % 32, F.lane); continue; } r -= I_OUT;
        transpose_item((const float*)P.in[18] + (size_t)l * 1024 * 2048, 2048, 0, 2048, nullptr, (bf16*)(wl + WO_PQ), 1024, 0, scr, r / 64, r % 64, F.lane);
    }
    const int gt = F.bid * NTHREADS + F.tid, NGT = F.G * NTHREADS;
    for (int i = gt; i < NLAYER * 65536; i += NGT) {
        const int l = i / 65536, e = (i % 65536) * 4;
        const f32x4 v = *(const f32x4*)((const float*)P.in[19] + (size_t)l * 262144 + e);
        u32x2 w; w.x = pk2(v.x, v.y); w.y = pk2(v.z, v.w);
        *(u32x2*)((bf16*)(F.ws + OFF_W + (size_t)l * W_LAYER + WO_SK) + e) = w;
    }
    {
        float* cosA = (float*)(F.ws + OFF_COSA); float* sinA = (float*)(F.ws + OFF_SINA); float* cosB = (float*)(F.ws + OFF_COSB); float* sinB = (float*)(F.ws + OFF_SINB);
        const int* pos = (const int*)P.in[1];
        for (int i = gt; i < MROWS * 24; i += NGT) {
            const int m = i / 24, j = i % 24; const float p = (float)pos[m];
            if (j < 16) { const float inv = powf(500000.0f, -(float)(2 * j) / 32.0f); const float a = p * inv; cosA[m * 16 + j] = cosf(a); sinA[m * 16 + j] = sinf(a); }
            else { const int jj = j - 16; const float inv = powf(500000.0f, -(float)(2 * jj) / 16.0f); const float a = p * inv; cosB[m * 8 + jj] = cosf(a); sinB[m * 8 + jj] = sinf(a); }
        }
    }
    for (int m = gw; m < MROWS; m += NGW)
        ln_row((const float*)P.in[0] + (size_t)m * DM, (const float*)P.in[2], (const float*)P.in[3], (float*)(F.ws + OFF_HF) + (size_t)m * DM, (bf16*)(F.ws + OFF_HB) + (size_t)m * DM, F.lane);
}

__device__ __forceinline__ void peer_tables(const Frame& F, const Params& P, int l) {
    const int gt = F.bid * NTHREADS + F.tid, NGT = F.G * NTHREADS;
    const float* u = (const float*)P.in[20] + (size_t)l * 16384 * 1024; const float* v = (const float*)P.in[21] + (size_t)l * 16384 * 1024;
    unsigned char* pu = (unsigned char*)(F.ws + OFF_PU); unsigned char* pv = (unsigned char*)(F.ws + OFF_PV);
    for (int i = gt; i < 2 * 1048576; i += NGT) {
        const bool isv = i >= 1048576; const size_t e = (size_t)(isv ? i - 1048576 : i) * 16;
        const float* s = (isv ? v : u) + e; const float sc = isv ? 16.0f : 256.0f;
        unsigned w[4];
#pragma unroll
        for (int q = 0; q < 4; ++q) { const f32x4 a = *(const f32x4*)(s + 4 * q) * sc; int t = 0; t = __builtin_amdgcn_cvt_pk_fp8_f32(a.x, a.y, t, false); t = __builtin_amdgcn_cvt_pk_fp8_f32(a.z, a.w, t, true); w[q] = (unsigned)t; }
        *(u32x4*)((isv ? pv : pu) + e) = (u32x4){w[0], w[1], w[2], w[3]};
    }
}

namespace epi {
using pg8::Unit; using pg8::HALF; using pg8::BM;

struct Proj {
    static constexpr bool PERM = true, AFTER_DRAIN = false;
    bf16* P1; bf16* P2;
    __device__ __forceinline__ void operator()(const f32x4 (&acc)[2][2][4][2], const Unit& u, int wr, int wc, int fr, int fq) const {
        const int row0 = u.pm * BM + wr * 64 + fr;
        bf16* base; int ldc, colt;
        if (u.pn < 5) { base = P1; ldc = P1LD; colt = u.pn * BM; } else { base = P2; ldc = P2LD; colt = (u.pn - 5) * BM; }
        const int col0 = colt + wc * 32 + 8 * fq;
#pragma unroll
        for (int ai = 0; ai < 2; ++ai)
#pragma unroll
            for (int m = 0; m < 4; ++m) { bf16* rowp = base + (size_t)(row0 + ai * HALF + m * 16) * ldc + col0;
#pragma unroll
                for (int bj = 0; bj < 2; ++bj) { const f32x4 v0 = acc[ai][bj][m][0], v1 = acc[ai][bj][m][1];
                    u32x4 w; w.x = pk2(v0[0], v0[1]); w.y = pk2(v0[2], v0[3]); w.z = pk2(v1[0], v1[1]); w.w = pk2(v1[2], v1[3]);
                    *(u32x4*)(rowp + bj * HALF) = w; } }
    }
};
struct Store {
    static constexpr bool PERM = true, AFTER_DRAIN = false;
    bf16* O; int ldc; const float* rs; int rsel;
    __device__ __forceinline__ void operator()(const f32x4 (&acc)[2][2][4][2], const Unit& u, int wr, int wc, int fr, int fq) const {
        const int row0 = u.pm * BM + wr * 64 + fr; const int col0 = u.pn * BM + wc * 32 + 8 * fq;
#pragma unroll
        for (int ai = 0; ai < 2; ++ai)
#pragma unroll
            for (int m = 0; m < 4; ++m) { const int row = row0 + ai * HALF + m * 16; bf16* rowp = O + (size_t)row * ldc + col0;
                const float sc = rs ? rs[(size_t)row * 2 + rsel] : 1.0f;
#pragma unroll
                for (int bj = 0; bj < 2; ++bj) { const f32x4 v0 = acc[ai][bj][m][0] * sc, v1 = acc[ai][bj][m][1] * sc;
                    u32x4 w; w.x = pk2(v0[0], v0[1]); w.y = pk2(v0[2], v0[3]); w.z = pk2(v1[0], v1[1]); w.w = pk2(v1[2], v1[3]);
                    *(u32x4*)(rowp + bj * HALF) = w; } }
    }
};
struct Merge {
    static constexpr bool PERM = true, AFTER_DRAIN = false;
    bf16* MG; const bf16* GLG; const float* gbias;
    __device__ __forceinline__ void operator()(const f32x4 (&acc)[2][2][4][2], const Unit& u, int wr, int wc, int fr, int fq) const {
        const int n = u.tag; const int row0 = u.pm * BM + wr * 64 + fr; const int col0 = (u.pn & 3) * BM + wc * 32 + 8 * fq;
        if (n > 0) asm volatile("s_waitcnt vmcnt(0)" ::: "memory");
#pragma unroll
        for (int ai = 0; ai < 2; ++ai)
#pragma unroll
            for (int m = 0; m < 4; ++m) { const int row = row0 + ai * HALF + m * 16;
#pragma unroll
                for (int bj = 0; bj < 2; ++bj) { const int col = col0 + bj * HALF;
                    const u32x4 gl = *(const u32x4*)(GLG + (size_t)row * 3072 + n * 1024 + col);
                    const f32x4 b0 = *(const f32x4*)(gbias + n * 1024 + col), b1 = *(const f32x4*)(gbias + n * 1024 + col + 4);
                    float g[8]; unpack8(gl, g);
                    float v[8];
                    const f32x4 a0 = acc[ai][bj][m][0], a1 = acc[ai][bj][m][1];
                    v[0] = a0[0] * sigmoidf_(g[0] + b0[0]); v[1] = a0[1] * sigmoidf_(g[1] + b0[1]); v[2] = a0[2] * sigmoidf_(g[2] + b0[2]); v[3] = a0[3] * sigmoidf_(g[3] + b0[3]);
                    v[4] = a1[0] * sigmoidf_(g[4] + b1[0]); v[5] = a1[1] * sigmoidf_(g[5] + b1[1]); v[6] = a1[2] * sigmoidf_(g[6] + b1[2]); v[7] = a1[3] * sigmoidf_(g[7] + b1[3]);
                    bf16* mp = MG + (size_t)row * 1024 + col;
                    if (n > 0) {
                        const unsigned long long p0 = __hip_atomic_load((const unsigned long long*)mp, __ATOMIC_RELAXED, __HIP_MEMORY_SCOPE_AGENT);
                        const unsigned long long p1 = __hip_atomic_load((const unsigned long long*)mp + 1, __ATOMIC_RELAXED, __HIP_MEMORY_SCOPE_AGENT);
                        u32x4 pv; pv.x = (unsigned)p0; pv.y = (unsigned)(p0 >> 32); pv.z = (unsigned)p1; pv.w = (unsigned)(p1 >> 32);
                        float pf[8]; unpack8(pv, pf);
#pragma unroll
                        for (int e = 0; e < 8; ++e) v[e] += pf[e];
                    }
                    *(u32x4*)mp = pack8(v); } }
    }
};
struct OutRes {
    static constexpr bool PERM = true, AFTER_DRAIN = false;
    float* Y; const float* H;
    __device__ __forceinline__ void operator()(const f32x4 (&acc)[2][2][4][2], const Unit& u, int wr, int wc, int fr, int fq) const {
        const int row0 = u.pm * BM + wr * 64 + fr; const int col0 = u.pn * BM + wc * 32 + 8 * fq;
#pragma unroll
        for (int ai = 0; ai < 2; ++ai)
#pragma unroll
            for (int m = 0; m < 4; ++m) { const size_t off = (size_t)(row0 + ai * HALF + m * 16) * 1024 + col0;
#pragma unroll
                for (int bj = 0; bj < 2; ++bj) {
                    const f32x4 h0 = *(const f32x4*)(H + off + bj * HALF), h1 = *(const f32x4*)(H + off + bj * HALF + 4);
                    *(f32x4*)(Y + off + bj * HALF) = h0 * DN_ALPHA + acc[ai][bj][m][0]; *(f32x4*)(Y + off + bj * HALF + 4) = h1 * DN_ALPHA + acc[ai][bj][m][1]; } }
    }
};
struct MergeOrder {
    pg8::StaticOrder so;
    __device__ void init(int G, int c) { so.init(MROWS, 1024, G, c); }
    __device__ bool next(int i, Unit& u) const {
        Unit b; if (!so.next(i / 3, b)) return false; const int n = i % 3;
        u.pm = b.pm; u.pn = 4 * n + b.pn; u.za = 512 * n; u.tag = n; return true;
    }
    __device__ __forceinline__ void a_ready(const Unit&) const {}
    __device__ __forceinline__ void done(const Unit&) const {}
};
}

__device__ __forceinline__ void p2_moba_block(const Frame& F, int u) {
    bf16* P2 = (bf16*)(F.ws + OFF_PROJ2);
    const float* cosB = (const float*)(F.ws + OFF_COSB); const float* sinB = (const float*)(F.ws + OFF_SINB);
    const int c = F.tid & 63, rg = F.tid >> 6;
    const int hh = c >> 3, cc = c & 7;
    float acc[16];
#pragma unroll
    for (int e = 0; e < 16; ++e) acc[e] = 0.f;
    for (int r = rg; r < 256; r += 8) {
        const size_t m = (size_t)u * 256 + r;
        if (cc <= 1) {
            bf16* p = P2 + m * P2LD + (cc == 0 ? C2_MK : C2_MQ) + hh * 64;
            const u32x4 a = *(const u32x4*)p, b = *(const u32x4*)(p + 8);
            float x1[8], x2[8], o1[8], o2[8]; unpack8(a, x1); unpack8(b, x2);
            const f32x4 c0 = *(const f32x4*)(cosB + m * 8), c1 = *(const f32x4*)(cosB + m * 8 + 4), s0 = *(const f32x4*)(sinB + m * 8), s1 = *(const f32x4*)(sinB + m * 8 + 4);
            const float cs[8] = {c0[0], c0[1], c0[2], c0[3], c1[0], c1[1], c1[2], c1[3]}, sn[8] = {s0[0], s0[1], s0[2], s0[3], s1[0], s1[1], s1[2], s1[3]};
#pragma unroll
            for (int e = 0; e < 8; ++e) { o1[e] = x1[e] * cs[e] - x2[e] * sn[e]; o2[e] = x2[e] * cs[e] + x1[e] * sn[e]; }
            const u32x4 w1 = pack8(o1), w2 = pack8(o2);
            *(u32x4*)p = w1; *(u32x4*)(p + 8) = w2;
            if (cc == 0) { float r1[8], r2[8]; unpack8(w1, r1); unpack8(w2, r2);
#pragma unroll
                for (int e = 0; e < 8; ++e) { acc[e] += r1[e]; acc[8 + e] += r2[e]; } }
        } else {
            const u32x4 a = *(const u32x4*)(P2 + m * P2LD + C2_MK + 8 * c);
            float x[8]; unpack8(a, x);
#pragma unroll
            for (int e = 0; e < 8; ++e) acc[e] += x[e];
        }
    }
    LAS float* red = (LAS float*)F.lds;
    __syncthreads();
    if (cc == 0) {
#pragma unroll
        for (int e = 0; e < 16; ++e) red[rg * 512 + hh * 64 + e] = acc[e];
    } else if (cc >= 2) {
#pragma unroll
        for (int e = 0; e < 8; ++e) red[rg * 512 + 8 * c + e] = acc[e];
    }
    __syncthreads();
    {
        float s = 0.f;
#pragma unroll
        for (int g = 0; g < 8; ++g) s += red[g * 512 + F.tid];
        const int b = u >> 3, blk = u & 7, h = F.tid >> 6, d = F.tid & 63;
        ((float*)(F.ws + OFF_KMEAN))[((b * 8 + blk) * 8 + h) * 64 + d] = s * (1.0f / 256.0f);
    }
    __syncthreads();
}

__device__ __forceinline__ void p2_row(const Frame& F, int m) {
    const bf16* P1 = (const bf16*)(F.ws + OFF_PROJ1) + (size_t)m * P1LD;
    const int lane = F.lane;
    float sq = 0.f, skv = 0.f;
    {
        const u32x4 a = *(const u32x4*)(P1 + 8 * lane); float x[8]; unpack8(a, x);
#pragma unroll
        for (int e = 0; e < 8; ++e) sq += x[e] * x[e];
        if (lane < 32) { const u32x4 b = *(const u32x4*)(P1 + 512 + 8 * lane); unpack8(b, x);
#pragma unroll
            for (int e = 0; e < 8; ++e) sq += x[e] * x[e]; }
        else { const u32x4 b = *(const u32x4*)(P1 + 768 + 8 * (lane - 32)); unpack8(b, x);
#pragma unroll
            for (int e = 0; e < 8; ++e) skv += x[e] * x[e]; }
    }
    sq = wave_sum(sq); skv = wave_sum(skv);
    if (lane == 0) { float* rs = (float*)(F.ws + OFF_RSTD) + (size_t)m * 2; rs[0] = 1.0f / sqrtf(sq * (1.0f / 768.0f) + RMS_EPS); rs[1] = 1.0f / sqrtf(skv * (1.0f / 256.0f) + RMS_EPS); }
    if (lane < 16) {
        const float x1 = bf1(P1[1024 + lane]), x2 = bf1(P1[1040 + lane]);
        const float c = ((const float*)(F.ws + OFF_COSA))[(size_t)m * 16 + lane], s = ((const float*)(F.ws + OFF_SINA))[(size_t)m * 16 + lane];
        bf16* kr = (bf16*)(F.ws + OFF_KR) + (size_t)m * 32;
        kr[lane] = (bf16)f2bf(x1 * c - x2 * s); kr[16 + lane] = (bf16)f2bf(x2 * c + x1 * s);
    }
}

template <int I> struct SubstRow {
    static __device__ __forceinline__ void run(float (&t)[64], const LAS float* A, int c) {
        float s0 = (I == c) ? 1.0f : 0.0f, s1 = 0.f, s2 = 0.f, s3 = 0.f;
        const LAS float* row = A + I * 68;
#pragma unroll
        for (int j = 0; j + 3 < I; j += 4) { const f32x4 a = *(const LAS f32x4*)(row + j); s0 -= a[0] * t[j]; s1 -= a[1] * t[j + 1]; s2 -= a[2] * t[j + 2]; s3 -= a[3] * t[j + 3]; }
#pragma unroll
        for (int j = (I / 4) * 4; j < I; ++j) s0 -= row[j] * t[j];
        t[I] = (s0 + s1) + (s2 + s3);
        SubstRow<I + 1>::run(t, A, c);
    }
};
template <> struct SubstRow<64> { static __device__ __forceinline__ void run(float (&)[64], const LAS float*, int) {} };

__device__ __forceinline__ void gdn_chunk_wave(const Frame& F, const Params& P, int l, int ch, LAS float* Asm) {
    const int lane = F.lane, i16 = lane & 15, kq = lane >> 4;
    const int h = ch & 7, c = (ch >> 3) & 31, b = ch >> 8;
    const size_t t0 = (size_t)b * SEQ + c * 64;
    const bf16* P2 = (const bf16*)(F.ws + OFF_PROJ2);
    bf16* G = (bf16*)(F.ws + OFF_GDN) + (size_t)ch * 6 * GDN_MAT;
    const float* convw = (const float*)P.in[9] + (size_t)l * 4 * 1536;
    float g, beta;
    {
        const float ga = bf1(P2[(t0 + lane) * P2LD + C2_GA + h]), gb = bf1(P2[(t0 + lane) * P2LD + C2_GB + h]);
        const float Al = ((const float*)P.in[10])[l * 8 + h], dtb = ((const float*)P.in[11])[l * 8 + h];
        g = -__expf(Al) * softplusf_(ga + dtb); beta = sigmoidf_(gb);
    }
    float gc = g;
#pragma unroll
    for (int o = 1; o < 64; o <<= 1) { const float t = __shfl_up(gc, o); if (lane >= o) gc += t; }
    const float glast = __shfl(gc, 63);
    if (lane == 0) ((float*)(F.ws + OFF_GLS))[ch] = __expf(glast);
    bf16x8 qf[4][2], kf[4][2];
    float gct[4], btk[4];
#pragma unroll
    for (int mt = 0; mt < 4; ++mt) { gct[mt] = __shfl(gc, 16 * mt + i16); btk[mt] = __shfl(beta, 16 * mt + i16); }
    float ssq_q[4], ssq_k[4];
#pragma unroll
    for (int mt = 0; mt < 4; ++mt) { ssq_q[mt] = 0.f; ssq_k[mt] = 0.f; }
    LAS u32x4* raw = (LAS u32x4*)Asm;
#pragma unroll 1
    for (int blk = 0; blk < 6; ++blk) {
        const int w3 = blk >> 1, ks = blk & 1;
        const int c0 = 32 * ks + 8 * kq;
        const int pcol = C2_GQ + w3 * 512 + h * 64 + c0, wcol = w3 * 512 + h * 64 + c0;
        float wt[4][8];
#pragma unroll
        for (int j = 0; j < 4; ++j) { const f32x4 w0 = *(const f32x4*)(convw + j * 1536 + wcol), w1 = *(const f32x4*)(convw + j * 1536 + wcol + 4);
            wt[j][0] = w0[0]; wt[j][1] = w0[1]; wt[j][2] = w0[2]; wt[j][3] = w0[3]; wt[j][4] = w1[0]; wt[j][5] = w1[1]; wt[j][6] = w1[2]; wt[j][7] = w1[3]; }
#pragma unroll
        for (int mt = 0; mt < 4; ++mt) {
            const int tok = 16 * mt + i16;
            float a8[8];
#pragma unroll
            for (int e = 0; e < 8; ++e) a8[e] = 0.f;
#pragma unroll
            for (int j = 0; j < 4; ++j) {
                const int s = c * 64 + tok - 3 + j;
                u32x4 xv = (u32x4){0u, 0u, 0u, 0u};
                if (s >= 0) xv = *(const u32x4*)(P2 + ((size_t)b * SEQ + s) * P2LD + pcol);
                float x[8]; unpack8(xv, x);
#pragma unroll
                for (int e = 0; e < 8; ++e) a8[e] += x[e] * wt[j][e];
            }
#pragma unroll
            for (int e = 0; e < 8; ++e) a8[e] = siluf_(a8[e]);
            if (w3 == 2) {
#pragma unroll
                for (int e = 0; e < 8; ++e) G[3 * GDN_MAT + (c0 + e) * 64 + tok] = (bf16)f2bf(a8[e] * btk[mt]);
            } else {
                float ss = 0.f;
#pragma unroll
                for (int e = 0; e < 8; ++e) ss += a8[e] * a8[e];
                ssq_q[mt] += (w3 == 0) ? ss : 0.f; ssq_k[mt] += (w3 == 1) ? ss : 0.f;
                raw[((w3 * 4 + mt) * 2 + ks) * 64 + lane] = pack8(a8);
            }
        }
    }
    LDS_WAIT(); asm volatile("" ::: "memory");
#pragma unroll
    for (int mt = 0; mt < 4; ++mt) {
        const int tok = 16 * mt + i16;
        float sq = ssq_q[mt], sk = ssq_k[mt];
        sq += __shfl_xor(sq, 16); sq += __shfl_xor(sq, 32); sk += __shfl_xor(sk, 16); sk += __shfl_xor(sk, 32);
        const float rq = 0.125f / sqrtf(sq + RMS_EPS), rk = 1.0f / sqrtf(sk + RMS_EPS);
        const float eg = __expf(gct[mt]), ed = __expf(glast - gct[mt]), bt = btk[mt];
#pragma unroll
        for (int ks = 0; ks < 2; ++ks) {
            const int c0 = 32 * ks + 8 * kq;
            float q[8], k[8], tq[8], tk[8];
            unpack8(raw[((0 * 4 + mt) * 2 + ks) * 64 + lane], q); unpack8(raw[((1 * 4 + mt) * 2 + ks) * 64 + lane], k);
#pragma unroll
            for (int e = 0; e < 8; ++e) { q[e] *= rq; k[e] *= rk; }
            qf[mt][ks] = __builtin_bit_cast(bf16x8, pack8(q)); kf[mt][ks] = __builtin_bit_cast(bf16x8, pack8(k));
#pragma unroll
            for (int e = 0; e < 8; ++e) { tq[e] = q[e] * eg; tk[e] = -k[e] * bt * eg; }
            *(u32x4*)(G + 0 * GDN_MAT + tok * 64 + c0) = pack8(tq);
            *(u32x4*)(G + 1 * GDN_MAT + tok * 64 + c0) = pack8(tk);
#pragma unroll
            for (int e = 0; e < 8; ++e) G[2 * GDN_MAT + (c0 + e) * 64 + tok] = (bf16)f2bf(k[e] * ed);
        }
    }
    LDS_WAIT(); asm volatile("" ::: "memory");
#pragma unroll
    for (int mt = 0; mt < 4; ++mt) {
        const int i = 16 * mt + i16; const float bti = __shfl(beta, i);
#pragma unroll
        for (int nt = 0; nt < 4; ++nt) {
            f32x4 sqk = {0.f, 0.f, 0.f, 0.f}, skk = {0.f, 0.f, 0.f, 0.f};
            if (nt <= mt) {
#pragma unroll
                for (int ks = 0; ks < 2; ++ks) {
                    sqk = __builtin_amdgcn_mfma_f32_16x16x32_bf16(kf[nt][ks], qf[mt][ks], sqk, 0, 0, 0);
                    skk = __builtin_amdgcn_mfma_f32_16x16x32_bf16(kf[nt][ks], kf[mt][ks], skk, 0, 0, 0);
                }
            }
            float oq[4], oa[4];
#pragma unroll
            for (int r = 0; r < 4; ++r) {
                const int j = 16 * nt + 4 * kq + r; const float gcj = __shfl(gc, j);
                const float dec = (j <= i) ? __expf(gct[mt] - gcj) : 0.f;
                oq[r] = sqk[r] * dec; oa[r] = (j < i) ? skk[r] * dec * bti : 0.f;
            }
            u32x2 w; w.x = pk2(oq[0], oq[1]); w.y = pk2(oq[2], oq[3]);
            *(u32x2*)(G + 5 * GDN_MAT + i * 64 + 16 * nt + 4 * kq) = w;
            *(LAS f32x4*)(Asm + i * 68 + 16 * nt + 4 * kq) = (f32x4){oa[0], oa[1], oa[2], oa[3]};
        }
    }
    LDS_WAIT(); asm volatile("" ::: "memory");
#ifndef NO_SUBST
    float t[64];
    SubstRow<0>::run(t, Asm, lane);
#pragma unroll
    for (int i = 0; i < 64; ++i) G[4 * GDN_MAT + i * 64 + lane] = (bf16)f2bf(t[i]);
#endif
    LDS_WAIT(); asm volatile("" ::: "memory");
}

__device__ __forceinline__ void p2_phase(const Frame& F, const Params& P, int l) {
    if (F.bid < 64) p2_moba_block(F, F.bid);
    const int gw = ((F.bid + F.G - 64) % F.G) * NWAVES + F.wave, NGW = F.G * NWAVES;
    for (int m = gw; m < MROWS; m += NGW) p2_row(F, m);
    LAS float* Asm = (LAS float*)(F.lds + F.wave * 17408);
    for (int ch = gw; ch < 2048; ch += NGW) gdn_chunk_wave(F, P, l, ch, Asm);
}

typedef short v4i16_t __attribute__((ext_vector_type(4)));
__device__ __forceinline__ s16x4 ds_tr16(const LAS bf16* p) { return __builtin_bit_cast(s16x4, __builtin_amdgcn_ds_read_tr16_b64_v4i16((LAS v4i16_t*)p)); }
__device__ __forceinline__ int crow(int r, int hi) { return (r & 3) + 8 * (r >> 2) + 4 * hi; }

template <int DK, bool MOBA>
__device__ __forceinline__ void attn_unit(const Frame& F, int b, int h, int qb) {
    constexpr int KSTR = (DK == 96) ? 104 : 72;
    constexpr int VSTR = 96;
    constexpr int BUF = 64 * KSTR + 64 * VSTR;
    constexpr int NS = DK / 16;
    const int tid = F.tid, lane = F.lane, w = F.wave, ql = lane & 31, hh = lane >> 5;
    LAS bf16* L = (LAS bf16*)F.lds;
    const bf16* Qs; const bf16* Ks; const bf16* Vs; int ldq, ldk; float scale;
    if (MOBA) { const bf16* P2 = (const bf16*)(F.ws + OFF_PROJ2); Qs = P2 + C2_MQ + h * 64; Ks = P2 + C2_MK + h * 64; Vs = P2 + C2_MV + h * 64; ldq = P2LD; ldk = P2LD; scale = 0.125f * 1.4426950408889634f; }
    else { Qs = (const bf16*)(F.ws + OFF_QMLA) + h * 96; const bf16* KV = (const bf16*)(F.ws + OFF_KVMLA) + h * 128; Ks = KV; Vs = KV + 64; ldq = 768; ldk = 1024; scale = 0.10206207261596575f * 1.4426950408889634f; }
    const bf16* KR = (const bf16*)(F.ws + OFF_KR);
    const size_t mb = (size_t)b * SEQ;
    const size_t mq = mb + qb * 256 + w * 32 + ql;

    unsigned selbits = 0;
    if (MOBA) {
        if (qb <= 3) selbits = (1u << qb) - 1u;
        else {
            LAS float* kml = (LAS float*)(F.lds + 2 * BUF * 2);
            __syncthreads();
            if (tid < qb * 64) kml[tid] = ((const float*)(F.ws + OFF_KMEAN))[((b * 8 + (tid >> 6)) * 8 + h) * 64 + (tid & 63)];
            __syncthreads();
            float qv[64];
#pragma unroll
            for (int c8 = 0; c8 < 8; ++c8) { const u32x4 a = *(const u32x4*)(Qs + mq * ldq + 8 * c8); unpack8(a, qv + 8 * c8); }
            float g0 = -3e38f, g1 = -3e38f, g2 = -3e38f; int i0 = 0, i1 = 0, i2 = 0;
            for (int j = 0; j < qb; ++j) {
                float s = 0.f;
#pragma unroll
                for (int d = 0; d < 64; ++d) s += qv[d] * kml[j * 64 + d];
                if (s > g0) { g2 = g1; i2 = i1; g1 = g0; i1 = i0; g0 = s; i0 = j; }
                else if (s > g1) { g2 = g1; i2 = i1; g1 = s; i1 = j; }
                else if (s > g2) { g2 = s; i2 = j; }
            }
            selbits = (1u << i0) | (1u << i1) | (1u << i2);
        }
    }
    bf16x8 qf[NS];
    {
        float qx[NS][8];
#pragma unroll
        for (int s = 0; s < NS; ++s) { const u32x4 a = *(const u32x4*)(Qs + mq * ldq + 16 * s + 8 * hh); unpack8(a, qx[s]); }
        if (!MOBA) {
            const float* cp = (const float*)(F.ws + OFF_COSA) + mq * 16 + 8 * hh; const float* sp = (const float*)(F.ws + OFF_SINA) + mq * 16 + 8 * hh;
            const f32x4 c0 = *(const f32x4*)cp, c1 = *(const f32x4*)(cp + 4), s0 = *(const f32x4*)sp, s1 = *(const f32x4*)(sp + 4);
            const float cs[8] = {c0[0], c0[1], c0[2], c0[3], c1[0], c1[1], c1[2], c1[3]}, sn[8] = {s0[0], s0[1], s0[2], s0[3], s1[0], s1[1], s1[2], s1[3]};
#pragma unroll
            for (int e = 0; e < 8; ++e) { const float x1 = qx[NS - 2][e], x2 = qx[NS - 1][e]; qx[NS - 2][e] = x1 * cs[e] - x2 * sn[e]; qx[NS - 1][e] = x2 * cs[e] + x1 * sn[e]; }
        }
#pragma unroll
        for (int s = 0; s < NS; ++s) {
#pragma unroll
            for (int e = 0; e < 8; ++e) qx[s][e] *= scale;
            qf[s] = __builtin_bit_cast(bf16x8, pack8(qx[s]));
        }
    }
    const int skr = tid >> 3, sc8 = tid & 7;
    const int rkr = tid >> 2, rc4 = tid & 3;
    const int ntile = 4 * (qb + 1);
    auto tile_of = [&](int it) -> int { return MOBA ? (it < 4 ? 4 * qb + it : it - 4) : it; };
    u32x4 rk, rv, rr;
    auto gload = [&](int t) {
        const size_t kb = mb + (size_t)t * 64;
        rk = *(const u32x4*)(Ks + (kb + skr) * ldk + 8 * sc8);
        rv = *(const u32x4*)(Vs + (kb + skr) * ldk + 8 * sc8);
        if (DK == 96 && tid < 256) rr = *(const u32x4*)(KR + (kb + rkr) * 32 + 8 * rc4);
    };
    auto lstore = [&](int buf) {
        LAS bf16* Kt = L + buf * BUF; LAS bf16* Vt = Kt + 64 * KSTR;
        *(LAS u32x4*)(Kt + skr * KSTR + 8 * sc8) = rk;
        *(LAS u32x4*)(Vt + skr * VSTR + 8 * sc8) = rv;
        if (DK == 96 && tid < 256) *(LAS u32x4*)(Kt + rkr * KSTR + 64 + 8 * rc4) = rr;
    };
    float mrun = -1e30f, lrun = 0.f;
    f32x16 o0 = {}, o1 = {};
    __syncthreads();
    gload(tile_of(0)); lstore(0);
    __syncthreads();
    for (int it = 0; it < ntile; ++it) {
        const int t = tile_of(it);
        if (it + 1 < ntile) gload(tile_of(it + 1));
        const bool diag = t >= 4 * qb; const int tb = t - 4 * qb;
        bool active = true;
        if (diag) active = tb <= (w >> 1);
        bool rowsel = true;
        if (MOBA && !diag) { rowsel = (selbits >> (t >> 2)) & 1u; active = __any(rowsel) != 0; }
        if (active) {
            const LAS bf16* Kt = L + (it & 1) * BUF; const LAS bf16* Vt = Kt + 64 * KSTR;
            f32x16 p0 = {}, p1 = {};
#pragma unroll
            for (int s = 0; s < NS; ++s) {
                const bf16x8 a0 = *(const LAS bf16x8*)(Kt + ql * KSTR + 16 * s + 8 * hh);
                const bf16x8 a1 = *(const LAS bf16x8*)(Kt + (32 + ql) * KSTR + 16 * s + 8 * hh);
                p0 = __builtin_amdgcn_mfma_f32_32x32x16_bf16(a0, qf[s], p0, 0, 0, 0);
                p1 = __builtin_amdgcn_mfma_f32_32x32x16_bf16(a1, qf[s], p1, 0, 0, 0);
            }
            if (diag) {
                const int qloc = 32 * w + ql;
#pragma unroll
                for (int r = 0; r < 16; ++r) { const int kl = 64 * tb + crow(r, hh); if (kl > qloc) p0[r] = -1e30f; if (kl + 32 > qloc) p1[r] = -1e30f; }
            }
            if (MOBA && !diag && !rowsel) {
#pragma unroll
                for (int r = 0; r < 16; ++r) { p0[r] = -1e30f; p1[r] = -1e30f; }
            }
            float mx = p0[0];
#pragma unroll
            for (int r = 1; r < 16; ++r) mx = fmaxf(mx, p0[r]);
#pragma unroll
            for (int r = 0; r < 16; ++r) mx = fmaxf(mx, p1[r]);
            mx = fmaxf(mx, __shfl_xor(mx, 32));
            const float mnew = fmaxf(mrun, mx);
            const float alpha = __builtin_amdgcn_exp2f(mrun - mnew);
            mrun = mnew;
            float ps = 0.f;
#pragma unroll
            for (int r = 0; r < 16; ++r) { p0[r] = __builtin_amdgcn_exp2f(p0[r] - mnew); p1[r] = __builtin_amdgcn_exp2f(p1[r] - mnew); ps += p0[r] + p1[r]; }
            lrun = lrun * alpha + ps;
#pragma unroll
            for (int r = 0; r < 16; ++r) { o0[r] *= alpha; o1[r] *= alpha; }
            bf16x8 pf[4];
            { float tmp[8];
#pragma unroll
              for (int e = 0; e < 8; ++e) tmp[e] = p0[e];
              pf[0] = __builtin_bit_cast(bf16x8, pack8(tmp));
#pragma unroll
              for (int e = 0; e < 8; ++e) tmp[e] = p0[8 + e];
              pf[1] = __builtin_bit_cast(bf16x8, pack8(tmp));
#pragma unroll
              for (int e = 0; e < 8; ++e) tmp[e] = p1[e];
              pf[2] = __builtin_bit_cast(bf16x8, pack8(tmp));
#pragma unroll
              for (int e = 0; e < 8; ++e) tmp[e] = p1[8 + e];
              pf[3] = __builtin_bit_cast(bf16x8, pack8(tmp)); }
            const int i15 = lane & 15, dblk = (lane >> 4) & 1;
#pragma unroll
            for (int s4 = 0; s4 < 4; ++s4) {
                const int key0 = 16 * s4 + 4 * hh;
#pragma unroll
                for (int dt = 0; dt < 2; ++dt) {
                    const LAS bf16* va = Vt + (key0 + (i15 >> 2)) * VSTR + 32 * dt + 16 * dblk + 4 * (i15 & 3);
                    const s16x4 lo = ds_tr16(va), hi2 = ds_tr16(va + 8 * VSTR);
                    const bf16x8 vf = (bf16x8){lo[0], lo[1], lo[2], lo[3], hi2[0], hi2[1], hi2[2], hi2[3]};
                    if (dt == 0) o0 = __builtin_amdgcn_mfma_f32_32x32x16_bf16(vf, pf[s4], o0, 0, 0, 0);
                    else o1 = __builtin_amdgcn_mfma_f32_32x32x16_bf16(vf, pf[s4], o1, 0, 0, 0);
                }
            }
        }
        if (it + 1 < ntile) lstore((it + 1) & 1);
        __syncthreads();
    }
    const float ltot = lrun + __shfl_xor(lrun, 32);
    const float inv = 1.0f / ltot;
    bf16* op = (bf16*)(F.ws + OFF_BR) + mq * BRLD + (MOBA ? 512 : 0) + h * 64;
#pragma unroll
    for (int g = 0; g < 4; ++g) {
        u32x2 w0, w1;
        w0.x = pk2(o0[4 * g] * inv, o0[4 * g + 1] * inv); w0.y = pk2(o0[4 * g + 2] * inv, o0[4 * g + 3] * inv);
        w1.x = pk2(o1[4 * g] * inv, o1[4 * g + 1] * inv); w1.y = pk2(o1[4 * g + 2] * inv, o1[4 * g + 3] * inv);
        *(u32x2*)(op + 8 * g + 4 * hh) = w0; *(u32x2*)(op + 32 + 8 * g + 4 * hh) = w1;
    }
}

__device__ __forceinline__ void gdn_scan_unit(const Frame& F, const Params& P, int l, int b, int h) {
    constexpr int BSTR = 72;
    constexpr int OSTR = 68;
    const int lane = F.lane, w = F.wave, i16 = lane & 15, kq = lane >> 4;
    LAS bf16* Sb = (LAS bf16*)F.lds;
    LAS bf16* XT = Sb + 64 * BSTR;
    LAS bf16* VT = XT + 64 * BSTR;
    LAS float* Ob = (LAS float*)(F.lds + 3 * 64 * BSTR * 2);
    const bf16* Gb = (const bf16*)(F.ws + OFF_GDN);
    const float* gls = (const float*)(F.ws + OFF_GLS);
    const bf16* P2 = (const bf16*)(F.ws + OFF_PROJ2);
    bf16* BR = (bf16*)(F.ws + OFF_BR);
    const float* onorm = (const float*)P.in[12] + l * 64;
    __syncthreads();
    f32x4 Sacc[4];
#pragma unroll
    for (int m = 0; m < 4; ++m) Sacc[m] = (f32x4){0.f, 0.f, 0.f, 0.f};
    if (w < 4) {
#pragma unroll
        for (int m = 0; m < 4; ++m) *(LAS u32x2*)(Sb + (16 * w + i16) * BSTR + 16 * m + 4 * kq) = (u32x2){0u, 0u};
    }
    for (int c = 0; c <= 32; ++c) {
        if (w < 4 && c < 32) {
            const int ch = (b * 32 + c) * 8 + h;
            const bf16* G = Gb + (size_t)ch * 6 * GDN_MAT;
            const float gl = ld_coh_f32((float*)gls + ch);
            const int dvr = 16 * w + i16;
#define AFRAG(mat, mt, ks) (*(const bf16x8*)(G + (mat) * GDN_MAT + (16 * (mt) + i16) * 64 + 32 * (ks) + 8 * kq))
#define BFRAG(img, ks) (*(const LAS bf16x8*)((img) + dvr * BSTR + 32 * (ks) + 8 * kq))
            f32x4 acc[4];
#pragma unroll
            for (int m = 0; m < 4; ++m) { const u32x2 vb = *(const u32x2*)(G + 3 * GDN_MAT + dvr * 64 + 16 * m + 4 * kq); acc[m] = (f32x4){bflo(vb.x), bfhi(vb.x), bflo(vb.y), bfhi(vb.y)}; }
            {
                const bf16x8 s0 = BFRAG(Sb, 0), s1 = BFRAG(Sb, 1);
#pragma unroll
                for (int m = 0; m < 4; ++m) { acc[m] = __builtin_amdgcn_mfma_f32_16x16x32_bf16(AFRAG(1, m, 0), s0, acc[m], 0, 0, 0); acc[m] = __builtin_amdgcn_mfma_f32_16x16x32_bf16(AFRAG(1, m, 1), s1, acc[m], 0, 0, 0); }
                f32x4 oacc[4];
#pragma unroll
                for (int m = 0; m < 4; ++m) { oacc[m] = __builtin_amdgcn_mfma_f32_16x16x32_bf16(AFRAG(0, m, 0), s0, (f32x4){0.f, 0.f, 0.f, 0.f}, 0, 0, 0); oacc[m] = __builtin_amdgcn_mfma_f32_16x16x32_bf16(AFRAG(0, m, 1), s1, oacc[m], 0, 0, 0); }
#pragma unroll
                for (int m = 0; m < 4; ++m) { u32x2 wv; wv.x = pk2(acc[m][0], acc[m][1]); wv.y = pk2(acc[m][2], acc[m][3]); *(LAS u32x2*)(XT + dvr * BSTR + 16 * m + 4 * kq) = wv; }
                const bf16x8 x0 = BFRAG(XT, 0), x1 = BFRAG(XT, 1);
#pragma unroll
                for (int m = 0; m < 4; ++m) { acc[m] = __builtin_amdgcn_mfma_f32_16x16x32_bf16(AFRAG(4, m, 0), x0, (f32x4){0.f, 0.f, 0.f, 0.f}, 0, 0, 0); acc[m] = __builtin_amdgcn_mfma_f32_16x16x32_bf16(AFRAG(4, m, 1), x1, acc[m], 0, 0, 0); }
#pragma unroll
                for (int m = 0; m < 4; ++m) { u32x2 wv; wv.x = pk2(acc[m][0], acc[m][1]); wv.y = pk2(acc[m][2], acc[m][3]); *(LAS u32x2*)(VT + dvr * BSTR + 16 * m + 4 * kq) = wv; }
                const bf16x8 v0 = BFRAG(VT, 0), v1 = BFRAG(VT, 1);
#pragma unroll
                for (int m = 0; m < 4; ++m) { oacc[m] = __builtin_amdgcn_mfma_f32_16x16x32_bf16(AFRAG(5, m, 0), v0, oacc[m], 0, 0, 0); oacc[m] = __builtin_amdgcn_mfma_f32_16x16x32_bf16(AFRAG(5, m, 1), v1, oacc[m], 0, 0, 0); }
                LAS float* Oc = Ob + (c & 1) * 64 * OSTR;
#pragma unroll
                for (int m = 0; m < 4; ++m)
#pragma unroll
                    for (int r = 0; r < 4; ++r) Oc[(16 * m + 4 * kq + r) * OSTR + dvr] = oacc[m][r];
#pragma unroll
                for (int m = 0; m < 4; ++m) { Sacc[m] = Sacc[m] * gl; Sacc[m] = __builtin_amdgcn_mfma_f32_16x16x32_bf16(AFRAG(2, m, 0), v0, Sacc[m], 0, 0, 0); Sacc[m] = __builtin_amdgcn_mfma_f32_16x16x32_bf16(AFRAG(2, m, 1), v1, Sacc[m], 0, 0, 0); }
#pragma unroll
                for (int m = 0; m < 4; ++m) { u32x2 wv; wv.x = pk2(Sacc[m][0], Sacc[m][1]); wv.y = pk2(Sacc[m][2], Sacc[m][3]); *(LAS u32x2*)(Sb + dvr * BSTR + 16 * m + 4 * kq) = wv; }
            }
#undef AFRAG
#undef BFRAG
        }
        if (w >= 4 && c >= 1) {
            const int cc = c - 1; const LAS float* Oc = Ob + (cc & 1) * 64 * OSTR;
            const int tok = 16 * (w - 4) + i16; const size_t m = (size_t)b * SEQ + cc * 64 + tok;
            float o[16];
#pragma unroll
            for (int q4 = 0; q4 < 4; ++q4) { const f32x4 v = *(const LAS f32x4*)(Oc + tok * OSTR + 16 * kq + 4 * q4); o[4 * q4] = v[0]; o[4 * q4 + 1] = v[1]; o[4 * q4 + 2] = v[2]; o[4 * q4 + 3] = v[3]; }
            float ss = 0.f;
#pragma unroll
            for (int e = 0; e < 16; ++e) ss += o[e] * o[e];
            ss += __shfl_xor(ss, 16); ss += __shfl_xor(ss, 32);
            const float rs = 1.0f / sqrtf(ss * (1.0f / 64.0f) + RMS_EPS);
            const bf16* zp = P2 + m * P2LD + C2_GZ + h * 64 + 16 * kq;
            float z[16]; unpack8(*(const u32x4*)zp, z); unpack8(*(const u32x4*)(zp + 8), z + 8);
            float r16[16];
#pragma unroll
            for (int e = 0; e < 16; ++e) r16[e] = o[e] * rs * onorm[16 * kq + e] * siluf_(z[e]);
            bf16* op = BR + m * BRLD + 1024 + h * 64 + 16 * kq;
            *(u32x4*)op = pack8(r16); *(u32x4*)(op + 8) = pack8(r16 + 8);
        }
        __syncthreads();
    }
}

__device__ __forceinline__ unsigned f2key(float f) { unsigned u = __builtin_bit_cast(unsigned, f); return (u & 0x80000000u) ? ~u : (u | 0x80000000u); }
__device__ __forceinline__ float key2f(unsigned k) { const unsigned u = (k & 0x80000000u) ? (k & 0x7fffffffu) : ~k; return __builtin_bit_cast(float, u); }

__device__ __forceinline__ void peer_topk_unit(const Frame& F, int l, int tt) {
    const int lane = F.lane, h = F.wave, tk = lane & 31, hh = lane >> 5;
    const size_t m = (size_t)tt * 32 + tk;
    const bf16* QRY = (const bf16*)(F.ws + OFF_QRY);
    const bf16* SK = (const bf16*)(F.ws + OFF_W + (size_t)l * W_LAYER + WO_SK);
    LAS int* li = (LAS int*)F.lds + F.tid * 33;
    unsigned top[2][16];
#pragma unroll
    for (int p = 0; p < 2; ++p) {
        bf16x8 qf[8];
#pragma unroll
        for (int s = 0; s < 8; ++s) qf[s] = *(const bf16x8*)(QRY + m * 2048 + (2 * h + p) * 128 + 16 * s + 8 * hh);
        unsigned key[64];
#pragma unroll
        for (int kt = 0; kt < 4; ++kt) {
            f32x16 acc = {};
            const bf16* kp = SK + ((size_t)(h * 2 + p) * 128 + 32 * kt + tk) * 128 + 8 * hh;
#pragma unroll
            for (int s = 0; s < 8; ++s) acc = __builtin_amdgcn_mfma_f32_32x32x16_bf16(*(const bf16x8*)(kp + 16 * s), qf[s], acc, 0, 0, 0);
#pragma unroll
            for (int r = 0; r < 16; ++r) { const int kidx = 32 * kt + crow(r, hh); key[16 * kt + r] = (f2key(acc[r]) & ~0x7fu) | (unsigned)(127 - kidx); }
        }
#pragma unroll
        for (int rd = 0; rd < 16; ++rd) {
            unsigned mx = key[0];
#pragma unroll
            for (int e = 1; e < 64; ++e) mx = mx > key[e] ? mx : key[e];
            const unsigned ox = (unsigned)__shfl_xor((int)mx, 32);
            mx = mx > ox ? mx : ox;
            top[p][rd] = mx;
#pragma unroll
            for (int e = 0; e < 64; ++e) key[e] = (key[e] == mx) ? 0u : key[e];
        }
    }
    float v1[16], v2[16];
#pragma unroll
    for (int a = 0; a < 16; ++a) { li[a] = 127 - (int)(top[0][a] & 0x7fu); li[16 + a] = 127 - (int)(top[1][a] & 0x7fu); v1[a] = key2f(top[0][a] & ~0x7fu); v2[a] = key2f(top[1][a] & ~0x7fu); }
    unsigned ck[25];
#pragma unroll
    for (int e = 0; e < 25; ++e) ck[e] = 0u;
    {
        int n = 0;
#pragma unroll
        for (int a = 0; a < 16; ++a)
#pragma unroll
            for (int bb = 0; bb < 16; ++bb)
                if ((a + 1) * (bb + 1) <= 16) {
                    const int slot = n % 25, owner = n / 25;
                    const unsigned kv = (f2key(v1[a] + v2[bb]) & ~0xffu) | (unsigned)(255 - (16 * a + bb));
                    if (owner == 0) ck[slot] = (hh == 0) ? kv : ck[slot]; else ck[slot] = (hh == 1) ? kv : ck[slot];
                    ++n;
                }
    }
    unsigned win[16];
#pragma unroll
    for (int rd = 0; rd < 16; ++rd) {
        unsigned mx = ck[0];
#pragma unroll
        for (int e = 1; e < 25; ++e) mx = mx > ck[e] ? mx : ck[e];
        const unsigned ox = (unsigned)__shfl_xor((int)mx, 32);
        mx = mx > ox ? mx : ox;
        win[rd] = mx;
#pragma unroll
        for (int e = 0; e < 25; ++e) ck[e] = (ck[e] == mx) ? 0u : ck[e];
    }
    LDS_WAIT();
    float sv[16]; int ids[16];
#pragma unroll
    for (int rd = 0; rd < 16; ++rd) {
        const int flat = 255 - (int)(win[rd] & 0xffu), a = flat >> 4, bb = flat & 15;
        const int ia = li[a], ib = li[16 + bb];
        ids[rd] = ia * 128 + ib;
        float sa = 0.f, sb = 0.f;
#pragma unroll
        for (int e = 0; e < 16; ++e) { sa = (e == a) ? v1[e] : sa; sb = (e == bb) ? v2[e] : sb; }
        sv[rd] = sa + sb;
    }
    float mxv = sv[0];
#pragma unroll
    for (int e = 1; e < 16; ++e) mxv = fmaxf(mxv, sv[e]);
    float den = 0.f;
#pragma unroll
    for (int e = 0; e < 16; ++e) { sv[e] = __expf(sv[e] - mxv); den += sv[e]; }
    const float inv = 1.0f / den;
    if (hh == 0) { int* ip = (int*)(F.ws + OFF_IDX) + m * 128 + h * 16;
#pragma unroll
        for (int q4 = 0; q4 < 4; ++q4) *(u32x4*)(ip + 4 * q4) = (u32x4){(unsigned)ids[4 * q4], (unsigned)ids[4 * q4 + 1], (unsigned)ids[4 * q4 + 2], (unsigned)ids[4 * q4 + 3]}; }
    else { float* gp = (float*)(F.ws + OFF_GATE) + m * 128 + h * 16;
#pragma unroll
        for (int q4 = 0; q4 < 4; ++q4) *(f32x4*)(gp + 4 * q4) = (f32x4){sv[4 * q4] * inv, sv[4 * q4 + 1] * inv, sv[4 * q4 + 2] * inv, sv[4 * q4 + 3] * inv}; }
    LDS_WAIT();
}

constexpr float PEER_US = 256.0f, PEER_VS = 16.0f;
__device__ __forceinline__ float gelu_exact(float x) { return 0.5f * x * (1.0f + erff(x * 0.7071067811865475f)); }
__device__ __forceinline__ void fp8x16_to_f32(const u32x4 v, float* f) {
    const unsigned w[4] = {v.x, v.y, v.z, v.w};
#pragma unroll
    for (int i = 0; i < 4; ++i) { const f32x2 lo = __builtin_amdgcn_cvt_pk_f32_fp8((int)w[i], false), hi = __builtin_amdgcn_cvt_pk_f32_fp8((int)w[i], true);
        f[4 * i] = lo.x; f[4 * i + 1] = lo.y; f[4 * i + 2] = hi.x; f[4 * i + 3] = hi.y; }
}
__device__ __forceinline__ float dot16(const u32x4 u, const float* x) {
    float f[16]; fp8x16_to_f32(u, f);
    float s0 = 0.f, s1 = 0.f;
#pragma unroll
    for (int e = 0; e < 16; e += 2) { s0 += f[e] * x[e]; s1 += f[e + 1] * x[e + 1]; }
    return s0 + s1;
}
__device__ __forceinline__ void axpy16(float* o, float w, const u32x4 v) {
    float f[16]; fp8x16_to_f32(v, f);
#pragma unroll
    for (int e = 0; e < 16; ++e) o[e] += w * f[e];
}
__device__ __forceinline__ void peer_token(const Frame& F, const Params& P, int l, size_t m, bool last_layer, bool en_peer) {
    const int lane = F.lane;
    const unsigned char* PU = (const unsigned char*)(F.ws + OFF_PU); const unsigned char* PV = (const unsigned char*)(F.ws + OFF_PV);
    const bf16* hb = (const bf16*)(F.ws + OFF_HB) + m * DM + 16 * lane;
    float* hf = (float*)(F.ws + OFF_HF) + m * DM + 16 * lane;
    float x[16]; unpack8(*(const u32x4*)hb, x); unpack8(*(const u32x4*)(hb + 8), x + 8);
    const int id0 = ((const int*)(F.ws + OFF_IDX))[m * 128 + lane], id1 = ((const int*)(F.ws + OFF_IDX))[m * 128 + 64 + lane];
    const float g0 = ((const float*)(F.ws + OFF_GATE))[m * 128 + lane], g1 = ((const float*)(F.ws + OFF_GATE))[m * 128 + 64 + lane];
    float out[16];
#pragma unroll
    for (int e = 0; e < 16; ++e) out[e] = 0.f;
    const int jl = ((lane >> 5) & 1) * 8 + ((lane >> 4) & 1) * 4 + ((lane >> 3) & 1) * 2 + ((lane >> 2) & 1);
#pragma unroll 1
    for (int bt = 0; bt < (en_peer ? 8 : 0); ++bt) {
        u32x4 uu[16], vv[16];
#pragma unroll
        for (int j = 0; j < 16; ++j) {
            const int e = 16 * bt + j;
            const int id = __builtin_amdgcn_readlane(bt < 4 ? id0 : id1, e & 63);
            uu[j] = *(const u32x4*)(PU + (size_t)id * 1024 + 16 * lane); vv[j] = *(const u32x4*)(PV + (size_t)id * 1024 + 16 * lane);
        }
        float p[16];
#pragma unroll
        for (int j = 0; j < 16; ++j) p[j] = dot16(uu[j], x);
#pragma unroll
        for (int j = 0; j < 8; ++j) { const bool up_ = (lane & 32) != 0; const float send = up_ ? p[j] : p[j + 8]; const float recv = __shfl_xor(send, 32); p[j] = (up_ ? p[j + 8] : p[j]) + recv; }
#pragma unroll
        for (int j = 0; j < 4; ++j) { const bool up_ = (lane & 16) != 0; const float send = up_ ? p[j] : p[j + 4]; const float recv = __shfl_xor(send, 16); p[j] = (up_ ? p[j + 4] : p[j]) + recv; }
#pragma unroll
        for (int j = 0; j < 2; ++j) { const bool up_ = (lane & 8) != 0; const float send = up_ ? p[j] : p[j + 2]; const float recv = __shfl_xor(send, 8); p[j] = (up_ ? p[j + 2] : p[j]) + recv; }
        { const bool up_ = (lane & 4) != 0; const float send = up_ ? p[0] : p[1]; const float recv = __shfl_xor(send, 4); p[0] = (up_ ? p[1] : p[0]) + recv; }
        float d = p[0]; d += __shfl_xor(d, 2); d += __shfl_xor(d, 1);
        d *= (1.0f / PEER_US);
        const int esel = 16 * bt + jl;
        const float gsel = __shfl(bt < 4 ? g0 : g1, esel & 63);
        const float wsel = gelu_exact(d) * gsel * (1.0f / PEER_VS);
#pragma unroll
        for (int j = 0; j < 16; ++j) {
            const int src = ((j >> 3) & 1) * 32 + ((j >> 2) & 1) * 16 + ((j >> 1) & 1) * 8 + (j & 1) * 4;
            const float wj = __builtin_bit_cast(float, __builtin_amdgcn_readlane(__builtin_bit_cast(int, wsel), src));
            axpy16(out, wj, vv[j]);
        }
    }
    float y[16];
#pragma unroll
    for (int q4 = 0; q4 < 4; ++q4) { const f32x4 a = *(const f32x4*)(hf + 4 * q4);
#pragma unroll
        for (int e = 0; e < 4; ++e) y[4 * q4 + e] = DN_ALPHA * a[e] + out[4 * q4 + e]; }
    float s = 0.f;
#pragma unroll
    for (int e = 0; e < 16; ++e) s += y[e];
    const float mean = wave_sum(s) * (1.0f / 1024.0f);
    float s2 = 0.f;
#pragma unroll
    for (int e = 0; e < 16; ++e) { y[e] -= mean; s2 += y[e] * y[e]; }
    const float rstd = 1.0f / sqrtf(wave_sum(s2) * (1.0f / 1024.0f) + LN_EPS);
    const float* g = (const float*)P.in[22] + l * 1024 + 16 * lane; const float* bb = (const float*)P.in[23] + l * 1024 + 16 * lane;
    float o[16];
#pragma unroll
    for (int q4 = 0; q4 < 4; ++q4) { const f32x4 ga = *(const f32x4*)(g + 4 * q4), ba = *(const f32x4*)(bb + 4 * q4);
#pragma unroll
        for (int e = 0; e < 4; ++e) o[4 * q4 + e] = y[4 * q4 + e] * rstd * ga[e] + ba[e]; }
    float* of = last_layer ? (P.out + m * DM + 16 * lane) : hf;
#pragma unroll
    for (int q4 = 0; q4 < 4; ++q4) *(f32x4*)(of + 4 * q4) = (f32x4){o[4 * q4], o[4 * q4 + 1], o[4 * q4 + 2], o[4 * q4 + 3]};
    if (!last_layer) { bf16* ob = (bf16*)(F.ws + OFF_HB) + m * DM + 16 * lane; *(u32x4*)ob = pack8(o); *(u32x4*)(ob + 8) = pack8(o + 8); }
}

#ifndef STOP_AFTER
#define STOP_AFTER 99
#endif
constexpr int PTR_OFF = LDS_BYTES - 512;
__device__ __forceinline__ Frame make_frame(unsigned char* ws_) {
    extern __shared__ __attribute__((aligned(16))) unsigned char lds_raw[];
    Frame F; F.lds = (LAS unsigned char*)lds_raw; { int t_ = threadIdx.x; asm volatile("" : "+v"(t_)); F.tid = t_; } F.lane = F.tid & 63; F.wave = __builtin_amdgcn_readfirstlane(F.tid >> 6);
    { int g_ = gridDim.x, b_ = blockIdx.x; asm volatile("" : "+s"(g_), "+s"(b_)); F.G = g_; F.bid = b_; }
    F.ws = ws_;
    return F;
}
__device__ __forceinline__ int dequeue(const Frame& F, unsigned* ctr) {
    LAS int* slot = (LAS int*)(F.lds + LDS_BYTES - 64);
    __syncthreads();
    if (F.tid == 0) slot[0] = (int)atomicAdd(ctr, 1u);
    __syncthreads();
    const int v = slot[0];
    return v;
}
__device__ __noinline__ void grid_sync_fn() { cg::this_grid().sync(); }
__device__ __noinline__ void bar_fn(unsigned char* ws_) {
    extern __shared__ __attribute__((aligned(16))) unsigned char lds_raw[];
    XcdBarrier b; b.bar = (unsigned*)(ws_ + OFF_CTL) + CW_BAR; b.x = xb_xcc_id(); b.st = (volatile LAS unsigned*)((LAS unsigned char*)lds_raw + XB_LDS_OFF);
    xcd_barrier(b);
}
typedef pg8::StaticOrder SO;
#ifndef PHASE_FN
#define PHASE_FN __device__ __forceinline__
#endif
__device__ __forceinline__ Params fresh_params() {
    const unsigned long long* ka = (const unsigned long long*)__builtin_amdgcn_kernarg_segment_ptr(); asm volatile("" : "+s"(ka));
    Params P;
#pragma unroll
    for (int i = 0; i < 24; ++i) P.in[i] = (const void*)ka[i];
    P.out = (float*)ka[24]; P.ws = (unsigned char*)ka[25]; P.pad0 = 0; P.pad1 = 0; return P;
}
__device__ __forceinline__ Frame relaunder(const Frame& F0) {
    Frame F = F0; int t_ = F0.tid; asm volatile("" : "+v"(t_)); F.tid = t_; F.lane = t_ & 63; return F;
}
#define PHASE_PROLOG() const Params P = fresh_params(); const Frame F = make_frame(P.ws); unsigned char* ws = F.ws; (void)ws;
#define WL(l) (ws + OFF_W + (size_t)(l) * W_LAYER)

PHASE_FN void ph_p0() { PHASE_PROLOG(); p0_prologue(F, P); }
PHASE_FN void ph_p1(int l) { PHASE_PROLOG();
    pg8::Gemm g{(const pg8::bf16_t*)(ws + OFF_HB), (const pg8::bf16_t*)(WL(l) + WO_IN), MROWS, 5120, 1024, 1024, 1024};
    SO S; S.init(MROWS, 5120, F.G, F.bid);
    epi::Proj E{(bf16*)(ws + OFF_PROJ1), (bf16*)(ws + OFF_PROJ2)};
    pg8::gemm_phase<epi::Proj, SO, true, true>(F.lds, g, S, E);
}
PHASE_FN void ph_p2a() { PHASE_PROLOG(); if (F.bid < 64) p2_moba_block(F, F.bid);
    const int gw = ((F.bid + F.G - 64) % F.G) * NWAVES + F.wave, NGW = F.G * NWAVES;
    for (int m = gw; m < MROWS; m += NGW) { const Frame Fi = relaunder(F); p2_row(Fi, m); } }
PHASE_FN void ph_p2b(int l) { PHASE_PROLOG();
    const int gw = ((F.bid + F.G - 64) % F.G) * NWAVES + F.wave, NGW = F.G * NWAVES;
    LAS float* Asm = (LAS float*)(F.lds + F.wave * 17408);
    for (int ch = gw; ch < 2048; ch += NGW) { const Frame Fi = relaunder(F); gdn_chunk_wave(Fi, P, l, ch, Asm); } }
PHASE_FN void ph_p3(int l, int which) { PHASE_PROLOG();
    if (which == 0) {
        pg8::Gemm g{(const pg8::bf16_t*)(ws + OFF_PROJ1), (const pg8::bf16_t*)(WL(l) + WO_UQ), MROWS, 768, 768, P1LD, 768};
        SO S; S.init(MROWS, 768, F.G, F.bid);
        epi::Store E{(bf16*)(ws + OFF_QMLA), 768, (const float*)(ws + OFF_RSTD), 0};
        pg8::gemm_phase<epi::Store, SO, true, true>(F.lds, g, S, E);
    } else {
        pg8::Gemm g{(const pg8::bf16_t*)(ws + OFF_PROJ1) + 768, (const pg8::bf16_t*)(WL(l) + WO_UKV), MROWS, 1024, 256, P1LD, 256};
        SO S; S.init(MROWS, 1024, F.G, (F.bid + 64) % F.G);
        epi::Store E{(bf16*)(ws + OFF_KVMLA), 1024, (const float*)(ws + OFF_RSTD), 1};
        pg8::gemm_phase<epi::Store, SO, true, true>(F.lds, g, S, E);
    }
}
PHASE_FN void ph_gdn(int l, int i) { PHASE_PROLOG(); gdn_scan_unit(F, P, l, i >> 3, i & 7); }
PHASE_FN void ph_mla(int bh, int qb) { PHASE_PROLOG(); attn_unit<96, false>(F, bh >> 3, bh & 7, qb); }
PHASE_FN void ph_moba(int bh, int qb) { PHASE_PROLOG(); attn_unit<64, true>(F, bh >> 3, bh & 7, qb); }
PHASE_FN void ph_brzero(int which) { PHASE_PROLOG();
    const int gt = F.bid * NTHREADS + F.tid, NGT = F.G * NTHREADS; bf16* BR = (bf16*)(ws + OFF_BR);
    for (int i = gt; i < MROWS * 64; i += NGT) { const int m = i >> 6, c8 = i & 63; *(u32x4*)(BR + (size_t)m * BRLD + which * 512 + 8 * c8) = (u32x4){0u, 0u, 0u, 0u}; } }
PHASE_FN void ph_p5a(int l) { PHASE_PROLOG();
    pg8::Gemm g{(const pg8::bf16_t*)(ws + OFF_HB), (const pg8::bf16_t*)(WL(l) + WO_G), MROWS, 3072, 1024, 1024, 1024};
    SO S; S.init(MROWS, 3072, F.G, F.bid);
    epi::Store E{(bf16*)(ws + OFF_GLG), 3072, nullptr, 0};
    pg8::gemm_phase<epi::Store, SO, true, true>(F.lds, g, S, E);
}
PHASE_FN void ph_p5b(int l) { PHASE_PROLOG();
    pg8::Gemm g{(const pg8::bf16_t*)(ws + OFF_BR), (const pg8::bf16_t*)(WL(l) + WO_BR), MROWS, 3072, 512, BRLD, 512};
    epi::MergeOrder S; S.init(F.G, F.bid);
    epi::Merge E{(bf16*)(ws + OFF_MERGED), (const bf16*)(ws + OFF_GLG), (const float*)P.in[13] + (size_t)l * 3072};
    pg8::gemm_phase<epi::Merge, epi::MergeOrder, true, true>(F.lds, g, S, E);
}
PHASE_FN void ph_p6(int l) { PHASE_PROLOG();
    pg8::Gemm g{(const pg8::bf16_t*)(ws + OFF_MERGED), (const pg8::bf16_t*)(WL(l) + WO_OUT), MROWS, 1024, 1024, 1024, 1024};
    SO S; S.init(MROWS, 1024, F.G, F.bid);
    epi::OutRes E{(float*)(ws + OFF_Y), (const float*)(ws + OFF_HF)};
    pg8::gemm_phase<epi::OutRes, SO, true, true>(F.lds, g, S, E);
}
PHASE_FN void ph_ln1(int l, int from_y) { PHASE_PROLOG();
    const int gw = F.bid * NWAVES + F.wave, NGW = F.G * NWAVES;
    for (int m = gw; m < MROWS; m += NGW)
        ln_row((const float*)(ws + (from_y ? OFF_Y : OFF_HF)) + (size_t)m * DM, (const float*)P.in[16] + l * 1024, (const float*)P.in[17] + l * 1024,
               (float*)(ws + OFF_HF) + (size_t)m * DM, (bf16*)(ws + OFF_HB) + (size_t)m * DM, F.lane, from_y ? 1.0f : DN_ALPHA);
}
PHASE_FN void ph_p7(int l) { PHASE_PROLOG();
    pg8::Gemm g{(const pg8::bf16_t*)(ws + OFF_HB), (const pg8::bf16_t*)(WL(l) + WO_PQ), MROWS, 2048, 1024, 1024, 1024};
    SO S; S.init(MROWS, 2048, F.G, F.bid);
    epi::Store E{(bf16*)(ws + OFF_QRY), 2048, nullptr, 0};
    pg8::gemm_phase<epi::Store, SO, true, true>(F.lds, g, S, E);
    peer_tables(F, P, l);
}
PHASE_FN void ph_p8(int l) { PHASE_PROLOG(); for (int u = F.bid; u < MROWS / 32; u += F.G) { const Frame Fi = relaunder(F); peer_topk_unit(Fi, l, u); } }
PHASE_FN void ph_p9(int l, int en_peer) { PHASE_PROLOG();
    const int gw = F.bid * NWAVES + F.wave, NGW = F.G * NWAVES;
    for (int m = gw; m < MROWS; m += NGW) { const Frame Fi = relaunder(F); peer_token(Fi, P, l, (size_t)m, l == NLAYER - 1, en_peer != 0); }
}

#ifndef EN_MIXER
#define EN_MIXER 1
#endif
#ifndef EN_MLA
#define EN_MLA 1
#endif
#ifndef EN_MOBA
#define EN_MOBA 1
#endif
#ifndef EN_GDN
#define EN_GDN 1
#endif
#ifndef EN_PEER
#define EN_PEER 1
#endif

#define GRID_BAR() bar_fn(fresh_params().ws)
template <int l> __device__ __forceinline__ void layer_body() {
    extern __shared__ __attribute__((aligned(16))) unsigned char lds_raw[];

        if (EN_MIXER) {
            ph_p1(l);
            GRID_BAR();
            ph_p2a(); ph_p2b(l);
            GRID_BAR();
            ph_p3(l, 0); ph_p3(l, 1);
            GRID_BAR();
            {
                unsigned* ctr = (unsigned*)(fresh_params().ws + OFF_CTL) + 64 * (1 + l);
                const int tid = threadIdx.x;
                LAS int* slot = (LAS int*)((LAS unsigned char*)lds_raw + LDS_BYTES - 64);
                for (;;) {
                    __syncthreads();
                    if (tid == 0) slot[0] = (int)atomicAdd(ctr, 1u);
                    __syncthreads();
                    const int i = __builtin_amdgcn_readfirstlane(slot[0]);
                    if (i >= 64 + 1024) break;
                    if (i < 64) { if (EN_GDN) ph_gdn(l, i); }
                    else { const int j = i - 64, qb = 7 - (j >> 7), typ = (j >> 6) & 1, bh = j & 63;
                        if (typ == 0) { if (EN_MLA) ph_mla(bh, qb); } else { if (EN_MOBA) ph_moba(bh, qb); } }
                }
                if (!EN_MLA) ph_brzero(0);
                if (!EN_MOBA) ph_brzero(1);
                if (!EN_GDN) ph_brzero(2);
            }
            GRID_BAR();
            ph_p5a(l);
            GRID_BAR();
            ph_p5b(l);
            GRID_BAR();
            ph_p6(l);
            GRID_BAR();
        }
        ph_ln1(l, EN_MIXER);
        GRID_BAR();
        if (EN_PEER) {
            ph_p7(l);
            GRID_BAR();
            ph_p8(l);
            GRID_BAR();
        }
        ph_p9(l, EN_PEER);
        if (l + 1 < NLAYER) GRID_BAR();
}
__global__ void __launch_bounds__(NTHREADS, 2) fwd_mega(Params Pk) {
    {
        extern __shared__ __attribute__((aligned(16))) unsigned char lds_raw[];
        volatile LAS unsigned* st = (volatile LAS unsigned*)((LAS unsigned char*)lds_raw + XB_LDS_OFF);
        if (threadIdx.x == 0) { st[0] = 0u; st[1] = 0u; }
        __syncthreads();
        (void)xcd_barrier_post((unsigned*)(Pk.ws + OFF_CTL) + CW_BAR, st);
    }
    ph_p0();
    grid_sync_fn();
    layer_body<0>();
    layer_body<1>();
}

extern "C" void kernel_launch(void* const* d_in, const int* in_sizes, int n_in, void* d_out, int out_size, void* d_ws, size_t ws_size, hipStream_t stream) {
    static int grid = 0;
    if (grid == 0) {
        if (n_in != 24 || out_size != MROWS * DM || ws_size < WS_END) { fprintf(stderr, "kernel_launch: unexpected shapes (n_in %d out %d ws %zu need %zu)\n", n_in, out_size, ws_size, (size_t)WS_END); grid = -1; return; }
        int dev = 0, cus = 0, per_cu = 0;
        if (hipGetDevice(&dev) != hipSuccess || hipDeviceGetAttribute(&cus, hipDeviceAttributeMultiprocessorCount, dev) != hipSuccess) { grid = -1; return; }
        if (hipFuncSetAttribute((const void*)fwd_mega, hipFuncAttributeMaxDynamicSharedMemorySize, LDS_BYTES) != hipSuccess) { fprintf(stderr, "kernel_launch: hipFuncSetAttribute failed\n"); grid = -1; return; }
        if (hipOccupancyMaxActiveBlocksPerMultiprocessor(&per_cu, (const void*)fwd_mega, NTHREADS, LDS_BYTES) != hipSuccess || per_cu < 1) { fprintf(stderr, "kernel_launch: occupancy query says %d\n", per_cu); per_cu = 1; }
        (void)hipGetLastError();
        grid = cus;
    }
    if (grid < 0) return;
    if (hipMemsetAsync((char*)d_ws + OFF_CTL, 0, CTL_BYTES, stream) != hipSuccess) { fprintf(stderr, "kernel_launch: memset failed\n"); return; }
    Params p{};
    for (int i = 0; i < 24; ++i) p.in[i] = d_in[i];
    p.out = (float*)d_out; p.ws = (unsigned char*)d_ws; p.pad0 = 0; p.pad1 = 0;
    void* args[] = {&p};
    hipError_t e = hipLaunchCooperativeKernel((void*)fwd_mega, dim3(grid), dim3(NTHREADS), args, LDS_BYTES, stream);
    if (e != hipSuccess) fprintf(stderr, "cooperative launch failed: %s (grid %d)\n", hipGetErrorString(e), grid);
}
```

```cpp
#include <hip/hip_runtime.h>
#include <hip/hip_cooperative_groups.h>
#include <cstdio>
#include <cstdint>
namespace cg = cooperative_groups;

namespace pg8 {
#define PG8_LAS __attribute__((address_space(3)))
typedef unsigned short bf16_t;
typedef short bf16x8 __attribute__((ext_vector_type(8)));
typedef float f32x4 __attribute__((ext_vector_type(4)));
typedef unsigned u32x4 __attribute__((ext_vector_type(4)));
constexpr int BM = 256, BK = 64, HALF = 128, HTB = HALF * BK * 2  , STAGE_BYTES = 8 * HTB, NXCD = 8, WGM = 8;

__host__ __device__ __forceinline__ int lds_byte(int r, int c) { const int st = (r >> 4) * 2 + (c >> 5), rr = r & 15, cc = c & 31, ob = rr * 64 + cc * 2; return st * 1024 + (ob ^ (((ob >> 9) & 1) << 5)); }
__host__ __device__ __forceinline__ void stage_rc(int b, int& R, int& C) { const int st = b / 1024, sb = b % 1024, swz = sb ^ (((sb >> 9) & 1) << 5); R = (st >> 1) * 16 + swz / 64; C = (st & 1) * 32 + (swz % 64) / 2; }
__host__ __device__ __forceinline__ int perm32(int rho) { const int n = rho >> 4, i = rho & 15; return 8 * (i >> 2) + 4 * n + (i & 3); }

struct Unit { int pm, pn, za, tag; };
struct Gemm { const bf16_t* A; const bf16_t* Bt; int M, N, K, lda, ldb; };

struct StaticOrder {
    int nM, nN, nwg, G, c;
    __host__ __device__ void init(int M, int N, int G_, int c_) { nM = M / BM; nN = N / BM; nwg = nM * nN; G = G_; c = c_; }
    __host__ __device__ bool next(int i, Unit& u) const {
        const long L = (long)i * G + c; if (L >= nwg) return false;
        int wgid = (int)L; { const int q = nwg / NXCD, r = nwg % NXCD, xcd = wgid % NXCD, off = wgid / NXCD; wgid = (xcd < r ? xcd * (q + 1) : r * (q + 1) + (xcd - r) * q) + off; }
        const int nig = WGM * nN, gid = wgid / nig, fm = gid * WGM, gsz = (nM - fm) < WGM ? (nM - fm) : WGM;
        u.pm = fm + ((wgid % nig) % gsz); u.pn = (wgid % nig) / gsz; u.za = 0; u.tag = 0; return true;
    }
    __device__ __forceinline__ void a_ready(const Unit&) const {}
    __device__ __forceinline__ void done(const Unit&) const {}
};

__device__ __forceinline__ unsigned cvt_pk_bf16(float lo, float hi) { unsigned r; asm volatile("v_cvt_pk_bf16_f32 %0, %1, %2" : "=v"(r) : "v"(lo), "v"(hi)); return r; }
typedef float f32x2 __attribute__((ext_vector_type(2)));
__device__ __forceinline__ f32x2 gelu_pk(f32x2 v) {
    const f32x2 av = __builtin_elementwise_abs(v), d = av * 0.2316418882f + 1.0f;
    f32x2 t; t.x = __builtin_amdgcn_rcpf(d.x); t.y = __builtin_amdgcn_rcpf(d.y);
    f32x2 q = t * 0.5307027145f + (-0.7265760135f); q = q * t + 0.7107068705f; q = q * t + (-0.142248368f); q = q * t + 0.127414796f; q = q * t;
    const f32x2 s = (v * v) * (-0.72134752044f);
    f32x2 e; e.x = __builtin_amdgcn_exp2f(s.x); e.y = __builtin_amdgcn_exp2f(s.y);
    const f32x2 m = v * (q * e), r = v - m;
    f32x2 o; o.x = v.x < 0.f ? m.x : r.x; o.y = v.y < 0.f ? m.y : r.y; return o;
}

template <int ACT  > struct EpiBf16 {
    static constexpr bool PERM = true, AFTER_DRAIN = false; static_assert(ACT == 0 || ACT == 1, "EpiBf16: ACT is 0 (none) or 1 (gelu_pk)");
    bf16_t* O; int ldc; const float* bias; int split_cols; size_t split_stride; float scale0;
    __device__ __forceinline__ void operator()(const f32x4 (&acc)[2][2][4][2], const Unit& u, int wr, int wc, int fr, int fq) const {
        const int row0 = u.pm * BM + wr * 64 + fr; int colt = u.pn * BM; bf16_t* base = O;
        float sc = 1.f; if (split_cols) { const int t = colt / split_cols; base += (size_t)t * split_stride; colt -= t * split_cols; if (t == 0) sc = scale0; }
        const int col0 = colt + wc * 32 + 8 * fq, bcol0 = u.pn * BM + wc * 32 + 8 * fq;
        f32x4 bv[2][2];
#pragma unroll
        for (int bj = 0; bj < 2; ++bj)
#pragma unroll
            for (int n = 0; n < 2; ++n) bv[bj][n] = bias ? *(const f32x4*)(bias + bcol0 + bj * HALF + 4 * n) : (f32x4){0.f, 0.f, 0.f, 0.f};
#pragma unroll
        for (int ai = 0; ai < 2; ++ai)
#pragma unroll
            for (int m = 0; m < 4; ++m) { bf16_t* rowp = base + (size_t)(row0 + ai * HALF + m * 16) * ldc + col0;
#pragma unroll
                for (int bj = 0; bj < 2; ++bj) { f32x4 v0 = acc[ai][bj][m][0] + bv[bj][0], v1 = acc[ai][bj][m][1] + bv[bj][1];
                    if (ACT == 1) { f32x2 a = gelu_pk((f32x2){v0[0], v0[1]}), b = gelu_pk((f32x2){v0[2], v0[3]}), c = gelu_pk((f32x2){v1[0], v1[1]}), d = gelu_pk((f32x2){v1[2], v1[3]});
                        v0 = (f32x4){a.x, a.y, b.x, b.y}; v1 = (f32x4){c.x, c.y, d.x, d.y}; }
                    v0 = v0 * sc; v1 = v1 * sc; u32x4 w; w.x = cvt_pk_bf16(v0[0], v0[1]); w.y = cvt_pk_bf16(v0[2], v0[3]); w.z = cvt_pk_bf16(v1[0], v1[1]); w.w = cvt_pk_bf16(v1[2], v1[3]);
                    *(u32x4*)(rowp + bj * HALF) = w; } }
    }
};

struct PanelStats {
    unsigned* xbuf;
    unsigned* cnt;
    unsigned* tmo;
    int ntn; float eps;
    unsigned code;
    __device__ __forceinline__ bool run(const f32x4 (&v)[2][2][4][2], const Unit& u, int wr, int wc, int fr, int fq, PG8_LAS unsigned char* lds, int wid, int lane) const {
        typedef float f32x2v __attribute__((ext_vector_type(2)));
        PG8_LAS f32x2v* P = (PG8_LAS f32x2v*)lds;
        PG8_LAS f32x2v* S = (PG8_LAS f32x2v*)(lds + 8192);
        PG8_LAS unsigned* flag = (PG8_LAS unsigned*)(lds + 8192 + 2048);
#pragma unroll
        for (int ai = 0; ai < 2; ++ai)
#pragma unroll
            for (int m = 0; m < 4; ++m) {
                float s = 0.f;
#pragma unroll
                for (int bj = 0; bj < 2; ++bj)
#pragma unroll
                    for (int n = 0; n < 2; ++n) { const f32x4 x = v[ai][bj][m][n]; s += (x[0] + x[1]) + (x[2] + x[3]); }
                s += __shfl_xor(s, 16); s += __shfl_xor(s, 32);
                const float mw = s * (1.0f / 64.0f); float q = 0.f;
#pragma unroll
                for (int bj = 0; bj < 2; ++bj)
#pragma unroll
                    for (int n = 0; n < 2; ++n) { const f32x4 d = v[ai][bj][m][n] - mw; q += (d[0] * d[0] + d[1] * d[1]) + (d[2] * d[2] + d[3] * d[3]); }
                q += __shfl_xor(q, 16); q += __shfl_xor(q, 32);
                if (fq == 0) P[(ai * HALF + wr * 64 + m * 16 + fr) * 4 + wc] = (f32x2v){mw, q};
            }
        asm volatile("s_waitcnt lgkmcnt(0)" ::: "memory"); __builtin_amdgcn_s_barrier(); asm volatile("" ::: "memory");
#if defined(BROKEN_EXCHANGE_NO_WAIT)
#warning BROKEN CONTROL BUILD: the row-statistics exchange does not wait; results are wrong by design
        if (blockIdx.x >= 64) { const long long t0_ = clock64(); while (clock64() - t0_ < 60000) __builtin_amdgcn_s_sleep(8); }
#endif
        const int row = wid * 32 + (lane & 31);
        if (lane < 32) {
            const f32x2v a = P[row * 4 + 0], b = P[row * 4 + 1], c = P[row * 4 + 2], d = P[row * 4 + 3];
            const float mt = (a.x + b.x + c.x + d.x) * 0.25f;
            const float da = a.x - mt, db = b.x - mt, dc = c.x - mt, dd = d.x - mt;
            const float m2 = (a.y + b.y) + (c.y + d.y) + 64.0f * ((da * da + db * db) + (dc * dc + dd * dd));
            unsigned long long* slot = (unsigned long long*)xbuf + ((size_t)(u.pm * BM + row) * 4 + u.pn);
            __hip_atomic_store(slot, ((unsigned long long)__float_as_uint(m2) << 32) | __float_as_uint(mt), __ATOMIC_RELAXED, __HIP_MEMORY_SCOPE_AGENT);
        }
        asm volatile("s_waitcnt vmcnt(0)" ::: "memory");
        if (lane == 0) __hip_atomic_fetch_add(cnt + 64 * u.pm, 1u, __ATOMIC_RELAXED, __HIP_MEMORY_SCOPE_AGENT);
        if (wid == 0) {
            bool dead = false; const unsigned long long t0 = __builtin_amdgcn_s_memrealtime(); const unsigned want = 8u * (unsigned)ntn;
            for (;;) {
#if defined(BROKEN_EXCHANGE_NO_WAIT)
                break;
#endif
                if ((unsigned)__builtin_amdgcn_readfirstlane(__hip_atomic_load(cnt + 64 * u.pm, __ATOMIC_RELAXED, __HIP_MEMORY_SCOPE_AGENT)) >= want) break;
                if (__builtin_amdgcn_s_memrealtime() - t0 > 2000000ull) {
                    if (lane == 0) { unsigned expect = 0u; __hip_atomic_compare_exchange_strong(tmo + 1, &expect, code | (unsigned)(u.pm & 0xff), __ATOMIC_RELAXED, __ATOMIC_RELAXED, __HIP_MEMORY_SCOPE_AGENT);
                                     __hip_atomic_store(tmo, 1u, __ATOMIC_RELAXED, __HIP_MEMORY_SCOPE_AGENT); }
                    dead = true; break; }
                __builtin_amdgcn_s_sleep(2);
            }
            __builtin_amdgcn_fence(__ATOMIC_ACQUIRE, "agent");
            if (lane == 0) flag[0] = dead ? 1u : 0u;
        }
        asm volatile("s_waitcnt vmcnt(0) lgkmcnt(0)" ::: "memory"); __builtin_amdgcn_s_barrier(); asm volatile("" ::: "memory");
        const bool bad = flag[0] != 0u;
        if (lane < 32) {
            const unsigned long long* slot = (const unsigned long long*)xbuf + (size_t)(u.pm * BM + row) * 4; float mt[4], m2[4]; float ms = 0.f;
#pragma unroll
            for (int t = 0; t < 4; ++t) { if (t < ntn) { const unsigned long long w = __hip_atomic_load(slot + t, __ATOMIC_RELAXED, __HIP_MEMORY_SCOPE_AGENT); mt[t] = __uint_as_float((unsigned)w); m2[t] = __uint_as_float((unsigned)(w >> 32)); } else { mt[t] = 0.f; m2[t] = 0.f; } ms += mt[t]; }
            const float mean = ms / (float)ntn; float q = 0.f;
#pragma unroll
            for (int t = 0; t < 4; ++t) if (t < ntn) { const float dm = mt[t] - mean; q += m2[t] + 256.0f * dm * dm; }
            S[row] = (f32x2v){mean, 1.0f / sqrtf(q / (256.0f * (float)ntn) + eps)};
        }
        asm volatile("s_waitcnt lgkmcnt(0)" ::: "memory"); __builtin_amdgcn_s_barrier(); asm volatile("" ::: "memory");
        return bad;
    }
};
struct EpiLnRes {
    static constexpr bool PERM = false, AFTER_DRAIN = true;
    const float* base; float* out; int ldc; const float* bias; PanelStats st; unsigned poison;
    __device__ __forceinline__ void fused(f32x4 (&acc)[2][2][4][2], const Unit& u, int wr, int wc, int fr, int fq, PG8_LAS unsigned char* lds, int wid, int lane) const {
        typedef float f32x2v __attribute__((ext_vector_type(2)));
        const PG8_LAS f32x2v* S = (const PG8_LAS f32x2v*)(lds + 8192);
        const int col0 = u.pn * BM + wc * 32 + 4 * fq;
#pragma unroll
        for (int bj = 0; bj < 2; ++bj)
#pragma unroll
            for (int n = 0; n < 2; ++n) { const f32x4 bv = bias ? *(const f32x4*)(bias + col0 + bj * HALF + n * 16) : (f32x4){0.f, 0.f, 0.f, 0.f};
#pragma unroll
                for (int ai = 0; ai < 2; ++ai)
#pragma unroll
                    for (int m = 0; m < 4; ++m) acc[ai][bj][m][n] += bv; }
        f32x4 pre[4][2][2];
#pragma unroll
        for (int m = 0; m < 4; ++m) { const size_t off = (size_t)(u.pm * BM + wr * 64 + m * 16 + fr) * ldc + col0;
#pragma unroll
            for (int bj = 0; bj < 2; ++bj)
#pragma unroll
                for (int n = 0; n < 2; ++n) pre[m][bj][n] = *(const f32x4*)(base + off + bj * HALF + n * 16); }
        const bool bad = st.run(acc, u, wr, wc, fr, fq, lds, wid, lane) || poison != 0u;
        const float qnan = __builtin_nanf("");
#pragma unroll
        for (int ai = 0; ai < 2; ++ai)
#pragma unroll
            for (int m = 0; m < 4; ++m) { const int r = ai * HALF + wr * 64 + m * 16 + fr; const f32x2v sr = S[r]; const size_t off = (size_t)(u.pm * BM + r) * ldc + col0;
#pragma unroll
                for (int bj = 0; bj < 2; ++bj)
#pragma unroll
                    for (int n = 0; n < 2; ++n) { const f32x4 bs = ai == 0 ? pre[m][bj][n] : *(const f32x4*)(base + off + bj * HALF + n * 16); f32x4 o = bs + (acc[ai][bj][m][n] - sr.x) * sr.y;
                        if (bad) o = (f32x4){qnan, qnan, qnan, qnan}; *(f32x4*)(out + off + bj * HALF + n * 16) = o; }
                if (m & 1) asm volatile("" ::: "memory"); }
    }
};
struct EpiLnResLn {
    static constexpr bool PERM = false, AFTER_DRAIN = true;
    const float* base; float* out; bf16_t* xn; int ldc; const float* bias; PanelStats st1, st2; unsigned poison;
    __device__ __forceinline__ void fused(f32x4 (&acc)[2][2][4][2], const Unit& u, int wr, int wc, int fr, int fq, PG8_LAS unsigned char* lds, int wid, int lane) const {
        typedef float f32x2v __attribute__((ext_vector_type(2))); typedef unsigned u32x2v __attribute__((ext_vector_type(2)));
        const PG8_LAS f32x2v* S = (const PG8_LAS f32x2v*)(lds + 8192);
        const int col0 = u.pn * BM + wc * 32 + 4 * fq;
#pragma unroll
        for (int bj = 0; bj < 2; ++bj)
#pragma unroll
            for (int n = 0; n < 2; ++n) { const f32x4 bv = bias ? *(const f32x4*)(bias + col0 + bj * HALF + n * 16) : (f32x4){0.f, 0.f, 0.f, 0.f};
#pragma unroll
                for (int ai = 0; ai < 2; ++ai)
#pragma unroll
                    for (int m = 0; m < 4; ++m) acc[ai][bj][m][n] += bv; }
        bool bad = st1.run(acc, u, wr, wc, fr, fq, lds, wid, lane) || poison != 0u;
        const float qnan = __builtin_nanf("");
#pragma unroll
        for (int ai = 0; ai < 2; ++ai)
#pragma unroll
            for (int m = 0; m < 4; ++m) { const int r = ai * HALF + wr * 64 + m * 16 + fr; const f32x2v sr = S[r]; const size_t off = (size_t)(u.pm * BM + r) * ldc + col0;
#pragma unroll
                for (int bj = 0; bj < 2; ++bj)
#pragma unroll
                    for (int n = 0; n < 2; ++n) { const f32x4 bs = *(const f32x4*)(base + off + bj * HALF + n * 16); acc[ai][bj][m][n] = bs + (acc[ai][bj][m][n] - sr.x) * sr.y; }
                asm volatile("" : "+v"(acc[ai][0][m][0]), "+v"(acc[ai][0][m][1]), "+v"(acc[ai][1][m][0]), "+v"(acc[ai][1][m][1]));
                if (m & 1) asm volatile("" ::: "memory"); }
        const bool bad1 = bad;
        bad = st2.run(acc, u, wr, wc, fr, fq, lds, wid, lane) || bad;
#pragma unroll
        for (int ai = 0; ai < 2; ++ai)
#pragma unroll
            for (int m = 0; m < 4; ++m) { const int r = ai * HALF + wr * 64 + m * 16 + fr; const f32x2v sr = S[r]; const size_t off = (size_t)(u.pm * BM + r) * ldc + col0;
#pragma unroll
                for (int bj = 0; bj < 2; ++bj)
#pragma unroll
                    for (int n = 0; n < 2; ++n) { const f32x4 x1 = acc[ai][bj][m][n]; *(f32x4*)(out + off + bj * HALF + n * 16) = bad1 ? (f32x4){qnan, qnan, qnan, qnan} : x1;
                        const f32x4 o = (x1 - sr.x) * sr.y; u32x2v w; w.x = cvt_pk_bf16(o[0], o[1]); w.y = cvt_pk_bf16(o[2], o[3]);
                        if (bad) { w.x = 0x7fc07fc0u; w.y = 0x7fc07fc0u; } *(u32x2v*)(xn + off + bj * HALF + n * 16) = w; }
                asm volatile("" ::: "memory"); }
    }
};

__device__ __forceinline__ const char* sgpr_ptr(const void* p) {
    const unsigned long long v = (unsigned long long)p;
    const unsigned lo = (unsigned)__builtin_amdgcn_readfirstlane((int)(unsigned)v), hi = (unsigned)__builtin_amdgcn_readfirstlane((int)(unsigned)(v >> 32));
    return (const char*)(((unsigned long long)hi << 32) | lo);
}
template <class Epi, class Sched, bool ALIGN_EPI = false, bool SP2 = false>
__device__ __forceinline__ void gemm_phase(PG8_LAS unsigned char* lds, const Gemm g, const Sched& S, const Epi& E, const int tid_in) {
    int tid_ = tid_in; asm volatile("" : "+v"(tid_));
    const int tid = tid_, wid = __builtin_amdgcn_readfirstlane(tid >> 6), lane = tid & 63, wr = wid >> 2, wc = wid & 3, fr = lane & 15, fq = lane >> 4;
    const int K = g.K, nt = K / BK;
    unsigned voffA[2], voffB[2];
#pragma unroll
    for (int i = 0; i < 2; ++i) { int R, C; stage_rc(tid * 16 + i * 8192, R, C); const int Rb = Epi::PERM ? ((R & ~31) + perm32(R & 31)) : R;
        voffA[i] = (unsigned)(R * g.lda + C) * 2u; voffB[i] = (unsigned)(Rb * g.ldb + C) * 2u; }
    const size_t kstep = (size_t)(BK * 2);
    const unsigned hstepA = (unsigned)HALF * g.lda * 2u, hstepB = (unsigned)HALF * g.ldb * 2u;
    const unsigned tstepA = 2u * hstepA, tstepB = 2u * hstepB;
    const unsigned ldsw = (unsigned)wid * 1024u;
    const int aoff = lds_byte(wr * 64 + fr, fq * 8), boff = lds_byte(wc * 32 + fr, fq * 8);
#define PG8_SA(b, h) (((b) * 2 + (h)) * HTB)
#define PG8_SB(b, h) ((4 + (b) * 2 + (h)) * HTB)
#define PG8_STAGE(bufoff, gbase, voff) do { _Pragma("unroll") for (int _i = 0; _i < 2; ++_i) \
        __builtin_amdgcn_global_load_lds((const unsigned*)((const char*)(gbase) + (voff)[_i]), (PG8_LAS unsigned*)(lds + (bufoff) + ldsw + _i * 8192), 16, 0, 0); } while (0)
#define PG8_LDA(dst, b, h) do { _Pragma("unroll") for (int m = 0; m < 4; ++m) _Pragma("unroll") for (int k = 0; k < 2; ++k) dst[m][k] = *(const PG8_LAS bf16x8*)(lds + PG8_SA(b, h) + aoff + m * 2048 + k * 1024); } while (0)
#define PG8_LDB(dst, b, h) do { _Pragma("unroll") for (int n = 0; n < 2; ++n) _Pragma("unroll") for (int k = 0; k < 2; ++k) dst[n][k] = *(const PG8_LAS bf16x8*)(lds + PG8_SB(b, h) + boff + n * 2048 + k * 1024); } while (0)
#define PG8_MMA(ai, bj, At, Bt) do { __builtin_amdgcn_s_setprio(1); _Pragma("unroll") for (int m = 0; m < 4; ++m) _Pragma("unroll") for (int n = 0; n < 2; ++n) _Pragma("unroll") for (int k = 0; k < 2; ++k) \
        acc[ai][bj][m][n] = __builtin_amdgcn_mfma_f32_16x16x32_bf16(Bt[n][k], At[m][k], acc[ai][bj][m][n], 0, 0, 0); __builtin_amdgcn_s_setprio(0); } while (0)
#define PG8_WAIT_V(n) asm volatile("s_waitcnt vmcnt(" #n ")" ::: "memory")
#define PG8_WAIT_L(n) asm volatile("s_waitcnt lgkmcnt(" #n ")" ::: "memory")
#define PG8_BAR __builtin_amdgcn_s_barrier()
#define PG8_SCHED __builtin_amdgcn_sched_barrier(0)
    Unit cur, nxt; int ui = 0;
    if (!S.next(0, cur)) return;
    f32x4 acc[2][2][4][2];
#pragma unroll
    for (int a = 0; a < 2; ++a)
#pragma unroll
        for (int b = 0; b < 2; ++b)
#pragma unroll
            for (int m = 0; m < 4; ++m)
#pragma unroll
                for (int n = 0; n < 2; ++n) acc[a][b][m][n] = (f32x4){0.f, 0.f, 0.f, 0.f};
    bf16x8 At[4][2], B0[2][2], B1[2][2];
    const char* cA = sgpr_ptr((const char*)g.A + ((unsigned)cur.pm * tstepA + (unsigned)cur.za * 2u)); const char* cB = sgpr_ptr((const char*)g.Bt + (unsigned)cur.pn * tstepB);
    S.a_ready(cur);
    if constexpr (SP2) {
        PG8_STAGE(PG8_SB(0, 0), cB, voffB); PG8_STAGE(PG8_SB(0, 1), cB + hstepB, voffB); PG8_STAGE(PG8_SA(0, 0), cA, voffA); PG8_STAGE(PG8_SA(0, 1), cA + hstepA, voffA);
        if (wr == 1) PG8_BAR;
        PG8_WAIT_V(2); PG8_BAR;
        PG8_STAGE(PG8_SB(1, 0), cB + kstep, voffB); PG8_STAGE(PG8_SA(1, 0), cA + kstep, voffA); PG8_STAGE(PG8_SB(1, 1), cB + hstepB + kstep, voffB);
        PG8_WAIT_V(6); PG8_BAR;
    } else {
        PG8_STAGE(PG8_SB(0, 0), cB, voffB); PG8_STAGE(PG8_SA(0, 0), cA, voffA); PG8_STAGE(PG8_SB(0, 1), cB + hstepB, voffB); PG8_STAGE(PG8_SA(0, 1), cA + hstepA, voffA);
        if (wr == 1) PG8_BAR;
        PG8_WAIT_V(4); PG8_BAR;
        PG8_STAGE(PG8_SB(1, 0), cB + kstep, voffB); PG8_STAGE(PG8_SA(1, 0), cA + kstep, voffA); PG8_STAGE(PG8_SB(1, 1), cB + hstepB + kstep, voffB);
        PG8_WAIT_V(6); PG8_BAR;
    }
    for (;;) {
        const bool has_next = S.next(ui + 1, nxt);
        const char* nA = has_next ? sgpr_ptr((const char*)g.A + ((unsigned)nxt.pm * tstepA + (unsigned)nxt.za * 2u)) : cA; const char* nB = has_next ? sgpr_ptr((const char*)g.Bt + (unsigned)nxt.pn * tstepB) : cB;
        for (int t = 0; t < nt; t += 2) {
            const bool last = (t == nt - 2);
            const char* a1 = cA + (size_t)(t + 1) * kstep;
            const char* a2 = last ? nA : cA + (size_t)(t + 2) * kstep; const char* b2 = last ? nB : cB + (size_t)(t + 2) * kstep;
            const char* a3 = a2 + kstep; const char* b3 = b2 + kstep;
            if (last && has_next) S.a_ready(nxt);
            if constexpr (SP2) {
            PG8_LDB(B0, 0, 0); PG8_LDB(B1, 0, 1); PG8_SCHED; PG8_LDA(At, 0, 0); PG8_STAGE(PG8_SA(1, 1), a1 + hstepA, voffA);
            PG8_WAIT_V(8); PG8_WAIT_L(0); PG8_BAR; PG8_MMA(0, 0, At, B0); PG8_MMA(0, 1, At, B1); PG8_BAR; PG8_SCHED;
            PG8_LDA(At, 0, 1); PG8_STAGE(PG8_SB(0, 0), b2, voffB); PG8_STAGE(PG8_SB(0, 1), b2 + hstepB, voffB); PG8_STAGE(PG8_SA(0, 0), a2, voffA);
            PG8_WAIT_V(8); PG8_WAIT_L(0); PG8_BAR; PG8_MMA(1, 0, At, B0); PG8_MMA(1, 1, At, B1); PG8_BAR; PG8_SCHED;
            PG8_LDB(B0, 1, 0); PG8_LDB(B1, 1, 1); PG8_SCHED; PG8_LDA(At, 1, 0); PG8_STAGE(PG8_SA(0, 1), a2 + hstepA, voffA);
            PG8_WAIT_V(8); PG8_WAIT_L(0); PG8_BAR; PG8_MMA(0, 0, At, B0); PG8_MMA(0, 1, At, B1); PG8_BAR; PG8_SCHED;
            PG8_LDA(At, 1, 1); PG8_STAGE(PG8_SB(1, 0), b3, voffB); PG8_STAGE(PG8_SB(1, 1), b3 + hstepB, voffB); PG8_STAGE(PG8_SA(1, 0), a3, voffA);
            PG8_WAIT_V(8); PG8_WAIT_L(0); PG8_BAR; PG8_MMA(1, 0, At, B0); PG8_MMA(1, 1, At, B1); PG8_BAR; PG8_SCHED;
            } else {
            PG8_LDB(B0, 0, 0); PG8_SCHED; PG8_LDA(At, 0, 0); PG8_STAGE(PG8_SA(1, 1), a1 + hstepA, voffA);
            PG8_WAIT_L(8); PG8_BAR; PG8_WAIT_L(0); PG8_MMA(0, 0, At, B0); PG8_BAR; PG8_SCHED;
            PG8_LDB(B1, 0, 1); PG8_STAGE(PG8_SB(0, 0), b2, voffB);
            PG8_BAR; PG8_WAIT_L(0); PG8_MMA(0, 1, At, B1); PG8_BAR;
            PG8_LDA(At, 0, 1); PG8_STAGE(PG8_SA(0, 0), a2, voffA);
            PG8_BAR; PG8_WAIT_L(0); PG8_MMA(1, 0, At, B0); PG8_BAR; PG8_SCHED;
            PG8_STAGE(PG8_SB(0, 1), b2 + hstepB, voffB);
            PG8_WAIT_V(6); PG8_BAR; PG8_MMA(1, 1, At, B1); PG8_BAR;
            PG8_LDB(B0, 1, 0); PG8_SCHED; PG8_LDA(At, 1, 0); PG8_STAGE(PG8_SA(0, 1), a2 + hstepA, voffA);
            PG8_WAIT_L(8); PG8_BAR; PG8_WAIT_L(0); PG8_MMA(0, 0, At, B0); PG8_BAR; PG8_SCHED;
            PG8_LDB(B1, 1, 1); PG8_STAGE(PG8_SB(1, 0), b3, voffB);
            PG8_BAR; PG8_WAIT_L(0); PG8_MMA(0, 1, At, B1); PG8_BAR;
            PG8_LDA(At, 1, 1); PG8_STAGE(PG8_SA(1, 0), a3, voffA);
            PG8_BAR; PG8_WAIT_L(0); PG8_MMA(1, 0, At, B0); PG8_BAR; PG8_SCHED;
            PG8_STAGE(PG8_SB(1, 1), b3 + hstepB, voffB);
            PG8_WAIT_V(6); PG8_BAR; PG8_MMA(1, 1, At, B1); PG8_BAR;
            }
        }
        if constexpr (ALIGN_EPI) { if (wr == 0) PG8_BAR; }
        if constexpr (!Epi::AFTER_DRAIN) { E(acc, cur, wr, wc, fr, fq); S.done(cur); }
        if (!has_next) break;
#pragma unroll
        for (int a = 0; a < 2; ++a)
#pragma unroll
            for (int b = 0; b < 2; ++b)
#pragma unroll
                for (int m = 0; m < 4; ++m)
#pragma unroll
                    for (int n = 0; n < 2; ++n) acc[a][b][m][n] = (f32x4){0.f, 0.f, 0.f, 0.f};
        cur = nxt; cA = nA; cB = nB; ++ui;
        if constexpr (ALIGN_EPI) { if (wr == 1) PG8_BAR; }
    }
    PG8_WAIT_V(0);
    if constexpr (!ALIGN_EPI) { if (wr == 0) PG8_BAR; }
    PG8_BAR;
    if constexpr (Epi::AFTER_DRAIN) { E.fused(acc, cur, wr, wc, fr, fq, lds, wid, lane); S.done(cur); }
#undef PG8_SA
#undef PG8_SB
#undef PG8_STAGE
#undef PG8_LDA
#undef PG8_LDB
#undef PG8_MMA
#undef PG8_WAIT_V
#undef PG8_WAIT_L
#undef PG8_BAR
#undef PG8_SCHED
}
}

constexpr int NB = 8, SEQ = 2048, DM = 1024, MROWS = NB * SEQ;
constexpr int NLAYER = 2;
constexpr int IN_COLS = 7728;
constexpr int P1LD = 1280, P2LD = 3840;
constexpr int C2_MQ = 0, C2_MK = 512, C2_MV = 1024, C2_GQ = 1536, C2_GK = 2048, C2_GV = 2560, C2_GZ = 3072, C2_GA = 3584, C2_GB = 3592;
constexpr int BRLD = 1536;
constexpr float LN_EPS = 1e-5f, RMS_EPS = 1e-6f;
constexpr float DN_ALPHA = 1.4142135623730951f;
constexpr int NWAVES = 8, NTHREADS = 512;

constexpr size_t KiB = 1024, MiB = 1024 * 1024;
constexpr size_t OFF_CTL = 0, CTL_BYTES = 1 * MiB;
constexpr size_t OFF_MISC = 1 * MiB;
constexpr size_t OFF_KMEAN = OFF_MISC;
constexpr size_t OFF_RSTD = OFF_MISC + 128 * KiB;
constexpr size_t OFF_GLS = OFF_MISC + 256 * KiB;
constexpr size_t OFF_TAB = 2 * MiB;
constexpr size_t OFF_COSA = OFF_TAB, OFF_SINA = OFF_TAB + 1 * MiB, OFF_COSB = OFF_TAB + 2 * MiB, OFF_SINB = OFF_TAB + 2 * MiB + 512 * KiB;
constexpr size_t OFF_W = 5 * MiB, W_LAYER = 28 * MiB;
constexpr size_t WO_IN = 0, WO_G = 10 * MiB, WO_UQ = 16 * MiB, WO_UKV = 17 * MiB + 256 * KiB, WO_BR = 17 * MiB + 768 * KiB,
                 WO_OUT = 20 * MiB + 768 * KiB, WO_PQ = 22 * MiB + 768 * KiB, WO_SK = 26 * MiB + 768 * KiB;
constexpr size_t OFF_HF = 61 * MiB, OFF_HB = 125 * MiB, OFF_RA = 157 * MiB, OFF_RB = 205 * MiB, OFF_RC = 325 * MiB, OFF_RD = 383 * MiB, WS_END = 480 * MiB;
constexpr size_t OFF_PROJ1 = OFF_RA, OFF_BR = OFF_RA;
constexpr size_t OFF_PROJ2 = OFF_RB, OFF_Y = OFF_RB, OFF_QRY = OFF_RB;
constexpr size_t OFF_QMLA = OFF_RC, OFF_KVMLA = OFF_RC + 24 * MiB, OFF_KR = OFF_RC + 56 * MiB, OFF_MERGED = OFF_RC, OFF_IDX = OFF_RC, OFF_GATE = OFF_RC + 8 * MiB;
constexpr size_t OFF_GDN = OFF_RD, OFF_GLG = OFF_RD, OFF_PU = OFF_RD, OFF_PV = OFF_RD + 16 * MiB;
constexpr int GDN_MAT = 4096;

#define GAS __attribute__((address_space(1)))
#define LAS __attribute__((address_space(3)))
typedef unsigned short bf16;
typedef short bf16x8 __attribute__((ext_vector_type(8)));
typedef short s16x4 __attribute__((ext_vector_type(4)));
typedef float f32x4 __attribute__((ext_vector_type(4)));
typedef float f32x2 __attribute__((ext_vector_type(2)));
typedef float f32x16 __attribute__((ext_vector_type(16)));
typedef unsigned u32x4 __attribute__((ext_vector_type(4)));
typedef unsigned u32x2 __attribute__((ext_vector_type(2)));

__device__ __forceinline__ unsigned f2bf(float f) { unsigned u = __builtin_bit_cast(unsigned, f); return (u + 0x7fffu + ((u >> 16) & 1u)) >> 16; }
typedef __bf16 hwbf16x2 __attribute__((ext_vector_type(2)));
__device__ __forceinline__ unsigned pk2(float lo, float hi) { const f32x2 v = {lo, hi}; const hwbf16x2 b = __builtin_convertvector(v, hwbf16x2); return __builtin_bit_cast(unsigned, b); }
__device__ __forceinline__ float bflo(unsigned w) { return __builtin_bit_cast(float, w << 16); }
__device__ __forceinline__ float bfhi(unsigned w) { return __builtin_bit_cast(float, w & 0xffff0000u); }
__device__ __forceinline__ float bf1(bf16 h) { return __builtin_bit_cast(float, (unsigned)h << 16); }
template <class T> __device__ __forceinline__ T shfl_idx(T v, int src) { return __builtin_bit_cast(T, __builtin_amdgcn_ds_bpermute(src << 2, __builtin_bit_cast(int, v))); }
template <class T> __device__ __forceinline__ T shfl_xl(T v, int m, int lane) { return shfl_idx(v, lane ^ m); }
template <class T> __device__ __forceinline__ T shfl_upl(T v, int d, int lane) { return shfl_idx(v, lane - d); }
__device__ __forceinline__ float wave_sum(float v, int lane) {
#pragma unroll
    for (int o = 1; o < 64; o <<= 1) v += shfl_xl(v, o, lane);
    return v;
}
__device__ __forceinline__ float sigmoidf_(float x) { return 1.0f / (1.0f + __expf(-x)); }
__device__ __forceinline__ float siluf_(float x) { return x / (1.0f + __expf(-x)); }
__device__ __forceinline__ float softplusf_(float x) { return x > 20.f ? x : log1pf(__expf(x)); }
__device__ __forceinline__ void unpack8(const u32x4 v, float* f) {
    f[0] = bflo(v.x); f[1] = bfhi(v.x); f[2] = bflo(v.y); f[3] = bfhi(v.y); f[4] = bflo(v.z); f[5] = bfhi(v.z); f[6] = bflo(v.w); f[7] = bfhi(v.w);
}
__device__ __forceinline__ u32x4 pack8(const float* f) { u32x4 v; v.x = pk2(f[0], f[1]); v.y = pk2(f[2], f[3]); v.z = pk2(f[4], f[5]); v.w = pk2(f[6], f[7]); return v; }

struct Params { const void* in[24]; float* out; unsigned char* ws; int pad0, pad1; };

constexpr int RING_BYTES = 131072;
constexpr int LDS_BYTES = 147456;

struct Frame {
    LAS unsigned char* lds;
    int tid, lane, wave, G, bid;
    unsigned char* ws;
};

typedef GAS unsigned gu32;
constexpr int CW_BAR = 4096;
constexpr int XB_LDS_OFF = LDS_BYTES - 32;
#define XB_TMO      128
#define XB_XCNT(j)  (256  + 64 * (j))
#define XB_XSUB(j)  (1280 + 64 * (j))
#define XB_XGEN(j)  (2304 + 64 * (j))
#define XB_TOP      3328
#define XB_TOPGEN   3392
#define XCD_BAR_WORDS 3456
#define XB_SPIN_CAP (1u << 22)

__device__ __forceinline__ unsigned xb_ld(unsigned* p)              { return __hip_atomic_load(p, __ATOMIC_RELAXED, __HIP_MEMORY_SCOPE_AGENT); }
__device__ __forceinline__ unsigned xb_add(unsigned* p, unsigned v) { return __hip_atomic_fetch_add(p, v, __ATOMIC_RELAXED, __HIP_MEMORY_SCOPE_AGENT); }
__device__ __forceinline__ unsigned xb_xcc_id() { return (unsigned)__builtin_amdgcn_s_getreg((3 << 11) | 20) & 0xFu; }
#define XB_SPIN(cond, bar) do { unsigned _sp = 0; while (cond) { __builtin_amdgcn_s_sleep(1); \
    if ((++_sp & 255u) == 0u) { if (xb_ld(&(bar)[XB_TMO])) break; if (_sp > XB_SPIN_CAP) { atomicAdd(&(bar)[XB_TMO], 1u); break; } } } } while (0)

struct XcdBarrier {
    unsigned* bar; unsigned x;
    volatile LAS unsigned* st;
};

__device__ __forceinline__ XcdBarrier xcd_barrier_post(unsigned* bar, volatile LAS unsigned* st, const int tid) {
    XcdBarrier b; b.bar = bar; b.x = xb_xcc_id(); b.st = st;
    if (tid == 0) (void)xb_add(&bar[XB_XCNT(b.x)], 1u);
    return b;
}
__device__ __forceinline__ void xcd_barrier_complete(unsigned* bar, unsigned x, unsigned& nloc, unsigned& nx) {
    const unsigned G = gridDim.x * gridDim.y * gridDim.z;
    unsigned sum, cnt, mine, sp = 0u;
    for (;;) {
        sum = 0u; cnt = 0u; mine = 0u;
#pragma unroll
        for (unsigned j = 0; j < 16; ++j) { const unsigned c = xb_ld(&bar[XB_XCNT(j)]); sum += c; cnt += (c > 0u) ? 1u : 0u; mine = (j == x) ? c : mine; }
        if (sum == G) break;
        __builtin_amdgcn_s_sleep(1);
        if ((++sp & 255u) == 0u) { if (xb_ld(&bar[XB_TMO])) break; if (sp > XB_SPIN_CAP) { atomicAdd(&bar[XB_TMO], 1u); break; } }
    }
    nloc = mine > 0u ? mine : 1u; nx = cnt > 0u ? cnt : 1u;
}

__device__ __forceinline__ void xcd_barrier(const XcdBarrier& b, const int tid) {
    asm volatile("s_waitcnt vmcnt(0)" ::: "memory");
    __syncthreads();
    if (tid == 0) {
        unsigned* bar = b.bar;
        __builtin_amdgcn_s_waitcnt(0);
        unsigned nloc = b.st[0], nx = b.st[1];
        if (nloc == 0u) { xcd_barrier_complete(bar, b.x, nloc, nx); b.st[0] = nloc; b.st[1] = nx; }
        const unsigned old = xb_add(&bar[XB_XSUB(b.x)], 1u);
        const unsigned gen = old / nloc;
        if (old + 1u == (gen + 1u) * nloc) {
            __builtin_amdgcn_fence(__ATOMIC_RELEASE, "agent");
            asm volatile("s_waitcnt vmcnt(0)" ::: "memory");
            const unsigned og = xb_add(&bar[XB_TOP], 1u);
            const unsigned tg = og / nx;
            if (og + 1u == (tg + 1u) * nx) xb_add(&bar[XB_TOPGEN], 1u);
            else XB_SPIN(xb_ld(&bar[XB_TOPGEN]) == tg, bar);
            __builtin_amdgcn_fence(__ATOMIC_ACQUIRE, "agent");
            xb_add(&bar[XB_XGEN(b.x)], 1u);
            asm volatile("s_waitcnt vmcnt(0)" ::: "memory");
        } else {
            XB_SPIN(xb_ld(&bar[XB_XGEN(b.x)]) == gen, bar);
            __builtin_amdgcn_fence(__ATOMIC_ACQUIRE, "agent");
            asm volatile("s_waitcnt vmcnt(0)" ::: "memory");
        }
    }
    __syncthreads();
}

#define LDS_WAIT() asm volatile("s_waitcnt lgkmcnt(0)" ::: "memory")
#define VM_WAIT() asm volatile("s_waitcnt vmcnt(0)" ::: "memory")
__device__ __forceinline__ float ld_coh_f32(float* p) { return __hip_atomic_load(p, __ATOMIC_RELAXED, __HIP_MEMORY_SCOPE_AGENT); }

__device__ __forceinline__ void ln_row(const float* xrow, const float* g, const float* bta, float* of32, bf16* obf, int lane, float pre = 1.0f) {
    const f32x4* xr = (const f32x4*)xrow + lane;
    f32x4 v[4]; float s = 0.f;
#pragma unroll
    for (int j = 0; j < 4; ++j) { v[j] = xr[64 * j] * pre; s += (v[j].x + v[j].y) + (v[j].z + v[j].w); }
    const float mean = wave_sum(s, lane) * (1.f / 1024.f); float s2 = 0.f;
#pragma unroll
    for (int j = 0; j < 4; ++j) { v[j] = v[j] - mean; s2 += (v[j].x * v[j].x + v[j].y * v[j].y) + (v[j].z * v[j].z + v[j].w * v[j].w); }
    const float rstd = 1.f / sqrtf(wave_sum(s2, lane) * (1.f / 1024.f) + LN_EPS);
    const f32x4* gr = (const f32x4*)g + lane; const f32x4* br = (const f32x4*)bta + lane;
    f32x4* o4 = (f32x4*)of32 + lane; u32x2* o8 = (u32x2*)obf + lane;
#pragma unroll
    for (int j = 0; j < 4; ++j) { const f32x4 o = v[j] * rstd * gr[64 * j] + br[64 * j]; if (of32) o4[64 * j] = o; if (obf) { u32x2 w; w.x = pk2(o.x, o.y); w.y = pk2(o.z, o.w); o8[64 * j] = w; } }
}

__device__ __forceinline__ void transpose_item(const float* W, int ldw, int c_off, int n_valid, const float* kscale, bf16* WT, int K, int row0, LAS float* scr, int kb, int nb, int lane) {
    const int k0 = 64 * kb, n0 = 32 * nb;
#pragma unroll 8
    for (int i = 0; i < 32; ++i) { const int kk = 2 * i + (lane >> 5), n = n0 + (lane & 31);
        float v = (n < n_valid) ? W[(size_t)(k0 + kk) * ldw + c_off + n] : 0.f; if (kscale) v *= kscale[k0 + kk];
        scr[kk * 33 + (lane & 31)] = v; }
    LDS_WAIT(); asm volatile("" ::: "memory");
    const int c = lane & 7;
#pragma unroll
    for (int j = 0; j < 4; ++j) { const int n = (lane >> 3) + 8 * j; const LAS float* s = scr + (8 * c) * 33 + n;
        u32x4 o; o.x = pk2(s[0 * 33], s[1 * 33]); o.y = pk2(s[2 * 33], s[3 * 33]); o.z = pk2(s[4 * 33], s[5 * 33]); o.w = pk2(s[6 * 33], s[7 * 33]);
        *(u32x4*)(WT + (size_t)(row0 + n0 + n) * K + k0 + 8 * c) = o; }
    LDS_WAIT(); asm volatile("" ::: "memory");
}

__device__ __forceinline__ void p0_prologue(const Frame& F, const Params& P) {
    LAS float* scr = (LAS float*)(F.lds + F.wave * 16384);
    const int gw = F.bid * NWAVES + F.wave, NGW = F.G * NWAVES;
    constexpr int I_IN1 = 16 * 40, I_IN2 = 16 * 120, I_G = 16 * 96, I_UQ = 12 * 24, I_UKV = 4 * 32, I_BR = 8 * 32, I_OUT = 16 * 32, I_PQ = 16 * 64;
    constexpr int I_LAYER = I_IN1 + I_IN2 + I_G + I_UQ + I_UKV + 3 * I_BR + I_OUT + I_PQ;
    for (int it = gw; it < NLAYER * I_LAYER; it += NGW) {
        const int l = it / I_LAYER; int r = it % I_LAYER;
        unsigned char* wl = F.ws + OFF_W + (size_t)l * W_LAYER;
        const float* w_in = (const float*)P.in[4] + (size_t)l * 1024 * IN_COLS;
        if (r < I_IN1) { transpose_item(w_in, IN_COLS, 0, 1056, nullptr, (bf16*)(wl + WO_IN), 1024, 0, scr, r / 40, r % 40, F.lane); continue; } r -= I_IN1;
        if (r < I_IN2) { transpose_item(w_in, IN_COLS, 1056, 3600, nullptr, (bf16*)(wl + WO_IN), 1024, 1280, scr, r / 120, r % 120, F.lane); continue; } r -= I_IN2;
        if (r < I_G) { transpose_item(w_in, IN_COLS, 4656, 3072, nullptr, (bf16*)(wl + WO_G), 1024, 0, scr, r / 96, r % 96, F.lane); continue; } r -= I_G;
        if (r < I_UQ) { transpose_item((const float*)P.in[7] + (size_t)l * 768 * 768, 768, 0, 768, (const float*)P.in[5] + l * 768, (bf16*)(wl + WO_UQ), 768, 0, scr, r / 24, r % 24, F.lane); continue; } r -= I_UQ;
        if (r < I_UKV) { transpose_item((const float*)P.in[8] + (size_t)l * 256 * 1024, 1024, 0, 1024, (const float*)P.in[6] + l * 256, (bf16*)(wl + WO_UKV), 256, 0, scr, r / 32, r % 32, F.lane); continue; } r -= I_UKV;
        if (r < 3 * I_BR) { const int n = r / I_BR; r %= I_BR;
            transpose_item((const float*)P.in[14] + ((size_t)l * 3 + n) * 512 * 1024, 1024, 0, 1024, nullptr, (bf16*)(wl + WO_BR) + (size_t)n * 1024 * 512, 512, 0, scr, r / 32, r % 32, F.lane); continue; } r -= 3 * I_BR;
        if (r < I_OUT) { transpose_item((const float*)P.in[15] + (size_t)l * 1024 * 1024, 1024, 0, 1024, nullptr, (bf16*)(wl + WO_OUT), 1024, 0, scr, r / 32, r % 32, F.lane); continue; } r -= I_OUT;
        transpose_item((const float*)P.in[18] + (size_t)l * 1024 * 2048, 2048, 0, 2048, nullptr, (bf16*)(wl + WO_PQ), 1024, 0, scr, r / 64, r % 64, F.lane);
    }
    const int gt = F.bid * NTHREADS + F.tid, NGT = F.G * NTHREADS;
    for (int i = gt; i < NLAYER * 65536; i += NGT) {
        const int l = i / 65536, e = (i % 65536) * 4;
        const f32x4 v = *(const f32x4*)((const float*)P.in[19] + (size_t)l * 262144 + e);
        u32x2 w; w.x = pk2(v.x, v.y); w.y = pk2(v.z, v.w);
        *(u32x2*)((bf16*)(F.ws + OFF_W + (size_t)l * W_LAYER + WO_SK) + e) = w;
    }
    {
        float* cosA = (float*)(F.ws + OFF_COSA); float* sinA = (float*)(F.ws + OFF_SINA); float* cosB = (float*)(F.ws + OFF_COSB); float* sinB = (float*)(F.ws + OFF_SINB);
        const int* pos = (const int*)P.in[1];
        for (int i = gt; i < MROWS * 24; i += NGT) {
            const int m = i / 24, j = i % 24; const float p = (float)pos[m];
            if (j < 16) { const float inv = powf(500000.0f, -(float)(2 * j) / 32.0f); const float a = p * inv; cosA[m * 16 + j] = cosf(a); sinA[m * 16 + j] = sinf(a); }
            else { const int jj = j - 16; const float inv = powf(500000.0f, -(float)(2 * jj) / 16.0f); const float a = p * inv; cosB[m * 8 + jj] = cosf(a); sinB[m * 8 + jj] = sinf(a); }
        }
    }
    for (int m = gw; m < MROWS; m += NGW)
        ln_row((const float*)P.in[0] + (size_t)m * DM, (const float*)P.in[2], (const float*)P.in[3], (float*)(F.ws + OFF_HF) + (size_t)m * DM, (bf16*)(F.ws + OFF_HB) + (size_t)m * DM, F.lane);
}

__device__ __forceinline__ void peer_tables(const Frame& F, const Params& P, int l) {
    const int gt = F.bid * NTHREADS + F.tid, NGT = F.G * NTHREADS;
    const float* u = (const float*)P.in[20] + (size_t)l * 16384 * 1024; const float* v = (const float*)P.in[21] + (size_t)l * 16384 * 1024;
    unsigned char* pu = (unsigned char*)(F.ws + OFF_PU); unsigned char* pv = (unsigned char*)(F.ws + OFF_PV);
    for (int i = gt; i < 2 * 1048576; i += NGT) {
        const bool isv = i >= 1048576; const size_t e = (size_t)(isv ? i - 1048576 : i) * 16;
        const float* s = (isv ? v : u) + e; const float sc = isv ? 16.0f : 256.0f;
        unsigned w[4];
#pragma unroll
        for (int q = 0; q < 4; ++q) { const f32x4 a = *(const f32x4*)(s + 4 * q) * sc; int t = 0; t = __builtin_amdgcn_cvt_pk_fp8_f32(a.x, a.y, t, false); t = __builtin_amdgcn_cvt_pk_fp8_f32(a.z, a.w, t, true); w[q] = (unsigned)t; }
        *(u32x4*)((isv ? pv : pu) + e) = (u32x4){w[0], w[1], w[2], w[3]};
    }
}

namespace epi {
using pg8::Unit; using pg8::HALF; using pg8::BM;

struct Proj {
    static constexpr bool PERM = true, AFTER_DRAIN = false;
    bf16* P1; bf16* P2;
    __device__ __forceinline__ void operator()(const f32x4 (&acc)[2][2][4][2], const Unit& u, int wr, int wc, int fr, int fq) const {
        const int row0 = u.pm * BM + wr * 64 + fr;
        bf16* base; int ldc, colt;
        if (u.pn < 5) { base = P1; ldc = P1LD; colt = u.pn * BM; } else { base = P2; ldc = P2LD; colt = (u.pn - 5) * BM; }
        const int col0 = colt + wc * 32 + 8 * fq;
#pragma unroll
        for (int ai = 0; ai < 2; ++ai)
#pragma unroll
            for (int m = 0; m < 4; ++m) { bf16* rowp = base + (size_t)(row0 + ai * HALF + m * 16) * ldc + col0;
#pragma unroll
                for (int bj = 0; bj < 2; ++bj) { const f32x4 v0 = acc[ai][bj][m][0], v1 = acc[ai][bj][m][1];
                    u32x4 w; w.x = pk2(v0[0], v0[1]); w.y = pk2(v0[2], v0[3]); w.z = pk2(v1[0], v1[1]); w.w = pk2(v1[2], v1[3]);
                    *(u32x4*)(rowp + bj * HALF) = w; } }
    }
};
struct Store {
    static constexpr bool PERM = true, AFTER_DRAIN = false;
    bf16* O; int ldc; const float* rs; int rsel;
    __device__ __forceinline__ void operator()(const f32x4 (&acc)[2][2][4][2], const Unit& u, int wr, int wc, int fr, int fq) const {
        const int row0 = u.pm * BM + wr * 64 + fr; const int col0 = u.pn * BM + wc * 32 + 8 * fq;
#pragma unroll
        for (int ai = 0; ai < 2; ++ai)
#pragma unroll
            for (int m = 0; m < 4; ++m) { const int row = row0 + ai * HALF + m * 16; bf16* rowp = O + (size_t)row * ldc + col0;
                const float sc = rs ? rs[(size_t)row * 2 + rsel] : 1.0f;
#pragma unroll
                for (int bj = 0; bj < 2; ++bj) { const f32x4 v0 = acc[ai][bj][m][0] * sc, v1 = acc[ai][bj][m][1] * sc;
                    u32x4 w; w.x = pk2(v0[0], v0[1]); w.y = pk2(v0[2], v0[3]); w.z = pk2(v1[0], v1[1]); w.w = pk2(v1[2], v1[3]);
                    *(u32x4*)(rowp + bj * HALF) = w; } }
    }
};
struct Merge {
    static constexpr bool PERM = true, AFTER_DRAIN = false;
    bf16* MG; const bf16* GLG; const float* gbias;
    __device__ __forceinline__ void operator()(const f32x4 (&acc)[2][2][4][2], const Unit& u, int wr, int wc, int fr, int fq) const {
        const int n = u.tag; const int row0 = u.pm * BM + wr * 64 + fr; const int col0 = (u.pn & 3) * BM + wc * 32 + 8 * fq;
        if (n > 0) asm volatile("s_waitcnt vmcnt(0)" ::: "memory");
#pragma unroll
        for (int ai = 0; ai < 2; ++ai)
#pragma unroll
            for (int m = 0; m < 4; ++m) { const int row = row0 + ai * HALF + m * 16;
#pragma unroll
                for (int bj = 0; bj < 2; ++bj) { const int col = col0 + bj * HALF;
                    const u32x4 gl = *(const u32x4*)(GLG + (size_t)row * 3072 + n * 1024 + col);
                    const f32x4 b0 = *(const f32x4*)(gbias + n * 1024 + col), b1 = *(const f32x4*)(gbias + n * 1024 + col + 4);
                    float g[8]; unpack8(gl, g);
                    float v[8];
                    const f32x4 a0 = acc[ai][bj][m][0], a1 = acc[ai][bj][m][1];
                    v[0] = a0[0] * sigmoidf_(g[0] + b0[0]); v[1] = a0[1] * sigmoidf_(g[1] + b0[1]); v[2] = a0[2] * sigmoidf_(g[2] + b0[2]); v[3] = a0[3] * sigmoidf_(g[3] + b0[3]);
                    v[4] = a1[0] * sigmoidf_(g[4] + b1[0]); v[5] = a1[1] * sigmoidf_(g[5] + b1[1]); v[6] = a1[2] * sigmoidf_(g[6] + b1[2]); v[7] = a1[3] * sigmoidf_(g[7] + b1[3]);
                    bf16* mp = MG + (size_t)row * 1024 + col;
                    if (n > 0) {
                        const unsigned long long p0 = __hip_atomic_load((const unsigned long long*)mp, __ATOMIC_RELAXED, __HIP_MEMORY_SCOPE_AGENT);
                        const unsigned long long p1 = __hip_atomic_load((const unsigned long long*)mp + 1, __ATOMIC_RELAXED, __HIP_MEMORY_SCOPE_AGENT);
                        u32x4 pv; pv.x = (unsigned)p0; pv.y = (unsigned)(p0 >> 32); pv.z = (unsigned)p1; pv.w = (unsigned)(p1 >> 32);
                        float pf[8]; unpack8(pv, pf);
#pragma unroll
                        for (int e = 0; e < 8; ++e) v[e] += pf[e];
                    }
                    *(u32x4*)mp = pack8(v); }
                asm volatile("" ::: "memory"); }
    }
};
struct OutRes {
    static constexpr bool PERM = true, AFTER_DRAIN = false;
    float* Y; const float* H;
    __device__ __forceinline__ void operator()(const f32x4 (&acc)[2][2][4][2], const Unit& u, int wr, int wc, int fr, int fq) const {
        const int row0 = u.pm * BM + wr * 64 + fr; const int col0 = u.pn * BM + wc * 32 + 8 * fq;
#pragma unroll
        for (int ai = 0; ai < 2; ++ai)
#pragma unroll
            for (int m = 0; m < 4; ++m) { const size_t off = (size_t)(row0 + ai * HALF + m * 16) * 1024 + col0;
#pragma unroll
                for (int bj = 0; bj < 2; ++bj) {
                    const f32x4 h0 = *(const f32x4*)(H + off + bj * HALF), h1 = *(const f32x4*)(H + off + bj * HALF + 4);
                    *(f32x4*)(Y + off + bj * HALF) = h0 * DN_ALPHA + acc[ai][bj][m][0]; *(f32x4*)(Y + off + bj * HALF + 4) = h1 * DN_ALPHA + acc[ai][bj][m][1]; }
                asm volatile("" ::: "memory"); }
    }
};
struct MergeOrder {
    pg8::StaticOrder so; int zstep;
    __device__ void init(int G, int c, int zstep_) { so.init(MROWS, 1024, G, c); zstep = zstep_; }
    __device__ bool next(int i, Unit& u) const {
        Unit b; if (!so.next(i / 3, b)) return false; const int n = i % 3;
        u.pm = b.pm; u.pn = 4 * n + b.pn; u.za = zstep * n; u.tag = n; return true;
    }
    __device__ __forceinline__ void a_ready(const Unit&) const {}
    __device__ __forceinline__ void done(const Unit&) const {}
};
}

__device__ __forceinline__ void p2_moba_block(const Frame& F, int u) {
    bf16* P2 = (bf16*)(F.ws + OFF_PROJ2);
    const float* cosB = (const float*)(F.ws + OFF_COSB); const float* sinB = (const float*)(F.ws + OFF_SINB);
    const int c = F.tid & 63, rg = F.tid >> 6;
    const int hh = c >> 3, cc = c & 7;
    float acc[16];
#pragma unroll
    for (int e = 0; e < 16; ++e) acc[e] = 0.f;
    for (int r = rg; r < 256; r += 8) {
        const size_t m = (size_t)u * 256 + r;
        if (cc <= 1) {
            bf16* p = P2 + m * P2LD + (cc == 0 ? C2_MK : C2_MQ) + hh * 64;
            const u32x4 a = *(const u32x4*)p, b = *(const u32x4*)(p + 8);
            float x1[8], x2[8], o1[8], o2[8]; unpack8(a, x1); unpack8(b, x2);
            const f32x4 c0 = *(const f32x4*)(cosB + m * 8), c1 = *(const f32x4*)(cosB + m * 8 + 4), s0 = *(const f32x4*)(sinB + m * 8), s1 = *(const f32x4*)(sinB + m * 8 + 4);
            const float cs[8] = {c0[0], c0[1], c0[2], c0[3], c1[0], c1[1], c1[2], c1[3]}, sn[8] = {s0[0], s0[1], s0[2], s0[3], s1[0], s1[1], s1[2], s1[3]};
#pragma unroll
            for (int e = 0; e < 8; ++e) { o1[e] = x1[e] * cs[e] - x2[e] * sn[e]; o2[e] = x2[e] * cs[e] + x1[e] * sn[e]; }
            const u32x4 w1 = pack8(o1), w2 = pack8(o2);
            *(u32x4*)p = w1; *(u32x4*)(p + 8) = w2;
            if (cc == 0) { float r1[8], r2[8]; unpack8(w1, r1); unpack8(w2, r2);
#pragma unroll
                for (int e = 0; e < 8; ++e) { acc[e] += r1[e]; acc[8 + e] += r2[e]; } }
        } else {
            const u32x4 a = *(const u32x4*)(P2 + m * P2LD + C2_MK + 8 * c);
            float x[8]; unpack8(a, x);
#pragma unroll
            for (int e = 0; e < 8; ++e) acc[e] += x[e];
        }
    }
    LAS float* red = (LAS float*)F.lds;
    __syncthreads();
    if (cc == 0) {
#pragma unroll
        for (int e = 0; e < 16; ++e) red[rg * 512 + hh * 64 + e] = acc[e];
    } else if (cc >= 2) {
#pragma unroll
        for (int e = 0; e < 8; ++e) red[rg * 512 + 8 * c + e] = acc[e];
    }
    __syncthreads();
    {
        float s = 0.f;
#pragma unroll
        for (int g = 0; g < 8; ++g) s += red[g * 512 + F.tid];
        const int b = u >> 3, blk = u & 7, h = F.tid >> 6, d = F.tid & 63;
        ((float*)(F.ws + OFF_KMEAN))[((b * 8 + blk) * 8 + h) * 64 + d] = s * (1.0f / 256.0f);
    }
    __syncthreads();
}

__device__ __forceinline__ void p2_row(const Frame& F, int m) {
    const bf16* P1 = (const bf16*)(F.ws + OFF_PROJ1) + (size_t)m * P1LD;
    const int lane = F.lane;
    float sq = 0.f, skv = 0.f;
    {
        const u32x4 a = *(const u32x4*)(P1 + 8 * lane); float x[8]; unpack8(a, x);
#pragma unroll
        for (int e = 0; e < 8; ++e) sq += x[e] * x[e];
        if (lane < 32) { const u32x4 b = *(const u32x4*)(P1 + 512 + 8 * lane); unpack8(b, x);
#pragma unroll
            for (int e = 0; e < 8; ++e) sq += x[e] * x[e]; }
        else { const u32x4 b = *(const u32x4*)(P1 + 768 + 8 * (lane - 32)); unpack8(b, x);
#pragma unroll
            for (int e = 0; e < 8; ++e) skv += x[e] * x[e]; }
    }
    sq = wave_sum(sq, lane); skv = wave_sum(skv, lane);
    if (lane == 0) { float* rs = (float*)(F.ws + OFF_RSTD) + (size_t)m * 2; rs[0] = 1.0f / sqrtf(sq * (1.0f / 768.0f) + RMS_EPS); rs[1] = 1.0f / sqrtf(skv * (1.0f / 256.0f) + RMS_EPS); }
    if (lane < 16) {
        const float x1 = bf1(P1[1024 + lane]), x2 = bf1(P1[1040 + lane]);
        const float c = ((const float*)(F.ws + OFF_COSA))[(size_t)m * 16 + lane], s = ((const float*)(F.ws + OFF_SINA))[(size_t)m * 16 + lane];
        bf16* kr = (bf16*)(F.ws + OFF_KR) + (size_t)m * 32;
        kr[lane] = (bf16)f2bf(x1 * c - x2 * s); kr[16 + lane] = (bf16)f2bf(x2 * c + x1 * s);
    }
}

template <int I> struct SubstRow {
    static __device__ __forceinline__ void run(float (&t)[64], const LAS float* A, int c) {
        float s0 = (I == c) ? 1.0f : 0.0f, s1 = 0.f, s2 = 0.f, s3 = 0.f;
        const LAS float* row = A + I * 68;
#pragma unroll
        for (int j = 0; j + 3 < I; j += 4) { const f32x4 a = *(const LAS f32x4*)(row + j); s0 -= a[0] * t[j]; s1 -= a[1] * t[j + 1]; s2 -= a[2] * t[j + 2]; s3 -= a[3] * t[j + 3]; }
#pragma unroll
        for (int j = (I / 4) * 4; j < I; ++j) s0 -= row[j] * t[j];
        t[I] = (s0 + s1) + (s2 + s3);
        SubstRow<I + 1>::run(t, A, c);
    }
};
template <> struct SubstRow<64> { static __device__ __forceinline__ void run(float (&)[64], const LAS float*, int) {} };

__device__ __forceinline__ void gdn_chunk_wave(const Frame& F, const Params& P, int l, int ch, LAS float* Asm) {
    const int lane = F.lane, i16 = lane & 15, kq = lane >> 4;
    const int h = ch & 7, c = (ch >> 3) & 31, b = ch >> 8;
    const size_t t0 = (size_t)b * SEQ + c * 64;
    const bf16* P2 = (const bf16*)(F.ws + OFF_PROJ2);
    bf16* G = (bf16*)(F.ws + OFF_GDN) + (size_t)ch * 6 * GDN_MAT;
    const float* convw = (const float*)P.in[9] + (size_t)l * 4 * 1536;
    float g, beta;
    {
        const float ga = bf1(P2[(t0 + lane) * P2LD + C2_GA + h]), gb = bf1(P2[(t0 + lane) * P2LD + C2_GB + h]);
        const float Al = ((const float*)P.in[10])[l * 8 + h], dtb = ((const float*)P.in[11])[l * 8 + h];
        g = -__expf(Al) * softplusf_(ga + dtb); beta = sigmoidf_(gb);
    }
    float gc = g;
#pragma unroll
    for (int o = 1; o < 64; o <<= 1) { const float t = shfl_upl(gc, o, lane); if (lane >= o) gc += t; }
    const float glast = shfl_idx(gc, 63);
    if (lane == 0) ((float*)(F.ws + OFF_GLS))[ch] = __expf(glast);
    bf16x8 qf[4][2], kf[4][2];
    float gct[4], btk[4];
#pragma unroll
    for (int mt = 0; mt < 4; ++mt) { gct[mt] = shfl_idx(gc, 16 * mt + i16); btk[mt] = shfl_idx(beta, 16 * mt + i16); }
    float ssq_q[4], ssq_k[4];
#pragma unroll
    for (int mt = 0; mt < 4; ++mt) { ssq_q[mt] = 0.f; ssq_k[mt] = 0.f; }
    LAS u32x4* raw = (LAS u32x4*)Asm;
#pragma unroll 1
    for (int blk = 0; blk < 6; ++blk) {
        const int w3 = blk >> 1, ks = blk & 1;
        const int c0 = 32 * ks + 8 * kq;
        const int pcol = C2_GQ + w3 * 512 + h * 64 + c0, wcol = w3 * 512 + h * 64 + c0;
        float wt[4][8];
#pragma unroll
        for (int j = 0; j < 4; ++j) { const f32x4 w0 = *(const f32x4*)(convw + j * 1536 + wcol), w1 = *(const f32x4*)(convw + j * 1536 + wcol + 4);
            wt[j][0] = w0[0]; wt[j][1] = w0[1]; wt[j][2] = w0[2]; wt[j][3] = w0[3]; wt[j][4] = w1[0]; wt[j][5] = w1[1]; wt[j][6] = w1[2]; wt[j][7] = w1[3]; }
#pragma unroll
        for (int mt = 0; mt < 4; ++mt) {
            const int tok = 16 * mt + i16;
            float a8[8];
#pragma unroll
            for (int e = 0; e < 8; ++e) a8[e] = 0.f;
#pragma unroll
            for (int j = 0; j < 4; ++j) {
                const int s = c * 64 + tok - 3 + j;
                u32x4 xv = (u32x4){0u, 0u, 0u, 0u};
                if (s >= 0) xv = *(const u32x4*)(P2 + ((size_t)b * SEQ + s) * P2LD + pcol);
                float x[8]; unpack8(xv, x);
#pragma unroll
                for (int e = 0; e < 8; ++e) a8[e] += x[e] * wt[j][e];
            }
#pragma unroll
            for (int e = 0; e < 8; ++e) a8[e] = siluf_(a8[e]);
            if (w3 == 2) {
#pragma unroll
                for (int e = 0; e < 8; ++e) G[3 * GDN_MAT + (c0 + e) * 64 + tok] = (bf16)f2bf(a8[e] * btk[mt]);
            } else {
                float ss = 0.f;
#pragma unroll
                for (int e = 0; e < 8; ++e) ss += a8[e] * a8[e];
                ssq_q[mt] += (w3 == 0) ? ss : 0.f; ssq_k[mt] += (w3 == 1) ? ss : 0.f;
                raw[((w3 * 4 + mt) * 2 + ks) * 64 + lane] = pack8(a8);
            }
        }
    }
    LDS_WAIT(); asm volatile("" ::: "memory");
#pragma unroll
    for (int mt = 0; mt < 4; ++mt) {
        const int tok = 16 * mt + i16;
        float sq = ssq_q[mt], sk = ssq_k[mt];
        sq += shfl_xl(sq, 16, lane); sq += shfl_xl(sq, 32, lane); sk += shfl_xl(sk, 16, lane); sk += shfl_xl(sk, 32, lane);
        const float rq = 0.125f / sqrtf(sq + RMS_EPS), rk = 1.0f / sqrtf(sk + RMS_EPS);
        const float eg = __expf(gct[mt]), ed = __expf(glast - gct[mt]), bt = btk[mt];
#pragma unroll
        for (int ks = 0; ks < 2; ++ks) {
            const int c0 = 32 * ks + 8 * kq;
            float q[8], k[8], tq[8], tk[8];
            unpack8(raw[((0 * 4 + mt) * 2 + ks) * 64 + lane], q); unpack8(raw[((1 * 4 + mt) * 2 + ks) * 64 + lane], k);
#pragma unroll
            for (int e = 0; e < 8; ++e) { q[e] *= rq; k[e] *= rk; }
            qf[mt][ks] = __builtin_bit_cast(bf16x8, pack8(q)); kf[mt][ks] = __builtin_bit_cast(bf16x8, pack8(k));
#pragma unroll
            for (int e = 0; e < 8; ++e) { tq[e] = q[e] * eg; tk[e] = -k[e] * bt * eg; }
            *(u32x4*)(G + 0 * GDN_MAT + tok * 64 + c0) = pack8(tq);
            *(u32x4*)(G + 1 * GDN_MAT + tok * 64 + c0) = pack8(tk);
#pragma unroll
            for (int e = 0; e < 8; ++e) G[2 * GDN_MAT + (c0 + e) * 64 + tok] = (bf16)f2bf(k[e] * ed);
        }
    }
    LDS_WAIT(); asm volatile("" ::: "memory");
#pragma unroll
    for (int mt = 0; mt < 4; ++mt) {
        const int i = 16 * mt + i16; const float bti = shfl_idx(beta, i);
#pragma unroll
        for (int nt = 0; nt < 4; ++nt) {
            f32x4 sqk = {0.f, 0.f, 0.f, 0.f}, skk = {0.f, 0.f, 0.f, 0.f};
            if (nt <= mt) {
#pragma unroll
                for (int ks = 0; ks < 2; ++ks) {
                    sqk = __builtin_amdgcn_mfma_f32_16x16x32_bf16(kf[nt][ks], qf[mt][ks], sqk, 0, 0, 0);
                    skk = __builtin_amdgcn_mfma_f32_16x16x32_bf16(kf[nt][ks], kf[mt][ks], skk, 0, 0, 0);
                }
            }
            float oq[4], oa[4];
#pragma unroll
            for (int r = 0; r < 4; ++r) {
                const int j = 16 * nt + 4 * kq + r; const float gcj = shfl_idx(gc, j);
                const float dec = (j <= i) ? __expf(gct[mt] - gcj) : 0.f;
                oq[r] = sqk[r] * dec; oa[r] = (j < i) ? skk[r] * dec * bti : 0.f;
            }
            u32x2 w; w.x = pk2(oq[0], oq[1]); w.y = pk2(oq[2], oq[3]);
            *(u32x2*)(G + 5 * GDN_MAT + i * 64 + 16 * nt + 4 * kq) = w;
            *(LAS f32x4*)(Asm + i * 68 + 16 * nt + 4 * kq) = (f32x4){oa[0], oa[1], oa[2], oa[3]};
        }
    }
    LDS_WAIT(); asm volatile("" ::: "memory");
#ifndef NO_SUBST
    float t[64];
    SubstRow<0>::run(t, Asm, lane);
#pragma unroll
    for (int i = 0; i < 64; ++i) G[4 * GDN_MAT + i * 64 + lane] = (bf16)f2bf(t[i]);
#endif
    LDS_WAIT(); asm volatile("" ::: "memory");
}

__device__ __forceinline__ void p2_phase(const Frame& F, const Params& P, int l) {
    if (F.bid < 64) p2_moba_block(F, F.bid);
    const int gw = ((F.bid + F.G - 64) % F.G) * NWAVES + F.wave, NGW = F.G * NWAVES;
    for (int m = gw; m < MROWS; m += NGW) p2_row(F, m);
    LAS float* Asm = (LAS float*)(F.lds + F.wave * 17408);
    for (int ch = gw; ch < 2048; ch += NGW) gdn_chunk_wave(F, P, l, ch, Asm);
}

typedef short v4i16_t __attribute__((ext_vector_type(4)));
__device__ __forceinline__ s16x4 ds_tr16(const LAS bf16* p) { return __builtin_bit_cast(s16x4, __builtin_amdgcn_ds_read_tr16_b64_v4i16((LAS v4i16_t*)p)); }
__device__ __forceinline__ int crow(int r, int hi) { return (r & 3) + 8 * (r >> 2) + 4 * hi; }

template <int DK, bool MOBA>
__device__ __forceinline__ void attn_unit(const Frame& F, int b, int h, int qb) {
    constexpr int KSTR = (DK == 96) ? 104 : 72;
    constexpr int VSTR = 96;
    constexpr int BUF = 64 * KSTR + 64 * VSTR;
    constexpr int NS = DK / 16;
    const int tid = F.tid, lane = F.lane, w = F.wave, ql = lane & 31, hh = lane >> 5;
    LAS bf16* L = (LAS bf16*)F.lds;
    const bf16* Qs; const bf16* Ks; const bf16* Vs; int ldq, ldk; float scale;
    if (MOBA) { const bf16* P2 = (const bf16*)(F.ws + OFF_PROJ2); Qs = P2 + C2_MQ + h * 64; Ks = P2 + C2_MK + h * 64; Vs = P2 + C2_MV + h * 64; ldq = P2LD; ldk = P2LD; scale = 0.125f * 1.4426950408889634f; }
    else { Qs = (const bf16*)(F.ws + OFF_QMLA) + h * 96; const bf16* KV = (const bf16*)(F.ws + OFF_KVMLA) + h * 128; Ks = KV; Vs = KV + 64; ldq = 768; ldk = 1024; scale = 0.10206207261596575f * 1.4426950408889634f; }
    const bf16* KR = (const bf16*)(F.ws + OFF_KR);
    const size_t mb = (size_t)b * SEQ;
    const size_t mq = mb + qb * 256 + w * 32 + ql;

    unsigned selbits = 0;
    if (MOBA) {
        if (qb <= 3) selbits = (1u << qb) - 1u;
        else {
            LAS float* kml = (LAS float*)(F.lds + 2 * BUF * 2);
            __syncthreads();
            if (tid < qb * 64) kml[tid] = ((const float*)(F.ws + OFF_KMEAN))[((b * 8 + (tid >> 6)) * 8 + h) * 64 + (tid & 63)];
            __syncthreads();
            float qv[64];
#pragma unroll
            for (int c8 = 0; c8 < 8; ++c8) { const u32x4 a = *(const u32x4*)(Qs + mq * ldq + 8 * c8); unpack8(a, qv + 8 * c8); }
            float g0 = -3e38f, g1 = -3e38f, g2 = -3e38f; int i0 = 0, i1 = 0, i2 = 0;
            for (int j = 0; j < qb; ++j) {
                float s = 0.f;
#pragma unroll
                for (int d = 0; d < 64; ++d) s += qv[d] * kml[j * 64 + d];
                if (s > g0) { g2 = g1; i2 = i1; g1 = g0; i1 = i0; g0 = s; i0 = j; }
                else if (s > g1) { g2 = g1; i2 = i1; g1 = s; i1 = j; }
                else if (s > g2) { g2 = s; i2 = j; }
            }
            selbits = (1u << i0) | (1u << i1) | (1u << i2);
        }
    }
    bf16x8 qf[NS];
    {
        float qx[NS][8];
#pragma unroll
        for (int s = 0; s < NS; ++s) { const u32x4 a = *(const u32x4*)(Qs + mq * ldq + 16 * s + 8 * hh); unpack8(a, qx[s]); }
        if (!MOBA) {
            const float* cp = (const float*)(F.ws + OFF_COSA) + mq * 16 + 8 * hh; const float* sp = (const float*)(F.ws + OFF_SINA) + mq * 16 + 8 * hh;
            const f32x4 c0 = *(const f32x4*)cp, c1 = *(const f32x4*)(cp + 4), s0 = *(const f32x4*)sp, s1 = *(const f32x4*)(sp + 4);
            const float cs[8] = {c0[0], c0[1], c0[2], c0[3], c1[0], c1[1], c1[2], c1[3]}, sn[8] = {s0[0], s0[1], s0[2], s0[3], s1[0], s1[1], s1[2], s1[3]};
#pragma unroll
            for (int e = 0; e < 8; ++e) { const float x1 = qx[NS - 2][e], x2 = qx[NS - 1][e]; qx[NS - 2][e] = x1 * cs[e] - x2 * sn[e]; qx[NS - 1][e] = x2 * cs[e] + x1 * sn[e]; }
        }
#pragma unroll
        for (int s = 0; s < NS; ++s) {
#pragma unroll
            for (int e = 0; e < 8; ++e) qx[s][e] *= scale;
            qf[s] = __builtin_bit_cast(bf16x8, pack8(qx[s]));
        }
    }
    const int skr = tid >> 3, sc8 = tid & 7;
    const int rkr = tid >> 2, rc4 = tid & 3;
    const int ntile = 4 * (qb + 1);
    auto tile_of = [&](int it) -> int { return MOBA ? (it < 4 ? 4 * qb + it : it - 4) : it; };
    u32x4 rk, rv, rr;
    auto gload = [&](int t) {
        const size_t kb = mb + (size_t)t * 64;
        rk = *(const u32x4*)(Ks + (kb + skr) * ldk + 8 * sc8);
        rv = *(const u32x4*)(Vs + (kb + skr) * ldk + 8 * sc8);
        if (DK == 96 && tid < 256) rr = *(const u32x4*)(KR + (kb + rkr) * 32 + 8 * rc4);
    };
    auto lstore = [&](int buf) {
        LAS bf16* Kt = L + buf * BUF; LAS bf16* Vt = Kt + 64 * KSTR;
        *(LAS u32x4*)(Kt + skr * KSTR + 8 * sc8) = rk;
        *(LAS u32x4*)(Vt + skr * VSTR + 8 * sc8) = rv;
        if (DK == 96 && tid < 256) *(LAS u32x4*)(Kt + rkr * KSTR + 64 + 8 * rc4) = rr;
    };
    float mrun = -1e30f, lrun = 0.f;
    f32x16 o0 = {}, o1 = {};
    __syncthreads();
    gload(tile_of(0)); lstore(0);
    __syncthreads();
    for (int it = 0; it < ntile; ++it) {
        const int t = tile_of(it);
        if (it + 1 < ntile) gload(tile_of(it + 1));
        const bool diag = t >= 4 * qb; const int tb = t - 4 * qb;
        bool active = true;
        if (diag) active = tb <= (w >> 1);
        bool rowsel = true;
        if (MOBA && !diag) { rowsel = (selbits >> (t >> 2)) & 1u; active = __any(rowsel) != 0; }
        if (active) {
            const LAS bf16* Kt = L + (it & 1) * BUF; const LAS bf16* Vt = Kt + 64 * KSTR;
            f32x16 p0 = {}, p1 = {};
#pragma unroll
            for (int s = 0; s < NS; ++s) {
                const bf16x8 a0 = *(const LAS bf16x8*)(Kt + ql * KSTR + 16 * s + 8 * hh);
                const bf16x8 a1 = *(const LAS bf16x8*)(Kt + (32 + ql) * KSTR + 16 * s + 8 * hh);
                p0 = __builtin_amdgcn_mfma_f32_32x32x16_bf16(a0, qf[s], p0, 0, 0, 0);
                p1 = __builtin_amdgcn_mfma_f32_32x32x16_bf16(a1, qf[s], p1, 0, 0, 0);
            }
            if (diag) {
                const int qloc = 32 * w + ql;
#pragma unroll
                for (int r = 0; r < 16; ++r) { const int kl = 64 * tb + crow(r, hh); if (kl > qloc) p0[r] = -1e30f; if (kl + 32 > qloc) p1[r] = -1e30f; }
            }
            if (MOBA && !diag && !rowsel) {
#pragma unroll
                for (int r = 0; r < 16; ++r) { p0[r] = -1e30f; p1[r] = -1e30f; }
            }
            float mx = p0[0];
#pragma unroll
            for (int r = 1; r < 16; ++r) mx = fmaxf(mx, p0[r]);
#pragma unroll
            for (int r = 0; r < 16; ++r) mx = fmaxf(mx, p1[r]);
            mx = fmaxf(mx, shfl_xl(mx, 32, lane));
            const float mnew = fmaxf(mrun, mx);
            if (__any(mnew > mrun)) {
                const float alpha = __builtin_amdgcn_exp2f(mrun - mnew);
                lrun *= alpha;
#pragma unroll
                for (int r = 0; r < 16; ++r) { o0[r] *= alpha; o1[r] *= alpha; }
            }
            mrun = mnew;
            float ps = 0.f;
#pragma unroll
            for (int r = 0; r < 16; ++r) { p0[r] = __builtin_amdgcn_exp2f(p0[r] - mnew); p1[r] = __builtin_amdgcn_exp2f(p1[r] - mnew); ps += p0[r] + p1[r]; }
            lrun += ps;
            bf16x8 pf[4];
            { float tmp[8];
#pragma unroll
              for (int e = 0; e < 8; ++e) tmp[e] = p0[e];
              pf[0] = __builtin_bit_cast(bf16x8, pack8(tmp));
#pragma unroll
              for (int e = 0; e < 8; ++e) tmp[e] = p0[8 + e];
              pf[1] = __builtin_bit_cast(bf16x8, pack8(tmp));
#pragma unroll
              for (int e = 0; e < 8; ++e) tmp[e] = p1[e];
              pf[2] = __builtin_bit_cast(bf16x8, pack8(tmp));
#pragma unroll
              for (int e = 0; e < 8; ++e) tmp[e] = p1[8 + e];
              pf[3] = __builtin_bit_cast(bf16x8, pack8(tmp)); }
            const int i15 = lane & 15, dblk = (lane >> 4) & 1;
#pragma unroll
            for (int s4 = 0; s4 < 4; ++s4) {
                const int key0 = 16 * s4 + 4 * hh;
#pragma unroll
                for (int dt = 0; dt < 2; ++dt) {
                    const LAS bf16* va = Vt + (key0 + (i15 >> 2)) * VSTR + 32 * dt + 16 * dblk + 4 * (i15 & 3);
                    const s16x4 lo = ds_tr16(va), hi2 = ds_tr16(va + 8 * VSTR);
                    const bf16x8 vf = (bf16x8){lo[0], lo[1], lo[2], lo[3], hi2[0], hi2[1], hi2[2], hi2[3]};
                    if (dt == 0) o0 = __builtin_amdgcn_mfma_f32_32x32x16_bf16(vf, pf[s4], o0, 0, 0, 0);
                    else o1 = __builtin_amdgcn_mfma_f32_32x32x16_bf16(vf, pf[s4], o1, 0, 0, 0);
                }
            }
        }
        if (it + 1 < ntile) lstore((it + 1) & 1);
        __syncthreads();
    }
    const float ltot = lrun + shfl_xl(lrun, 32, lane);
    const float inv = 1.0f / ltot;
    bf16* op = (bf16*)(F.ws + OFF_BR) + mq * BRLD + (MOBA ? 512 : 0) + h * 64;
#pragma unroll
    for (int g = 0; g < 4; ++g) {
        u32x2 w0, w1;
        w0.x = pk2(o0[4 * g] * inv, o0[4 * g + 1] * inv); w0.y = pk2(o0[4 * g + 2] * inv, o0[4 * g + 3] * inv);
        w1.x = pk2(o1[4 * g] * inv, o1[4 * g + 1] * inv); w1.y = pk2(o1[4 * g + 2] * inv, o1[4 * g + 3] * inv);
        *(u32x2*)(op + 8 * g + 4 * hh) = w0; *(u32x2*)(op + 32 + 8 * g + 4 * hh) = w1;
    }
}

#define LBAR() do { asm volatile("s_waitcnt lgkmcnt(0)" ::: "memory"); __builtin_amdgcn_s_barrier(); asm volatile("" ::: "memory"); } while (0)
struct GdnOps { bf16x8 a[5][2]; u32x2 vb[2]; bf16 z[8]; float gl; };

__device__ __forceinline__ void gdn_load_ops(GdnOps& o, const bf16* Gb, float* gls, const bf16* P2, int b, int h, int c, int rg, int dh, int i16, int kq) {
    const int ch = (b * 32 + c) * 8 + h;
    const bf16* G = Gb + (size_t)ch * 6 * GDN_MAT;
    const int row = 16 * rg + i16;
    constexpr int MATS[5] = {1, 4, 0, 5, 2};
#pragma unroll
    for (int m = 0; m < 5; ++m)
#pragma unroll
        for (int ks = 0; ks < 2; ++ks) o.a[m][ks] = *(const bf16x8*)(G + MATS[m] * GDN_MAT + row * 64 + 32 * ks + 8 * kq);
#pragma unroll
    for (int nt = 0; nt < 2; ++nt) o.vb[nt] = *(const u32x2*)(G + 3 * GDN_MAT + (32 * dh + 16 * nt + i16) * 64 + 16 * rg + 4 * kq);
    const size_t m0 = (size_t)b * SEQ + c * 64 + 16 * rg + 4 * kq;
#pragma unroll
    for (int r = 0; r < 4; ++r)
#pragma unroll
        for (int nt = 0; nt < 2; ++nt) o.z[2 * r + nt] = P2[(m0 + r) * P2LD + C2_GZ + h * 64 + 32 * dh + 16 * nt + i16];
    o.gl = ld_coh_f32(gls + ch);
}

__device__ __forceinline__ void gdn_chunk_step(const GdnOps& o, f32x4 (&Sacc)[2], LAS bf16* Sb, LAS bf16* XT, LAS bf16* VT, LAS float* ssq, bf16* BR, const float on0, const float on1,
                                               int b, int h, int c, int rg, int dh, int i16, int kq) {
    constexpr int BSTR = 72;
    const int lane = 16 * kq + i16;
    const int brow0 = 32 * dh + i16;
    const int kcol = 16 * rg + 4 * kq;
#define BFR(img, nt, ks) (*(const LAS bf16x8*)((img) + (brow0 + 16 * (nt)) * BSTR + 32 * (ks) + 8 * kq))
    const f32x4 zero4 = {0.f, 0.f, 0.f, 0.f};
    f32x4 accX[2], accO[2], accV[2];
    {
        const bf16x8 s00 = BFR(Sb, 0, 0), s01 = BFR(Sb, 0, 1), s10 = BFR(Sb, 1, 0), s11 = BFR(Sb, 1, 1);
        accX[0] = (f32x4){bflo(o.vb[0].x), bfhi(o.vb[0].x), bflo(o.vb[0].y), bfhi(o.vb[0].y)};
        accX[1] = (f32x4){bflo(o.vb[1].x), bfhi(o.vb[1].x), bflo(o.vb[1].y), bfhi(o.vb[1].y)};
        accX[0] = __builtin_amdgcn_mfma_f32_16x16x32_bf16(o.a[0][0], s00, accX[0], 0, 0, 0); accX[0] = __builtin_amdgcn_mfma_f32_16x16x32_bf16(o.a[0][1], s01, accX[0], 0, 0, 0);
        accX[1] = __builtin_amdgcn_mfma_f32_16x16x32_bf16(o.a[0][0], s10, accX[1], 0, 0, 0); accX[1] = __builtin_amdgcn_mfma_f32_16x16x32_bf16(o.a[0][1], s11, accX[1], 0, 0, 0);
#pragma unroll
        for (int nt = 0; nt < 2; ++nt) { u32x2 wv; wv.x = pk2(accX[nt][0], accX[nt][1]); wv.y = pk2(accX[nt][2], accX[nt][3]); *(LAS u32x2*)(XT + (brow0 + 16 * nt) * BSTR + kcol) = wv; }
        accO[0] = __builtin_amdgcn_mfma_f32_16x16x32_bf16(o.a[2][0], s00, zero4, 0, 0, 0); accO[0] = __builtin_amdgcn_mfma_f32_16x16x32_bf16(o.a[2][1], s01, accO[0], 0, 0, 0);
        accO[1] = __builtin_amdgcn_mfma_f32_16x16x32_bf16(o.a[2][0], s10, zero4, 0, 0, 0); accO[1] = __builtin_amdgcn_mfma_f32_16x16x32_bf16(o.a[2][1], s11, accO[1], 0, 0, 0);
    }
    LBAR();
    {
        const bf16x8 x00 = BFR(XT, 0, 0), x01 = BFR(XT, 0, 1), x10 = BFR(XT, 1, 0), x11 = BFR(XT, 1, 1);
        accV[0] = __builtin_amdgcn_mfma_f32_16x16x32_bf16(o.a[1][0], x00, zero4, 0, 0, 0); accV[0] = __builtin_amdgcn_mfma_f32_16x16x32_bf16(o.a[1][1], x01, accV[0], 0, 0, 0);
        accV[1] = __builtin_amdgcn_mfma_f32_16x16x32_bf16(o.a[1][0], x10, zero4, 0, 0, 0); accV[1] = __builtin_amdgcn_mfma_f32_16x16x32_bf16(o.a[1][1], x11, accV[1], 0, 0, 0);
#pragma unroll
        for (int nt = 0; nt < 2; ++nt) { u32x2 wv; wv.x = pk2(accV[nt][0], accV[nt][1]); wv.y = pk2(accV[nt][2], accV[nt][3]); *(LAS u32x2*)(VT + (brow0 + 16 * nt) * BSTR + kcol) = wv; }
    }
    LBAR();
    {
        const bf16x8 v00 = BFR(VT, 0, 0), v01 = BFR(VT, 0, 1), v10 = BFR(VT, 1, 0), v11 = BFR(VT, 1, 1);
        Sacc[0] = Sacc[0] * o.gl; Sacc[1] = Sacc[1] * o.gl;
        Sacc[0] = __builtin_amdgcn_mfma_f32_16x16x32_bf16(o.a[4][0], v00, Sacc[0], 0, 0, 0); Sacc[0] = __builtin_amdgcn_mfma_f32_16x16x32_bf16(o.a[4][1], v01, Sacc[0], 0, 0, 0);
        Sacc[1] = __builtin_amdgcn_mfma_f32_16x16x32_bf16(o.a[4][0], v10, Sacc[1], 0, 0, 0); Sacc[1] = __builtin_amdgcn_mfma_f32_16x16x32_bf16(o.a[4][1], v11, Sacc[1], 0, 0, 0);
#pragma unroll
        for (int nt = 0; nt < 2; ++nt) { u32x2 wv; wv.x = pk2(Sacc[nt][0], Sacc[nt][1]); wv.y = pk2(Sacc[nt][2], Sacc[nt][3]); *(LAS u32x2*)(Sb + (brow0 + 16 * nt) * BSTR + kcol) = wv; }
        accO[0] = __builtin_amdgcn_mfma_f32_16x16x32_bf16(o.a[3][0], v00, accO[0], 0, 0, 0); accO[0] = __builtin_amdgcn_mfma_f32_16x16x32_bf16(o.a[3][1], v01, accO[0], 0, 0, 0);
        accO[1] = __builtin_amdgcn_mfma_f32_16x16x32_bf16(o.a[3][0], v10, accO[1], 0, 0, 0); accO[1] = __builtin_amdgcn_mfma_f32_16x16x32_bf16(o.a[3][1], v11, accO[1], 0, 0, 0);
    }
#undef BFR
    LAS float* sq = ssq + (c & 1) * 128;
#pragma unroll
    for (int r = 0; r < 4; ++r) {
        float s = accO[0][r] * accO[0][r] + accO[1][r] * accO[1][r];
        s += shfl_xl(s, 1, lane); s += shfl_xl(s, 2, lane); s += shfl_xl(s, 4, lane); s += shfl_xl(s, 8, lane);
        if (i16 == 0) sq[dh * 64 + kcol + r] = s;
    }
    LBAR();
    const size_t m0 = (size_t)b * SEQ + c * 64 + kcol;
#pragma unroll
    for (int r = 0; r < 4; ++r) {
        const float rs = 1.0f / sqrtf((sq[kcol + r] + sq[64 + kcol + r]) * (1.0f / 64.0f) + RMS_EPS);
#pragma unroll
        for (int nt = 0; nt < 2; ++nt) {
            const int dv = 32 * dh + 16 * nt + i16;
            const float v = accO[nt][r] * rs * (nt == 0 ? on0 : on1) * siluf_(bf1(o.z[2 * r + nt]));
            BR[(m0 + r) * BRLD + 1024 + h * 64 + dv] = (bf16)f2bf(v);
        }
    }
}

__device__ __forceinline__ void gdn_scan_unit(const Frame& F, const Params& P, int l, int b, int h) {
    constexpr int BSTR = 72;
    const int lane = F.lane, w = F.wave, i16 = lane & 15, kq = lane >> 4, rg = w & 3, dh = w >> 2;
    LAS bf16* Sb = (LAS bf16*)F.lds;
    LAS bf16* XT = Sb + 64 * BSTR;
    LAS bf16* VT = XT + 64 * BSTR;
    LAS float* ssq = (LAS float*)(F.lds + 3 * 64 * BSTR * 2);
    const bf16* Gb = (const bf16*)(F.ws + OFF_GDN);
    float* gls = (float*)(F.ws + OFF_GLS);
    const bf16* P2 = (const bf16*)(F.ws + OFF_PROJ2);
    bf16* BR = (bf16*)(F.ws + OFF_BR);
    const float* onorm = (const float*)P.in[12] + l * 64;
    const float on0 = onorm[32 * dh + i16], on1 = onorm[32 * dh + 16 + i16];
    __syncthreads();
    f32x4 Sacc[2] = {{0.f, 0.f, 0.f, 0.f}, {0.f, 0.f, 0.f, 0.f}};
#pragma unroll
    for (int nt = 0; nt < 2; ++nt) *(LAS u32x2*)(Sb + (32 * dh + 16 * nt + i16) * BSTR + 16 * rg + 4 * kq) = (u32x2){0u, 0u};
    GdnOps A, B;
    gdn_load_ops(A, Gb, gls, P2, b, h, 0, rg, dh, i16, kq);
    __syncthreads();
#pragma unroll 1
    for (int c = 0; c < 32; c += 2) {
        gdn_load_ops(B, Gb, gls, P2, b, h, c + 1, rg, dh, i16, kq);
        gdn_chunk_step(A, Sacc, Sb, XT, VT, ssq, BR, on0, on1, b, h, c, rg, dh, i16, kq);
        if (c + 2 < 32) gdn_load_ops(A, Gb, gls, P2, b, h, c + 2, rg, dh, i16, kq);
        gdn_chunk_step(B, Sacc, Sb, XT, VT, ssq, BR, on0, on1, b, h, c + 1, rg, dh, i16, kq);
    }
    __syncthreads();
}

__device__ __forceinline__ unsigned f2key(float f) { unsigned u = __builtin_bit_cast(unsigned, f); return (u & 0x80000000u) ? ~u : (u | 0x80000000u); }
__device__ __forceinline__ float key2f(unsigned k) { const unsigned u = (k & 0x80000000u) ? (k & 0x7fffffffu) : ~k; return __builtin_bit_cast(float, u); }


__device__ __forceinline__ void cmpx_desc(unsigned& a, unsigned& b) { const unsigned hi = a > b ? a : b, lo = a > b ? b : a; a = hi; b = lo; }
template <int N> __device__ __forceinline__ void bitonic_merge_desc(unsigned* a) {
#pragma unroll
    for (int j = N / 2; j > 0; j >>= 1)
#pragma unroll
        for (int i = 0; i < N; ++i) { const int l = i ^ j; if (l > i) cmpx_desc(a[i], a[l]); }
}
template <int N> __device__ __forceinline__ void bitonic_sort_desc(unsigned* a) {
#pragma unroll
    for (int k = 2; k <= N; k <<= 1)
#pragma unroll
        for (int j = k >> 1; j > 0; j >>= 1)
#pragma unroll
            for (int i = 0; i < N; ++i) { const int l = i ^ j; if (l > i) { if ((i & k) == 0 || k == N) cmpx_desc(a[i], a[l]); else cmpx_desc(a[l], a[i]); } }
}
__device__ __forceinline__ void top16_merge(unsigned* a, const unsigned* b) {
#pragma unroll
    for (int i = 0; i < 16; ++i) a[i] = a[i] > b[15 - i] ? a[i] : b[15 - i];
    bitonic_merge_desc<16>(a);
}
__device__ __forceinline__ void top16_of_pair64(unsigned* key, unsigned* out, int lane) {
    bitonic_sort_desc<16>(key); bitonic_sort_desc<16>(key + 16); bitonic_sort_desc<16>(key + 32); bitonic_sort_desc<16>(key + 48);
    top16_merge(key, key + 16); top16_merge(key + 32, key + 48); top16_merge(key, key + 32);
    unsigned oth[16];
#pragma unroll
    for (int i = 0; i < 16; ++i) oth[i] = (unsigned)shfl_xl((int)key[i], 32, lane);
#pragma unroll
    for (int i = 0; i < 16; ++i) out[i] = key[i];
    top16_merge(out, oth);
}
__device__ __forceinline__ void peer_topk_unit(const Frame& F, int l, int tt) {
    const int lane = F.lane, h = F.wave, tk = lane & 31, hh = lane >> 5;
    const size_t m = (size_t)tt * 32 + tk;
    const bf16* QRY = (const bf16*)(F.ws + OFF_QRY);
    const bf16* SK = (const bf16*)(F.ws + OFF_W + (size_t)l * W_LAYER + WO_SK);
    LAS int* li = (LAS int*)F.lds + F.tid * 33;
    unsigned top[2][16];
#pragma unroll
    for (int p = 0; p < 2; ++p) {
        bf16x8 qf[8];
#pragma unroll
        for (int s = 0; s < 8; ++s) qf[s] = *(const bf16x8*)(QRY + m * 2048 + (2 * h + p) * 128 + 16 * s + 8 * hh);
        unsigned key[64];
#pragma unroll
        for (int kt = 0; kt < 4; ++kt) {
            f32x16 acc = {};
            const bf16* kp = SK + ((size_t)(h * 2 + p) * 128 + 32 * kt + tk) * 128 + 8 * hh;
#pragma unroll
            for (int s = 0; s < 8; ++s) acc = __builtin_amdgcn_mfma_f32_32x32x16_bf16(*(const bf16x8*)(kp + 16 * s), qf[s], acc, 0, 0, 0);
#pragma unroll
            for (int r = 0; r < 16; ++r) { const int kidx = 32 * kt + crow(r, hh); key[16 * kt + r] = (f2key(acc[r]) & ~0x7fu) | (unsigned)(127 - kidx); }
        }
        top16_of_pair64(key, top[p], lane);
    }
    float v1[16], v2[16];
#pragma unroll
    for (int a = 0; a < 16; ++a) { li[a] = 127 - (int)(top[0][a] & 0x7fu); li[16 + a] = 127 - (int)(top[1][a] & 0x7fu); v1[a] = key2f(top[0][a] & ~0x7fu); v2[a] = key2f(top[1][a] & ~0x7fu); }
    unsigned ck[32];
#pragma unroll
    for (int e = 0; e < 32; ++e) ck[e] = 0u;
    {
        int n = 0;
#pragma unroll
        for (int a = 0; a < 16; ++a)
#pragma unroll
            for (int bb = 0; bb < 16; ++bb)
                if ((a + 1) * (bb + 1) <= 16) {
                    const int slot = n % 25, owner = n / 25;
                    const unsigned kv = (f2key(v1[a] + v2[bb]) & ~0xffu) | (unsigned)(255 - (16 * a + bb));
                    if (owner == 0) ck[slot] = (hh == 0) ? kv : ck[slot]; else ck[slot] = (hh == 1) ? kv : ck[slot];
                    ++n;
                }
    }
    unsigned win[16];
    {
        bitonic_sort_desc<16>(ck); bitonic_sort_desc<16>(ck + 16); top16_merge(ck, ck + 16);
        unsigned oth[16];
#pragma unroll
        for (int i = 0; i < 16; ++i) oth[i] = (unsigned)shfl_xl((int)ck[i], 32, lane);
#pragma unroll
        for (int i = 0; i < 16; ++i) win[i] = ck[i];
        top16_merge(win, oth);
    }
    LDS_WAIT();
    float sv[16]; int ids[16];
#pragma unroll
    for (int rd = 0; rd < 16; ++rd) {
        const int flat = 255 - (int)(win[rd] & 0xffu), a = flat >> 4, bb = flat & 15;
        const int ia = li[a], ib = li[16 + bb];
        ids[rd] = ia * 128 + ib;
        float sa = 0.f, sb = 0.f;
#pragma unroll
        for (int e = 0; e < 16; ++e) { sa = (e == a) ? v1[e] : sa; sb = (e == bb) ? v2[e] : sb; }
        sv[rd] = sa + sb;
    }
    float mxv = sv[0];
#pragma unroll
    for (int e = 1; e < 16; ++e) mxv = fmaxf(mxv, sv[e]);
    float den = 0.f;
#pragma unroll
    for (int e = 0; e < 16; ++e) { sv[e] = __expf(sv[e] - mxv); den += sv[e]; }
    const float inv = 1.0f / den;
    if (hh == 0) { int* ip = (int*)(F.ws + OFF_IDX) + m * 128 + h * 16;
#pragma unroll
        for (int q4 = 0; q4 < 4; ++q4) *(u32x4*)(ip + 4 * q4) = (u32x4){(unsigned)ids[4 * q4], (unsigned)ids[4 * q4 + 1], (unsigned)ids[4 * q4 + 2], (unsigned)ids[4 * q4 + 3]}; }
    else { float* gp = (float*)(F.ws + OFF_GATE) + m * 128 + h * 16;
#pragma unroll
        for (int q4 = 0; q4 < 4; ++q4) *(f32x4*)(gp + 4 * q4) = (f32x4){sv[4 * q4] * inv, sv[4 * q4 + 1] * inv, sv[4 * q4 + 2] * inv, sv[4 * q4 + 3] * inv}; }
    LDS_WAIT();
}

constexpr float PEER_US = 256.0f, PEER_VS = 16.0f;
__device__ __forceinline__ float gelu_exact(float x) { return 0.5f * x * (1.0f + erff(x * 0.7071067811865475f)); }
__device__ __forceinline__ void fp8x16_to_f32(const u32x4 v, float* f) {
    const unsigned w[4] = {v.x, v.y, v.z, v.w};
#pragma unroll
    for (int i = 0; i < 4; ++i) { const f32x2 lo = __builtin_amdgcn_cvt_pk_f32_fp8((int)w[i], false), hi = __builtin_amdgcn_cvt_pk_f32_fp8((int)w[i], true);
        f[4 * i] = lo.x; f[4 * i + 1] = lo.y; f[4 * i + 2] = hi.x; f[4 * i + 3] = hi.y; }
}
__device__ __forceinline__ float dot16(const u32x4 u, const float* x) {
    float f[16]; fp8x16_to_f32(u, f);
    float s0 = 0.f, s1 = 0.f;
#pragma unroll
    for (int e = 0; e < 16; e += 2) { s0 += f[e] * x[e]; s1 += f[e + 1] * x[e + 1]; }
    return s0 + s1;
}
__device__ __forceinline__ void axpy16(float* o, float w, const u32x4 v) {
    float f[16]; fp8x16_to_f32(v, f);
#pragma unroll
    for (int e = 0; e < 16; ++e) o[e] += w * f[e];
}
__device__ __forceinline__ void peer_token(const Frame& F, const Params& P, int l, size_t m, bool last_layer, int en_peer) {
    const int lane = F.lane;
    const unsigned char* PU = (const unsigned char*)(F.ws + OFF_PU); const unsigned char* PV = (const unsigned char*)(F.ws + OFF_PV);
    const bf16* hb = (const bf16*)(F.ws + OFF_HB) + m * DM + 16 * lane;
    float* hf = (float*)(F.ws + OFF_HF) + m * DM + 16 * lane;
    float x[16]; unpack8(*(const u32x4*)hb, x); unpack8(*(const u32x4*)(hb + 8), x + 8);
    const int id0 = ((const int*)(F.ws + OFF_IDX))[m * 128 + lane], id1 = ((const int*)(F.ws + OFF_IDX))[m * 128 + 64 + lane];
    const float g0 = ((const float*)(F.ws + OFF_GATE))[m * 128 + lane], g1 = ((const float*)(F.ws + OFF_GATE))[m * 128 + 64 + lane];
    float out[16];
#pragma unroll
    for (int e = 0; e < 16; ++e) out[e] = 0.f;
    const int jl = ((lane >> 5) & 1) * 8 + ((lane >> 4) & 1) * 4 + ((lane >> 3) & 1) * 2 + ((lane >> 2) & 1);
#pragma unroll 1
    for (int rp = 0; rp < en_peer; ++rp)
#pragma unroll 1
    for (int bt = 0; bt < 8; ++bt) {
        u32x4 uu[16], vv[16];
#pragma unroll
        for (int j = 0; j < 16; ++j) {
            const int e = 16 * bt + j;
            const int id = __builtin_amdgcn_readlane(bt < 4 ? id0 : id1, e & 63);
            uu[j] = *(const u32x4*)(PU + (size_t)id * 1024 + 16 * lane); vv[j] = *(const u32x4*)(PV + (size_t)id * 1024 + 16 * lane);
        }
        float p[16];
#pragma unroll
        for (int j = 0; j < 16; ++j) p[j] = dot16(uu[j], x);
#pragma unroll
        for (int j = 0; j < 8; ++j) { const bool up_ = (lane & 32) != 0; const float send = up_ ? p[j] : p[j + 8]; const float recv = shfl_xl(send, 32, lane); p[j] = (up_ ? p[j + 8] : p[j]) + recv; }
#pragma unroll
        for (int j = 0; j < 4; ++j) { const bool up_ = (lane & 16) != 0; const float send = up_ ? p[j] : p[j + 4]; const float recv = shfl_xl(send, 16, lane); p[j] = (up_ ? p[j + 4] : p[j]) + recv; }
#pragma unroll
        for (int j = 0; j < 2; ++j) { const bool up_ = (lane & 8) != 0; const float send = up_ ? p[j] : p[j + 2]; const float recv = shfl_xl(send, 8, lane); p[j] = (up_ ? p[j + 2] : p[j]) + recv; }
        { const bool up_ = (lane & 4) != 0; const float send = up_ ? p[0] : p[1]; const float recv = shfl_xl(send, 4, lane); p[0] = (up_ ? p[1] : p[0]) + recv; }
        float d = p[0]; d += shfl_xl(d, 2, lane); d += shfl_xl(d, 1, lane);
        d *= (1.0f / PEER_US);
        const int esel = 16 * bt + jl;
        const float gsel = shfl_idx(bt < 4 ? g0 : g1, esel & 63);
        const float wsel = gelu_exact(d) * gsel * (1.0f / PEER_VS) / (float)en_peer;
#pragma unroll
        for (int j = 0; j < 16; ++j) {
            const int src = ((j >> 3) & 1) * 32 + ((j >> 2) & 1) * 16 + ((j >> 1) & 1) * 8 + (j & 1) * 4;
            const float wj = __builtin_bit_cast(float, __builtin_amdgcn_readlane(__builtin_bit_cast(int, wsel), src));
            axpy16(out, wj, vv[j]);
        }
    }
    float y[16];
#pragma unroll
    for (int q4 = 0; q4 < 4; ++q4) { const f32x4 a = *(const f32x4*)(hf + 4 * q4);
#pragma unroll
        for (int e = 0; e < 4; ++e) y[4 * q4 + e] = DN_ALPHA * a[e] + out[4 * q4 + e]; }
    float s = 0.f;
#pragma unroll
    for (int e = 0; e < 16; ++e) s += y[e];
    const float mean = wave_sum(s, lane) * (1.0f / 1024.0f);
    float s2 = 0.f;
#pragma unroll
    for (int e = 0; e < 16; ++e) { y[e] -= mean; s2 += y[e] * y[e]; }
    const float rstd = 1.0f / sqrtf(wave_sum(s2, lane) * (1.0f / 1024.0f) + LN_EPS);
    const float* g = (const float*)P.in[22] + l * 1024 + 16 * lane; const float* bb = (const float*)P.in[23] + l * 1024 + 16 * lane;
    float o[16];
#pragma unroll
    for (int q4 = 0; q4 < 4; ++q4) { const f32x4 ga = *(const f32x4*)(g + 4 * q4), ba = *(const f32x4*)(bb + 4 * q4);
#pragma unroll
        for (int e = 0; e < 4; ++e) o[4 * q4 + e] = y[4 * q4 + e] * rstd * ga[e] + ba[e]; }
    float* of = last_layer ? (P.out + m * DM + 16 * lane) : hf;
#pragma unroll
    for (int q4 = 0; q4 < 4; ++q4) *(f32x4*)(of + 4 * q4) = (f32x4){o[4 * q4], o[4 * q4 + 1], o[4 * q4 + 2], o[4 * q4 + 3]};
    if (!last_layer) { bf16* ob = (bf16*)(F.ws + OFF_HB) + m * DM + 16 * lane; *(u32x4*)ob = pack8(o); *(u32x4*)(ob + 8) = pack8(o + 8); }
}

constexpr size_t OFF_ACT = OFF_RC + 16 * MiB;
constexpr size_t OFF_YP = OFF_RB;
constexpr size_t OFF_PART = OFF_RD + 32 * MiB;
constexpr int PEER_CHUNK = 64, PEER_NCHUNK = MROWS / PEER_CHUNK, PEER_TPW = PEER_CHUNK / NWAVES;
__device__ __forceinline__ unsigned peer_xcc() { return (unsigned)__builtin_amdgcn_s_getreg((3 << 11) | 20) & 7u; }

__device__ __forceinline__ void peer_dequeue(const Frame& F, unsigned* ctr, int& slice, int& chunk, int& qstart) {
    LAS int* slot = (LAS int*)(F.lds + LDS_BYTES - 64);
    __syncthreads();
    if (F.tid == 0) {
        int k = qstart, q = 0, i = -1;
        for (; k < 8; ++k) { q = (int)((peer_xcc() + (unsigned)k) & 7u); const unsigned got = atomicAdd(ctr + 64 * q, 1u); if (got < (unsigned)PEER_NCHUNK) { i = (int)got; break; } }
        slot[0] = q; slot[1] = i; slot[2] = k;
    }
    __syncthreads();
    slice = slot[0]; chunk = slot[1]; qstart = slot[2];
}

template <bool IS_U, int NT>
__device__ __forceinline__ void peer_slice_item(const Frame& F, size_t m0, int s) {
    const int lane = F.lane, grp = lane >> 3, ch = lane & 7;
#define SHX(v, m) __builtin_bit_cast(float, __builtin_amdgcn_ds_bpermute(((lane ^ (m)) << 2), __builtin_bit_cast(int, (float)(v))))
#define SHI(v, i) __builtin_amdgcn_ds_bpermute(((i) << 2), (int)(v))
#define SHF(v, i) __builtin_bit_cast(float, __builtin_amdgcn_ds_bpermute(((i) << 2), __builtin_bit_cast(int, (float)(v))))
    const unsigned char* TAB = (const unsigned char*)(F.ws + (IS_U ? OFF_PU : OFF_PV)) + 128 * s;
    const unsigned choff = 16u * (unsigned)ch;
    const int* idp = (const int*)(F.ws + OFF_IDX) + m0 * 128 + lane;
    const float* wp = (const float*)(F.ws + OFF_ACT) + m0 * 128 + lane;
    const int ycol = 128 * s + 16 * ch + 8 * ((lane >> 5) & 1) + 4 * ((lane >> 4) & 1) + 2 * ((lane >> 3) & 1);
    const int pexp = grp + 8 * (8 * ((lane >> 2) & 1) + 4 * ((lane >> 1) & 1) + 2 * (lane & 1));
    const float* hp = (const float*)(F.ws + OFF_HF) + m0 * DM + ycol;
    const bf16* xp = (const bf16*)(F.ws + OFF_HB) + m0 * DM + 128 * s + 16 * ch;
    int ida[NT], idb[NT]; float wa[NT], wb[NT]; f32x2 hv[NT]; u32x4 xa[NT], xb[NT];
#pragma unroll
    for (int k = 0; k < NT; ++k) {
        ida[k] = idp[k * 128]; idb[k] = idp[k * 128 + 64];
        if (!IS_U) { wa[k] = wp[k * 128]; wb[k] = wp[k * 128 + 64]; hv[k] = *(const f32x2*)(hp + (size_t)k * DM); }
        else { xa[k] = *(const u32x4*)(xp + (size_t)k * DM); xb[k] = *(const u32x4*)(xp + (size_t)k * DM + 8); }
    }
    u32x4 sa[8], sb[8];
#define PEER_ISSUE(dst, idv) do { _Pragma("unroll") for (int jj = 0; jj < 8; ++jj) { const int idj = SHI(idv, grp + 8 * jj); dst[jj] = *(const u32x4*)(TAB + (((unsigned)idj << 10) + choff)); } } while (0)
    constexpr bool DB = IS_U;
    if (DB) { PEER_ISSUE(sa, ida[0]); PEER_ISSUE(sb, idb[0]); }
#pragma unroll
    for (int k = 0; k < NT; ++k) {
        if (!DB) { asm volatile("" ::: "memory"); PEER_ISSUE(sa, ida[k]); PEER_ISSUE(sb, idb[k]); asm volatile("" ::: "memory"); }
        float x[16];
        if (IS_U) { unpack8(xa[k], x); unpack8(xb[k], x + 8); }
        float acc[16];
#pragma unroll
        for (int e = 0; e < 16; ++e) acc[e] = 0.f;
#pragma unroll
        for (int jj = 0; jj < 8; ++jj) { asm volatile("" : "+v"(sa[jj]));
            if (IS_U) acc[jj] = dot16(sa[jj], x); else axpy16(acc, SHF(wa[k], grp + 8 * jj), sa[jj]); }
        asm volatile("" ::: "memory");
        if (DB && k + 1 < NT) PEER_ISSUE(sa, ida[k + 1]);
        asm volatile("" ::: "memory");
#pragma unroll
        for (int jj = 0; jj < 8; ++jj) { asm volatile("" : "+v"(sb[jj]));
            if (IS_U) acc[8 + jj] = dot16(sb[jj], x); else axpy16(acc, SHF(wb[k], grp + 8 * jj), sb[jj]); }
        asm volatile("" ::: "memory");
        if (DB && k + 1 < NT) PEER_ISSUE(sb, idb[k + 1]);
        asm volatile("" ::: "memory");
        if (IS_U) {
#pragma unroll
            for (int i = 0; i < 8; ++i) { const bool up_ = (lane & 4) != 0; const float send = up_ ? acc[i] : acc[i + 8]; const float recv = SHX(send, 4); acc[i] = (up_ ? acc[i + 8] : acc[i]) + recv; }
#pragma unroll
            for (int i = 0; i < 4; ++i) { const bool up_ = (lane & 2) != 0; const float send = up_ ? acc[i] : acc[i + 4]; const float recv = SHX(send, 2); acc[i] = (up_ ? acc[i + 4] : acc[i]) + recv; }
#pragma unroll
            for (int i = 0; i < 2; ++i) { const bool up_ = (lane & 1) != 0; const float send = up_ ? acc[i] : acc[i + 2]; const float recv = SHX(send, 1); acc[i] = (up_ ? acc[i + 2] : acc[i]) + recv; }
            float* pp = (float*)(F.ws + OFF_PART) + ((size_t)s * MROWS + m0 + k) * 128 + pexp;
            pp[0] = acc[0]; pp[8] = acc[1];
        } else {
#pragma unroll
            for (int i = 0; i < 8; ++i) { const bool up_ = (lane & 32) != 0; const float send = up_ ? acc[i] : acc[i + 8]; const float recv = SHX(send, 32); acc[i] = (up_ ? acc[i + 8] : acc[i]) + recv; }
#pragma unroll
            for (int i = 0; i < 4; ++i) { const bool up_ = (lane & 16) != 0; const float send = up_ ? acc[i] : acc[i + 4]; const float recv = SHX(send, 16); acc[i] = (up_ ? acc[i + 4] : acc[i]) + recv; }
#pragma unroll
            for (int i = 0; i < 2; ++i) { const bool up_ = (lane & 8) != 0; const float send = up_ ? acc[i] : acc[i + 2]; const float recv = SHX(send, 8); acc[i] = (up_ ? acc[i + 2] : acc[i]) + recv; }
            *(f32x2*)((float*)(F.ws + OFF_YP) + (m0 + k) * DM + ycol) = (f32x2){DN_ALPHA * hv[k].x + acc[0], DN_ALPHA * hv[k].y + acc[1]};
        }
    }
#undef PEER_ISSUE
#undef SHX
#undef SHI
#undef SHF
}

__device__ __forceinline__ void peer_reduce_token(const Frame& F, size_t m) {
    const int lane = F.lane;
    const float* pp = (const float*)(F.ws + OFF_PART) + m * 128;
    float d0 = 0.f, d1 = 0.f;
#pragma unroll
    for (int s = 0; s < 8; ++s) { d0 += pp[(size_t)s * MROWS * 128 + lane]; d1 += pp[(size_t)s * MROWS * 128 + 64 + lane]; }
    const float* gp = (const float*)(F.ws + OFF_GATE) + m * 128; float* ap = (float*)(F.ws + OFF_ACT) + m * 128;
    ap[lane] = gelu_exact(d0 * (1.0f / PEER_US)) * gp[lane] * (1.0f / PEER_VS);
    ap[64 + lane] = gelu_exact(d1 * (1.0f / PEER_US)) * gp[64 + lane] * (1.0f / PEER_VS);
}

#ifndef STOP_AFTER
#define STOP_AFTER 99
#endif
constexpr int PTR_OFF = LDS_BYTES - 512;
__device__ __forceinline__ int tid_of(const int widx) { return (widx << 6) | (int)__builtin_amdgcn_mbcnt_hi(~0u, __builtin_amdgcn_mbcnt_lo(~0u, 0u)); }
__device__ __forceinline__ Frame make_frame(unsigned char* ws_, const int widx) {
    extern __shared__ __attribute__((aligned(16))) unsigned char lds_raw[];
    Frame F; F.lds = (LAS unsigned char*)lds_raw; { int t_ = tid_of(widx); asm volatile("" : "+v"(t_)); F.tid = t_; } F.lane = F.tid & 63; F.wave = __builtin_amdgcn_readfirstlane(F.tid >> 6);
    { int g_ = gridDim.x, b_ = blockIdx.x; asm volatile("" : "+s"(g_), "+s"(b_)); F.G = g_; F.bid = b_; }
    F.ws = ws_;
    return F;
}
__device__ __forceinline__ int dequeue(const Frame& F, unsigned* ctr) {
    LAS int* slot = (LAS int*)(F.lds + LDS_BYTES - 64);
    __syncthreads();
    if (F.tid == 0) slot[0] = (int)atomicAdd(ctr, 1u);
    __syncthreads();
    const int v = slot[0];
    return v;
}
__device__ __noinline__ void grid_sync_fn() { cg::this_grid().sync(); }
__device__ __forceinline__ void bar_fn(unsigned char* ws_, const int widx) {
    extern __shared__ __attribute__((aligned(16))) unsigned char lds_raw[];
    XcdBarrier b; b.bar = (unsigned*)(ws_ + OFF_CTL) + CW_BAR; b.x = xb_xcc_id(); b.st = (volatile LAS unsigned*)((LAS unsigned char*)lds_raw + XB_LDS_OFF);
    xcd_barrier(b, tid_of(widx));
}
typedef pg8::StaticOrder SO;
#ifndef PHASE_FN
#define PHASE_FN __device__ __forceinline__
#endif
__device__ __forceinline__ unsigned long long sgpr64(unsigned long long v) {
    const unsigned lo = (unsigned)__builtin_amdgcn_readfirstlane((int)(unsigned)v), hi = (unsigned)__builtin_amdgcn_readfirstlane((int)(unsigned)(v >> 32));
    return ((unsigned long long)hi << 32) | lo;
}
__device__ __forceinline__ Params fresh_params() {
    const unsigned long long* ka = (const unsigned long long*)__builtin_amdgcn_kernarg_segment_ptr(); asm volatile("" : "+s"(ka));
    Params P;
#pragma unroll
    for (int i = 0; i < 24; ++i) P.in[i] = (const void*)(GAS const unsigned char*)sgpr64(ka[i]);
    P.out = (float*)(GAS float*)sgpr64(ka[24]); P.ws = (unsigned char*)(GAS unsigned char*)sgpr64(ka[25]); P.pad0 = 0; P.pad1 = 0; return P;
}
__device__ __forceinline__ Frame relaunder(const Frame& F0) {
    Frame F = F0; int t_ = F0.tid; asm volatile("" : "+v"(t_)); F.tid = t_; F.lane = t_ & 63; return F;
}
#define PHASE_PROLOG() const Params P = fresh_params(); const Frame F = make_frame(P.ws, widx); unsigned char* ws = F.ws; (void)ws;
#define WL(l) (ws + OFF_W + (size_t)(l) * W_LAYER)

PHASE_FN void ph_p0(const int widx) { PHASE_PROLOG(); p0_prologue(F, P); }
PHASE_FN void ph_p1(const int widx, int l) { PHASE_PROLOG();
    pg8::Gemm g{(const pg8::bf16_t*)(ws + OFF_HB), (const pg8::bf16_t*)(WL(l) + WO_IN), MROWS, 5120, 1024, 1024, 1024};
    SO S; S.init(MROWS, 5120, F.G, F.bid);
    epi::Proj E{(bf16*)(ws + OFF_PROJ1), (bf16*)(ws + OFF_PROJ2)};
    pg8::gemm_phase<epi::Proj, SO, true, true>(F.lds, g, S, E, F.tid);
}
PHASE_FN void ph_p2a(const int widx) { PHASE_PROLOG(); if (F.bid < 64) p2_moba_block(F, F.bid);
    const int gw = ((F.bid + F.G - 64) % F.G) * NWAVES + F.wave, NGW = F.G * NWAVES;
    for (int m = gw; m < MROWS; m += NGW) { const Frame Fi = relaunder(F); p2_row(Fi, m); } }
PHASE_FN void ph_p2b(const int widx, int l) { PHASE_PROLOG();
    const int gw = ((F.bid + F.G - 64) % F.G) * NWAVES + F.wave, NGW = F.G * NWAVES;
    LAS float* Asm = (LAS float*)(F.lds + F.wave * 17408);
    for (int ch = gw; ch < 2048; ch += NGW) { const Frame Fi = relaunder(F); gdn_chunk_wave(Fi, P, l, ch, Asm); } }
PHASE_FN void ph_p3(const int widx, int l, int which) { PHASE_PROLOG();
    if (which == 0) {
        pg8::Gemm g{(const pg8::bf16_t*)(ws + OFF_PROJ1), (const pg8::bf16_t*)(WL(l) + WO_UQ), MROWS, 768, 768, P1LD, 768};
        SO S; S.init(MROWS, 768, F.G, F.bid);
        epi::Store E{(bf16*)(ws + OFF_QMLA), 768, (const float*)(ws + OFF_RSTD), 0};
        pg8::gemm_phase<epi::Store, SO, true, true>(F.lds, g, S, E, F.tid);
    } else {
        pg8::Gemm g{(const pg8::bf16_t*)(ws + OFF_PROJ1) + 768, (const pg8::bf16_t*)(WL(l) + WO_UKV), MROWS, 1024, 256, P1LD, 256};
        SO S; S.init(MROWS, 1024, F.G, (F.bid + 64) % F.G);
        epi::Store E{(bf16*)(ws + OFF_KVMLA), 1024, (const float*)(ws + OFF_RSTD), 1};
        pg8::gemm_phase<epi::Store, SO, true, true>(F.lds, g, S, E, F.tid);
    }
}
PHASE_FN void ph_gdn(const int widx, int l, int i) { PHASE_PROLOG(); gdn_scan_unit(F, P, l, i >> 3, i & 7); }
PHASE_FN void ph_mla(const int widx, int bh, int qb) { PHASE_PROLOG(); attn_unit<96, false>(F, bh >> 3, bh & 7, qb); }
PHASE_FN void ph_moba(const int widx, int bh, int qb) { PHASE_PROLOG(); attn_unit<64, true>(F, bh >> 3, bh & 7, qb); }
PHASE_FN void ph_brzero(const int widx, int which) { PHASE_PROLOG();
    const int gt = F.bid * NTHREADS + F.tid, NGT = F.G * NTHREADS; bf16* BR = (bf16*)(ws + OFF_BR);
    for (int i = gt; i < MROWS * 64; i += NGT) { const int m = i >> 6, c8 = i & 63; *(u32x4*)(BR + (size_t)m * BRLD + which * 512 + 8 * c8) = (u32x4){0u, 0u, 0u, 0u}; } }
PHASE_FN void ph_p5a(const int widx, int l) { PHASE_PROLOG();
    pg8::Gemm g{(const pg8::bf16_t*)(ws + OFF_HB), (const pg8::bf16_t*)(WL(l) + WO_G), MROWS, 3072, 1024, 1024, 1024};
    epi::MergeOrder S; S.init(F.G, F.bid, 0);
    epi::Store E{(bf16*)(ws + OFF_GLG), 3072, nullptr, 0};
    pg8::gemm_phase<epi::Store, epi::MergeOrder, true, true>(F.lds, g, S, E, F.tid);
}
PHASE_FN void ph_p5b(const int widx, int l) { PHASE_PROLOG();
    pg8::Gemm g{(const pg8::bf16_t*)(ws + OFF_BR), (const pg8::bf16_t*)(WL(l) + WO_BR), MROWS, 3072, 512, BRLD, 512};
    epi::MergeOrder S; S.init(F.G, F.bid, 512);
    epi::Merge E{(bf16*)(ws + OFF_MERGED), (const bf16*)(ws + OFF_GLG), (const float*)P.in[13] + (size_t)l * 3072};
    pg8::gemm_phase<epi::Merge, epi::MergeOrder, true, true>(F.lds, g, S, E, F.tid);
}
PHASE_FN void ph_p6(const int widx, int l) { PHASE_PROLOG();
    pg8::Gemm g{(const pg8::bf16_t*)(ws + OFF_MERGED), (const pg8::bf16_t*)(WL(l) + WO_OUT), MROWS, 1024, 1024, 1024, 1024};
    SO S; S.init(MROWS, 1024, F.G, F.bid);
    epi::OutRes E{(float*)(ws + OFF_Y), (const float*)(ws + OFF_HF)};
    pg8::gemm_phase<epi::OutRes, SO, true, true>(F.lds, g, S, E, F.tid);
}
PHASE_FN void ph_ln1(const int widx, int l, int from_y) { PHASE_PROLOG();
    const int gw = F.bid * NWAVES + F.wave, NGW = F.G * NWAVES;
    for (int m = gw; m < MROWS; m += NGW)
        ln_row((const float*)(ws + (from_y ? OFF_Y : OFF_HF)) + (size_t)m * DM, (const float*)P.in[16] + l * 1024, (const float*)P.in[17] + l * 1024,
               (float*)(ws + OFF_HF) + (size_t)m * DM, (bf16*)(ws + OFF_HB) + (size_t)m * DM, F.lane, from_y ? 1.0f : DN_ALPHA);
}
PHASE_FN void ph_p7(const int widx, int l) { PHASE_PROLOG();
    pg8::Gemm g{(const pg8::bf16_t*)(ws + OFF_HB), (const pg8::bf16_t*)(WL(l) + WO_PQ), MROWS, 2048, 1024, 1024, 1024};
    SO S; S.init(MROWS, 2048, F.G, F.bid);
    epi::Store E{(bf16*)(ws + OFF_QRY), 2048, nullptr, 0};
    pg8::gemm_phase<epi::Store, SO, true, true>(F.lds, g, S, E, F.tid);
    peer_tables(F, P, l);
}
PHASE_FN void ph_p8(const int widx, int l) { PHASE_PROLOG(); for (int u = F.bid; u < MROWS / 32; u += F.G) { const Frame Fi = relaunder(F); peer_topk_unit(Fi, l, u); } }
PHASE_FN void ph_p9(const int widx, int l, int en_peer) { PHASE_PROLOG();
    const int gw = F.bid * NWAVES + F.wave, NGW = F.G * NWAVES;
    for (int m = gw; m < MROWS; m += NGW) { const Frame Fi = relaunder(F); peer_token(Fi, P, l, (size_t)m, l == NLAYER - 1, en_peer); }
}

PHASE_FN void ph_p9u(const int widx, int l) { PHASE_PROLOG();
    unsigned* ctr = (unsigned*)(ws + OFF_CTL) + 512 + 64 * (l * 16);
    int qstart = 0;
    for (;;) {
        int s, c; peer_dequeue(F, ctr, s, c, qstart);
        if (c < 0) break;
        s = __builtin_amdgcn_readfirstlane(s); c = __builtin_amdgcn_readfirstlane(c);
#pragma unroll 1
        for (int hf = 0; hf < 2; ++hf) { const Frame Fi = relaunder(F); peer_slice_item<true, 4>(Fi, (size_t)c * PEER_CHUNK + F.wave * PEER_TPW + 4 * hf, s); }
    }
}
PHASE_FN void ph_p9r(const int widx) { PHASE_PROLOG();
    const int gw = F.bid * NWAVES + F.wave, NGW = F.G * NWAVES;
    for (int m = gw; m < MROWS; m += NGW) peer_reduce_token(F, (size_t)m);
}
PHASE_FN void ph_p9v(const int widx, int l) { PHASE_PROLOG();
    unsigned* ctr = (unsigned*)(ws + OFF_CTL) + 512 + 64 * (l * 16 + 8);
    int qstart = 0;
    for (;;) {
        int s, c; peer_dequeue(F, ctr, s, c, qstart);
        if (c < 0) break;
        s = __builtin_amdgcn_readfirstlane(s); c = __builtin_amdgcn_readfirstlane(c);
#pragma unroll 1
        for (int hf = 0; hf < 4; ++hf) { const Frame Fi = relaunder(F); peer_slice_item<false, 2>(Fi, (size_t)c * PEER_CHUNK + F.wave * PEER_TPW + 2 * hf, s); }
    }
}
PHASE_FN void ph_p9ln(const int widx, int l) { PHASE_PROLOG();
    const int gw = F.bid * NWAVES + F.wave, NGW = F.G * NWAVES; const bool last = (l == NLAYER - 1);
    for (int m = gw; m < MROWS; m += NGW)
        ln_row((const float*)(ws + OFF_YP) + (size_t)m * DM, (const float*)P.in[22] + l * 1024, (const float*)P.in[23] + l * 1024,
               last ? P.out + (size_t)m * DM : (float*)(ws + OFF_HF) + (size_t)m * DM, last ? nullptr : (bf16*)(ws + OFF_HB) + (size_t)m * DM, F.lane);
}
#ifndef REP_GEMM
#define REP_GEMM 1
#endif
#ifndef REP_P2
#define REP_P2 1
#endif
#ifndef REP_P4
#define REP_P4 1
#endif
#ifndef REP_GDN
#define REP_GDN 1
#endif
#ifndef REP_ATT
#define REP_ATT 1
#endif
#ifndef REP_P0
#define REP_P0 1
#endif
#ifndef REP_LN1
#define REP_LN1 1
#endif
#ifndef REP_P1
#define REP_P1 REP_GEMM
#endif
#ifndef REP_P3
#define REP_P3 REP_GEMM
#endif
#ifndef REP_P5
#define REP_P5 REP_GEMM
#endif
#ifndef REP_P6
#define REP_P6 REP_GEMM
#endif
#ifndef REP_P7
#define REP_P7 REP_GEMM
#endif
#ifndef PEER_V2
#define PEER_V2 1
#endif
#ifndef REP_P8
#define REP_P8 1
#endif
#ifndef REP_P9
#define REP_P9 1
#endif
#define REPEAT(n, ...) do { __VA_ARGS__; if ((n) > 1) { __VA_ARGS__; } } while (0)
#ifndef EN_MIXER
#define EN_MIXER 1
#endif
#ifndef EN_MLA
#define EN_MLA 1
#endif
#ifndef EN_MOBA
#define EN_MOBA 1
#endif
#ifndef EN_GDN
#define EN_GDN 1
#endif
#ifndef EN_PEER
#define EN_PEER 1
#endif


#define GRID_BAR() bar_fn(fresh_params().ws, widx)
template <int l> __device__ __forceinline__ void layer_body(const int widx) {
    extern __shared__ __attribute__((aligned(16))) unsigned char lds_raw[];

        if (EN_MIXER) {
            REPEAT(REP_P1, ph_p1(widx, l));
            GRID_BAR();
            ph_p2a(widx); REPEAT(REP_P2, ph_p2b(widx, l));
            GRID_BAR();
            REPEAT(REP_P3, ph_p3(widx, l, 0); ph_p3(widx, l, 1));
            GRID_BAR();
            {
              {
                unsigned* ctr = (unsigned*)(fresh_params().ws + OFF_CTL) + 64 * (1 + l);
                const int tid = tid_of(widx);
                LAS int* slot = (LAS int*)((LAS unsigned char*)lds_raw + LDS_BYTES - 64);
                for (;;) {
                    __syncthreads();
                    if (tid == 0) slot[0] = (int)atomicAdd(ctr, 1u);
                    __syncthreads();
                    const int i = __builtin_amdgcn_readfirstlane(slot[0]);
                    if (i >= 64 + 1024) break;
                    if (i < 64) { if (EN_GDN) { REPEAT(REP_GDN, ph_gdn(widx, l, i)); } }
                    else { const int j = i - 64, qb = 7 - (j >> 7), typ = (j >> 6) & 1, bh = j & 63;
                        if (typ == 0) { if (EN_MLA) { REPEAT(REP_ATT, ph_mla(widx, bh, qb)); } } else { if (EN_MOBA) { REPEAT(REP_ATT, ph_moba(widx, bh, qb)); } } }
                }
              }
              if (REP_P4 > 1) {
                unsigned* ctr = (unsigned*)(fresh_params().ws + OFF_CTL) + 64 * (3 + l);
                const int tid = tid_of(widx);
                LAS int* slot = (LAS int*)((LAS unsigned char*)lds_raw + LDS_BYTES - 64);
                for (;;) {
                    __syncthreads();
                    if (tid == 0) slot[0] = (int)atomicAdd(ctr, 1u);
                    __syncthreads();
                    const int i = __builtin_amdgcn_readfirstlane(slot[0]);
                    if (i >= 64 + 1024) break;
                    if (i < 64) { if (EN_GDN) { REPEAT(REP_GDN, ph_gdn(widx, l, i)); } }
                    else { const int j = i - 64, qb = 7 - (j >> 7), typ = (j >> 6) & 1, bh = j & 63;
                        if (typ == 0) { if (EN_MLA) { REPEAT(REP_ATT, ph_mla(widx, bh, qb)); } } else { if (EN_MOBA) { REPEAT(REP_ATT, ph_moba(widx, bh, qb)); } } }
                }
              }
                if (!EN_MLA) ph_brzero(widx, 0);
                if (!EN_MOBA) ph_brzero(widx, 1);
                if (!EN_GDN) ph_brzero(widx, 2);
            }
            GRID_BAR();
            REPEAT(REP_P5, ph_p5a(widx, l); ph_p5b(widx, l));
            GRID_BAR();
            REPEAT(REP_P6, ph_p6(widx, l));
            GRID_BAR();
        }
        REPEAT(REP_LN1, ph_ln1(widx, l, EN_MIXER));
        GRID_BAR();
        if (EN_PEER) {
            REPEAT(REP_P7, ph_p7(widx, l));
            GRID_BAR();
            REPEAT(REP_P8, ph_p8(widx, l));
            GRID_BAR();
        }
        if (PEER_V2 && EN_PEER) {
            ph_p9u(widx, l);
            GRID_BAR();
            ph_p9r(widx);
            GRID_BAR();
            ph_p9v(widx, l);
            GRID_BAR();
            ph_p9ln(widx, l);
        } else ph_p9(widx, l, EN_PEER ? REP_P9 : 0);
        if (l + 1 < NLAYER) GRID_BAR();
}
__global__ void __launch_bounds__(NTHREADS, 2) fwd_mega(Params Pk) {
    const int widx = __builtin_amdgcn_readfirstlane(threadIdx.x >> 6);
    {
        extern __shared__ __attribute__((aligned(16))) unsigned char lds_raw[];
        volatile LAS unsigned* st = (volatile LAS unsigned*)((LAS unsigned char*)lds_raw + XB_LDS_OFF);
        if (threadIdx.x == 0) { st[0] = 0u; st[1] = 0u; }
        __syncthreads();
        (void)xcd_barrier_post((unsigned*)(Pk.ws + OFF_CTL) + CW_BAR, st, threadIdx.x);
    }
    REPEAT(REP_P0, ph_p0(widx));
    grid_sync_fn();
    layer_body<0>(widx);
    layer_body<1>(widx);
}

extern "C" void kernel_launch(void* const* d_in, const int* in_sizes, int n_in, void* d_out, int out_size, void* d_ws, size_t ws_size, hipStream_t stream) {
    static int grid = 0;
    if (grid == 0) {
        if (n_in != 24 || out_size != MROWS * DM || ws_size < WS_END) { fprintf(stderr, "kernel_launch: unexpected shapes (n_in %d out %d ws %zu need %zu)\n", n_in, out_size, ws_size, (size_t)WS_END); grid = -1; return; }
        int dev = 0, cus = 0, per_cu = 0;
        if (hipGetDevice(&dev) != hipSuccess || hipDeviceGetAttribute(&cus, hipDeviceAttributeMultiprocessorCount, dev) != hipSuccess) { grid = -1; return; }
        if (hipFuncSetAttribute((const void*)fwd_mega, hipFuncAttributeMaxDynamicSharedMemorySize, LDS_BYTES) != hipSuccess) { fprintf(stderr, "kernel_launch: hipFuncSetAttribute failed\n"); grid = -1; return; }
        if (hipOccupancyMaxActiveBlocksPerMultiprocessor(&per_cu, (const void*)fwd_mega, NTHREADS, LDS_BYTES) != hipSuccess || per_cu < 1) { fprintf(stderr, "kernel_launch: occupancy query says %d\n", per_cu); per_cu = 1; }
        (void)hipGetLastError();
        grid = cus;
    }
    if (grid < 0) return;
    if (hipMemsetAsync((char*)d_ws + OFF_CTL, 0, CTL_BYTES, stream) != hipSuccess) { fprintf(stderr, "kernel_launch: memset failed\n"); return; }
    Params p{};
    for (int i = 0; i < 24; ++i) p.in[i] = d_in[i];
    p.out = (float*)d_out; p.ws = (unsigned char*)d_ws; p.pad0 = 0; p.pad1 = 0;
    void* args[] = {&p};
    hipError_t e = hipLaunchCooperativeKernel((void*)fwd_mega, dim3(grid), dim3(NTHREADS), args, LDS_BYTES, stream);
    if (e != hipSuccess) fprintf(stderr, "cooperative launch failed: %s (grid %d)\n", hipGetErrorString(e), grid);
}
```
